# Optimizing an MI355X kernel written in HIP

```python
import math
import numpy as np
import jax
import jax.numpy as jnp
from jax import lax

D_MODEL = 1024
BATCH = 16
SEQ = 2048
DEPTH = 2

HEAD_DIM = 64
FOX_HEADS = 8
DSA_HEADS = 8
DSA_KV_HEADS = 2
IDX_HEADS = 4
IDX_DIM = 64
DSA_TOPK = 256
HGRN_HEADS = 8
HGRN_KDIM = 64
HGRN_VDIM = 64
HGRN_CHUNK = 64
DIFF_HEADS = 4
DIFF_DIM = 64
Q_BLOCK = 128
ROPE_THETA = 10000.0
D_FF = 2816
N_EXPERTS = 8
TOP_K = 2
D_FF_EXPERT = 3584
NORM_EPS = 1e-6
NEG_INF = -1e30
F32 = jnp.float32

FOX_W = FOX_HEADS * HEAD_DIM
DSA_W = DSA_HEADS * HEAD_DIM
DSA_KV_W = DSA_KV_HEADS * HEAD_DIM
HGRN_KW = HGRN_HEADS * HGRN_KDIM
HGRN_VW = HGRN_HEADS * HGRN_VDIM
DIFF_QW = DIFF_HEADS * 2 * DIFF_DIM
DIFF_VW = DIFF_HEADS * 2 * DIFF_DIM
EVEN_SPLITS = (FOX_W, FOX_W, FOX_W, FOX_HEADS, DSA_W, DSA_KV_W, DSA_KV_W, IDX_HEADS * IDX_DIM, IDX_DIM, IDX_HEADS)
ODD_SPLITS = (HGRN_KW, HGRN_KW, HGRN_VW, HGRN_VW, DIFF_QW, DIFF_QW, DIFF_VW)
IN_EVEN = sum(EVEN_SPLITS)
IN_ODD = sum(ODD_SPLITS)
MIX_EVEN = FOX_W + DSA_W
MIX_ODD = HGRN_VW + DIFF_VW
N_EVEN = (DEPTH + 1) // 2
N_ODD = DEPTH // 2

kernel_name = "hybrid_fox_dsa_hgrn2_diff_moe_trunk"


def rms_norm(x, g):
    xf = x.astype(F32)
    y = xf * lax.rsqrt(jnp.mean(xf * xf, axis=-1, keepdims=True) + NORM_EPS)
    return (y * g.astype(F32)).astype(x.dtype)


def rope(x, pos):
    d = x.shape[-1]
    half = d // 2
    inv = ROPE_THETA ** (-jnp.arange(half, dtype=F32) * 2.0 / d)
    ang = pos.astype(F32)[:, None] * inv[None, :]
    cos = jnp.cos(ang)[:, None, :]
    sin = jnp.sin(ang)[:, None, :]
    xf = x.astype(F32)
    x1, x2 = xf[..., :half], xf[..., half:]
    return jnp.concatenate([x1 * cos - x2 * sin, x2 * cos + x1 * sin], axis=-1).astype(x.dtype)


def split_cols(h, sizes):
    return jnp.split(h, np.cumsum(sizes)[:-1].tolist(), axis=-1)


def to_blocks(a):
    B, S = a.shape[:2]
    return a.reshape((B, S // Q_BLOCK, Q_BLOCK) + a.shape[2:]).swapaxes(0, 1)


def from_blocks(a):
    a = a.swapaxes(0, 1)
    return a.reshape((a.shape[0], a.shape[1] * a.shape[2]) + a.shape[3:])


def fox_attention(q, k, v, log_f):
    B, S, H, d = q.shape
    nb = S // Q_BLOCK
    scale = d ** -0.5
    c = jnp.cumsum(log_f, axis=1)
    c_keys = c.transpose(0, 2, 1)[:, :, None, :]
    kpos = jnp.arange(S)

    def block(args):
        qi, ci, i = args
        qpos = i * Q_BLOCK + jnp.arange(Q_BLOCK)
        s = jnp.einsum('bqhd,bkhd->bhqk', qi, k, preferred_element_type=F32) * scale
        s = s + ci.transpose(0, 2, 1)[..., None] - c_keys
        s = jnp.where((kpos[None, :] <= qpos[:, None])[None, None], s, NEG_INF)
        p = jax.nn.softmax(s, axis=-1)
        return jnp.einsum('bhqk,bkhd->bqhd', p.astype(v.dtype), v)

    out = lax.map(block, (to_blocks(q), to_blocks(c), jnp.arange(nb)))
    return from_blocks(out)


def dsa_attention(q, k, v, q_idx, k_idx, w_idx):
    B, S, H, d = q.shape
    G = k.shape[2]
    R = H // G
    nb = S // Q_BLOCK
    n_sel = min(DSA_TOPK, S // 4)
    scale = d ** -0.5
    kpos = jnp.arange(S)

    def block(args):
        qi, qii, wi, i = args
        qpos = i * Q_BLOCK + jnp.arange(Q_BLOCK)
        logits = jnp.einsum('bqhd,bkd->bqhk', qii, k_idx, preferred_element_type=F32) * (IDX_DIM ** -0.5)
        score = jnp.einsum('bqh,bqhk->bqk', wi.astype(F32), jax.nn.relu(logits))
        score = jnp.where((kpos[None, :] <= qpos[:, None])[None], score, -jnp.inf)
        _, sel = lax.top_k(score, n_sel)
        kg = jax.vmap(lambda kk, ii: kk[ii])(k, sel)
        vg = jax.vmap(lambda vv, ii: vv[ii])(v, sel)
        qg = qi.reshape(B, Q_BLOCK, G, R, d)
        s = jnp.einsum('bqgrd,bqngd->bgrqn', qg, kg, preferred_element_type=F32) * scale
        valid = sel <= qpos[None, :, None]
        s = jnp.where(valid[:, None, None], s, NEG_INF)
        p = jax.nn.softmax(s, axis=-1)
        o = jnp.einsum('bgrqn,bqngd->bqgrd', p.astype(vg.dtype), vg)
        return o.reshape(B, Q_BLOCK, H, d)

    out = lax.map(block, (to_blocks(q), to_blocks(q_idx), to_blocks(w_idx), jnp.arange(nb)))
    return from_blocks(out)


def hgrn2_chunked(q, log_f, k, v):
    B, S, H, dk = q.shape
    dv = v.shape[-1]
    C = HGRN_CHUNK
    n = S // C

    def to_chunks(a):
        return a.reshape(B, n, C, H, a.shape[-1]).transpose(1, 0, 3, 2, 4)

    tri = jnp.tril(jnp.ones((C, C), dtype=bool))[None, None, :, :, None]

    def step(state, inp):
        qc, fc, kc, vc = inp
        b = jnp.cumsum(fc, axis=2)
        o_inter = jnp.einsum('bhtk,bhkv->bhtv', qc * jnp.exp(b), state)
        rel = jnp.exp(jnp.where(tri, b[:, :, :, None, :] - b[:, :, None, :, :], NEG_INF))
        scores = jnp.einsum('bhtk,bhtsk,bhsk->bhts', qc, rel, kc)
        o_intra = jnp.einsum('bhts,bhsv->bhtv', scores, vc)
        b_last = b[:, :, -1, :]
        new_state = state * jnp.exp(b_last)[..., None] + jnp.einsum(
            'bhsk,bhsv->bhkv', kc * jnp.exp(b_last[:, :, None, :] - b), vc)
        return new_state, o_inter + o_intra

    state0 = jnp.zeros((B, H, dk, dv), F32)
    _, out = lax.scan(step, state0, (to_chunks(q), to_chunks(log_f), to_chunks(k), to_chunks(v)))
    return out.transpose(1, 0, 3, 2, 4).reshape(B, S, H, dv)


def diff_attention(q, k, v, lam):
    B, S, H, _, d = q.shape
    nb = S // Q_BLOCK
    scale = d ** -0.5
    kpos = jnp.arange(S)

    def block(args):
        qi, i = args
        qpos = i * Q_BLOCK + jnp.arange(Q_BLOCK)
        s = jnp.einsum('bqhmd,bkhmd->bhmqk', qi, k, preferred_element_type=F32) * scale
        s = jnp.where((kpos[None, :] <= qpos[:, None])[None, None, None], s, NEG_INF)
        p = jax.nn.softmax(s, axis=-1)
        a = p[:, :, 0] - lam * p[:, :, 1]
        return jnp.einsum('bhqk,bkhv->bqhv', a.astype(v.dtype), v)

    out = lax.map(block, (to_blocks(q), jnp.arange(nb)))
    return from_blocks(out)


def even_mixer(h, w_in, b_f, w_out, pos):
    B, S, _ = h.shape
    fq, fk, fv, ff, dq, dk, dv, iq, ik, iw = split_cols(h @ w_in, EVEN_SPLITS)
    log_f = jax.nn.log_sigmoid((ff + b_f).astype(F32))
    fox_o = fox_attention(fq.reshape(B, S, FOX_HEADS, HEAD_DIM), fk.reshape(B, S, FOX_HEADS, HEAD_DIM),
                          fv.reshape(B, S, FOX_HEADS, HEAD_DIM), log_f)
    dsa_o = dsa_attention(
        rope(dq.reshape(B, S, DSA_HEADS, HEAD_DIM), pos),
        rope(dk.reshape(B, S, DSA_KV_HEADS, HEAD_DIM), pos),
        dv.reshape(B, S, DSA_KV_HEADS, HEAD_DIM),
        rope(iq.reshape(B, S, IDX_HEADS, IDX_DIM), pos),
        rope(ik[:, :, None, :], pos)[:, :, 0, :],
        iw * (IDX_HEADS ** -0.5))
    mixed = jnp.concatenate([fox_o.reshape(B, S, FOX_W), dsa_o.reshape(B, S, DSA_W)], axis=-1)
    return mixed @ w_out


def odd_mixer(h, w_in, lb, hgrn_g, lam_vecs, lam_init, diff_g, w_out, pos):
    B, S, _ = h.shape
    hq, hf, hi, hg, q, k, v = split_cols(h @ w_in, ODD_SPLITS)
    f = lb + (1.0 - lb) * jax.nn.sigmoid(hf.astype(F32))
    shp_k = (B, S, HGRN_HEADS, HGRN_KDIM)
    o_h = hgrn2_chunked(jax.nn.silu(hq.astype(F32)).reshape(shp_k), jnp.log(f).reshape(shp_k),
                        (1.0 - f).reshape(shp_k), hi.astype(F32).reshape(B, S, HGRN_HEADS, HGRN_VDIM))
    o_h = rms_norm(o_h, hgrn_g) * jax.nn.silu(hg.astype(F32)).reshape(B, S, HGRN_HEADS, HGRN_VDIM)
    o_h = o_h.astype(h.dtype).reshape(B, S, HGRN_VW)
    lv = lam_vecs.astype(F32)
    lam = jnp.exp(jnp.sum(lv[0] * lv[1])) - jnp.exp(jnp.sum(lv[2] * lv[3])) + lam_init
    qd = rope(q.reshape(B, S, 2 * DIFF_HEADS, DIFF_DIM), pos).reshape(B, S, DIFF_HEADS, 2, DIFF_DIM)
    kd = rope(k.reshape(B, S, 2 * DIFF_HEADS, DIFF_DIM), pos).reshape(B, S, DIFF_HEADS, 2, DIFF_DIM)
    vd = v.reshape(B, S, DIFF_HEADS, 2 * DIFF_DIM)
    o_d = rms_norm(diff_attention(qd, kd, vd, lam), diff_g) * (1.0 - lam_init)
    o_d = o_d.astype(h.dtype).reshape(B, S, DIFF_VW)
    mixed = jnp.concatenate([o_h, o_d], axis=-1)
    return mixed @ w_out


def swiglu(h, w_gate, w_up, w_down):
    return (jax.nn.silu(h @ w_gate) * (h @ w_up)) @ w_down


def moe_swiglu(h, w_router, w_gate, w_up, w_down):
    logits = jnp.einsum('bsd,de->bse', h, w_router, preferred_element_type=F32)
    top_val, top_idx = lax.top_k(logits, TOP_K)
    gates = jax.nn.softmax(top_val, axis=-1)
    dense_gate = jnp.sum(jax.nn.one_hot(top_idx, N_EXPERTS, dtype=F32) * gates[..., None], axis=-2)
    dense_gate = dense_gate.astype(h.dtype)
    y = jnp.zeros_like(h)
    for e in range(N_EXPERTS):
        y = y + dense_gate[..., e:e + 1] * swiglu(h, w_gate[e], w_up[e], w_down[e])
    return y


def hgrn_lower_bound(lb_logits, layer):
    p = jax.nn.softmax(lb_logits.astype(F32), axis=0)
    return jnp.cumsum(p, axis=0)[layer] - p[0]


def setup_inputs(seed: int = 0) -> dict:
    key = jax.random.key(seed)
    ks = jax.random.split(key, 24)

    def w(k, shape, fan_in):
        return jax.random.normal(k, shape, F32) * (fan_in ** -0.5)

    def gain(k, shape):
        return 1.0 + 0.02 * jax.random.normal(k, shape, F32)

    return {
        'x': jax.random.normal(ks[0], (BATCH, SEQ, D_MODEL), F32),
        'ln_mix_e': gain(ks[1], (N_EVEN, D_MODEL)),
        'w_in_e': w(ks[2], (N_EVEN, D_MODEL, IN_EVEN), D_MODEL),
        'b_fox_f': 0.1 * jax.random.normal(ks[3], (N_EVEN, FOX_HEADS), F32),
        'w_out_e': w(ks[4], (N_EVEN, MIX_EVEN, D_MODEL), MIX_EVEN),
        'ln_ffn_e': gain(ks[5], (N_EVEN, D_MODEL)),
        'w_ffn_gate': w(ks[6], (N_EVEN, D_MODEL, D_FF), D_MODEL),
        'w_ffn_up': w(ks[7], (N_EVEN, D_MODEL, D_FF), D_MODEL),
        'w_ffn_down': w(ks[8], (N_EVEN, D_FF, D_MODEL), D_FF),
        'ln_mix_o': gain(ks[9], (N_ODD, D_MODEL)),
        'w_in_o': w(ks[10], (N_ODD, D_MODEL, IN_ODD), D_MODEL),
        'hgrn_lb_logits': jax.random.normal(ks[11], (DEPTH, HGRN_KW), F32),
        'hgrn_norm_g': gain(ks[12], (N_ODD, HGRN_VDIM)),
        'diff_lambda': 0.1 * jax.random.normal(ks[13], (N_ODD, 4, DIFF_DIM), F32),
        'diff_norm_g': gain(ks[14], (N_ODD, 2 * DIFF_DIM)),
        'w_out_o': w(ks[15], (N_ODD, MIX_ODD, D_MODEL), MIX_ODD),
        'ln_ffn_o': gain(ks[16], (N_ODD, D_MODEL)),
        'w_router': w(ks[17], (N_ODD, D_MODEL, N_EXPERTS), D_MODEL),
        'w_exp_gate': w(ks[18], (N_ODD, N_EXPERTS, D_MODEL, D_FF_EXPERT), D_MODEL),
        'w_exp_up': w(ks[19], (N_ODD, N_EXPERTS, D_MODEL, D_FF_EXPERT), D_MODEL),
        'w_exp_down': w(ks[20], (N_ODD, N_EXPERTS, D_FF_EXPERT, D_MODEL), D_FF_EXPERT),
        'ln_final': gain(ks[21], (D_MODEL,)),
    }


def reference(x, ln_mix_e, w_in_e, b_fox_f, w_out_e, ln_ffn_e, w_ffn_gate, w_ffn_up, w_ffn_down,
              ln_mix_o, w_in_o, hgrn_lb_logits, hgrn_norm_g, diff_lambda, diff_norm_g, w_out_o,
              ln_ffn_o, w_router, w_exp_gate, w_exp_up, w_exp_down, ln_final):
    S = x.shape[1]
    pos = jnp.arange(S)
    for layer in range(DEPTH):
        j = layer // 2
        if layer % 2 == 0:
            x = x + even_mixer(rms_norm(x, ln_mix_e[j]), w_in_e[j], b_fox_f[j], w_out_e[j], pos)
            x = x + swiglu(rms_norm(x, ln_ffn_e[j]), w_ffn_gate[j], w_ffn_up[j], w_ffn_down[j])
        else:
            lb = hgrn_lower_bound(hgrn_lb_logits, layer)
            lam_init = 0.8 - 0.6 * math.exp(-0.3 * layer)
            x = x + odd_mixer(rms_norm(x, ln_mix_o[j]), w_in_o[j], lb, hgrn_norm_g[j], diff_lambda[j],
                              lam_init, diff_norm_g[j], w_out_o[j], pos)
            x = x + moe_swiglu(rms_norm(x, ln_ffn_o[j]), w_router[j], w_exp_gate[j], w_exp_up[j], w_exp_down[j])
    return rms_norm(x, ln_final)
```

```cpp
#include <hip/hip_runtime.h>
#include <hip/hip_bf16.h>
#include <cstdio>
#include <cstdint>

#ifndef MK_PER_PHASE
#define MK_PER_PHASE 1
#endif
#ifndef KO
#define KO 0
#endif
#define DBG 0
#define DBG_LAST 1
#ifndef FAST_ATTN
#define FAST_ATTN 0
#endif

#define LAS __attribute__((address_space(3)))
#define GAS __attribute__((address_space(1)))
typedef unsigned short bf16_t;
typedef short bf16x8 __attribute__((ext_vector_type(8)));
typedef float f32x4 __attribute__((ext_vector_type(4)));
typedef float f32x2 __attribute__((ext_vector_type(2)));
typedef unsigned u32x4 __attribute__((ext_vector_type(4)));
typedef unsigned u32x2 __attribute__((ext_vector_type(2)));
typedef unsigned long long u64;

constexpr int NB = 16, SEQ = 2048, DM = 1024, MTOK = NB * SEQ;
constexpr int N0 = 2816;
constexpr int N0SRC = 2636, N1 = 3584, FF = 2816, FFE = 3584, NEXP = 8;
constexpr float EPS = 1e-6f;
constexpr float LOG2E = 1.4426950408889634f;
constexpr float C2 = 0.125f * LOG2E;
constexpr int C0_FQ = 0, C0_DQ = 512, C0_FK = 1024, C0_FV = 1536, C0_DK = 2048, C0_DV = 2176, C0_IQ = 2304, C0_IK = 2560, C0_FF = 2624, C0_IW = 2632;
constexpr int C1_HQ = 0, C1_Q = 512, C1_HF = 1024, C1_HI = 1536, C1_HG = 2048, C1_K = 2560, C1_V = 3072;

constexpr size_t MiB = 1u << 20;
constexpr size_t WS_CTL = 0, CTL_ZERO_BYTES = 1 * MiB;
constexpr size_t WS_ROPE = 1 * MiB;
constexpr size_t WS_IW   = WS_ROPE + 512 * 1024;
constexpr size_t WS_LOGF = 2 * MiB;
constexpr size_t WS_CB   = 3 * MiB;
constexpr size_t WS_SS   = 4 * MiB;
constexpr size_t WS_WRT  = 6 * MiB;
constexpr size_t WS_GATE = 6 * MiB + 256 * 1024;
constexpr size_t WS_LIST = 7 * MiB;
constexpr size_t WS_WIN0 = 10 * MiB;
constexpr size_t WS_WOUT0 = 16 * MiB;
constexpr size_t WS_WGU0 = 18 * MiB;
constexpr size_t WS_WDN0 = 29 * MiB;
constexpr size_t WS_WIN1 = 35 * MiB;
constexpr size_t WS_WOUT1 = 42 * MiB;
constexpr size_t WS_WEGU = 44 * MiB;
constexpr size_t WS_WEDN = 156 * MiB;
constexpr size_t WS_XB = 212 * MiB;
constexpr size_t WS_BIG = 276 * MiB;
constexpr size_t WS_END = 514 * MiB;
constexpr int MAXPANEL = 136;
static_assert(WS_BIG + (size_t)MAXPANEL * 256 * FFE * 2 <= WS_END && WS_BIG + (size_t)MTOK * N1 * 2 <= WS_END, "ws map");
constexpr int CW_TMO = 0, CW_CODE = 1;
constexpr int CW_CNT = 64;
constexpr int CW_BAR = 4096;

constexpr int RING_BYTES = 135168;
constexpr int LDSCTL_OFF = RING_BYTES, MISC_OFF = LDSCTL_OFF + 320;
constexpr int LDS_BYTES = 147456;
constexpr int NWAVES = 8, NTHR = 512;

#define RLX_AGENT __ATOMIC_RELAXED, __HIP_MEMORY_SCOPE_AGENT
#define LDS_WAIT() asm volatile("s_waitcnt lgkmcnt(0)" ::: "memory")
__device__ __forceinline__ unsigned cvt_pk_bf16(float lo, float hi) { unsigned r; asm volatile("v_cvt_pk_bf16_f32 %0, %1, %2" : "=v"(r) : "v"(lo), "v"(hi)); return r; }
__device__ __forceinline__ float bf_lo(unsigned u) { return __uint_as_float(u << 16); }
__device__ __forceinline__ float bf_hi(unsigned u) { return __uint_as_float(u & 0xffff0000u); }
__device__ __forceinline__ float bf1(bf16_t u) { return __uint_as_float(((unsigned)u) << 16); }
__device__ __forceinline__ float wave_sum(float v) {
#pragma unroll
    for (int o = 1; o < 64; o <<= 1) v += __shfl_xor(v, o);
    return v;
}
__device__ __forceinline__ float wave_max(float v) {
#pragma unroll
    for (int o = 1; o < 64; o <<= 1) v = fmaxf(v, __shfl_xor(v, o));
    return v;
}
__device__ __forceinline__ float sigmoidf_(float x) { return 1.0f / (1.0f + __expf(-x)); }
__device__ __forceinline__ float siluf_(float x) { return x / (1.0f + __expf(-x)); }

namespace pg8 {
constexpr int BM = 256, BK = 64, HALF = 128, HTB = HALF * BK * 2, STAGE_BYTES = 8 * HTB, NXCD = 8, WGM = 8;
__host__ __device__ __forceinline__ int lds_byte(int r, int c) { const int st = (r >> 4) * 2 + (c >> 5), rr = r & 15, cc = c & 31, ob = rr * 64 + cc * 2; return st * 1024 + (ob ^ (((ob >> 9) & 1) << 5)); }
__host__ __device__ __forceinline__ void stage_rc(int b, int& R, int& C) { const int st = b / 1024, sb = b % 1024, swz = sb ^ (((sb >> 9) & 1) << 5); R = (st >> 1) * 16 + swz / 64; C = (st & 1) * 32 + (swz % 64) / 2; }
__host__ __device__ __forceinline__ int perm32(int rho) { const int n = rho >> 4, i = rho & 15; return 8 * (i >> 2) + 4 * n + (i & 3); }

struct Unit { int pm, pn, e, nvalid, lbase; };
struct Gemm { const bf16_t* A; const bf16_t* Bt; int lda; int K; size_t bstride_e; const int* list; };

__device__ __forceinline__ void swz_order(int L, int nM, int nN, int& pm, int& pn) {
    const int nwg = nM * nN; int wgid = L;
    { const int q = nwg / NXCD, r = nwg % NXCD, xcd = wgid % NXCD, off = wgid / NXCD; wgid = (xcd < r ? xcd * (q + 1) : r * (q + 1) + (xcd - r) * q) + off; }
    const int nig = WGM * nN, gid = wgid / nig, fm = gid * WGM, gsz = (nM - fm) < WGM ? (nM - fm) : WGM;
    pm = fm + ((wgid % nig) % gsz); pn = (wgid % nig) / gsz;
}
struct StaticOrder {
    int nM, nN, nwg, G, c;
    __device__ __forceinline__ void init(int M, int N, int G_, int c_) { nM = M / BM; nN = N / BM; nwg = nM * nN; G = G_; c = c_; }
    __device__ __forceinline__ bool next(int i, Unit& u) const {
        const long L = (long)i * G + c; if (L >= nwg) return false;
        swz_order((int)L, nM, nN, u.pm, u.pn); u.e = 0; u.nvalid = BM; u.lbase = 0; return true;
    }
};
struct MoeOrder {
    int nN, NP, G, c; int c0, c1, c2, c3, c4, c5, c6, c7;
    __device__ __forceinline__ void init(const unsigned* cntp, int nN_, int G_, int c_) {
        nN = nN_; G = G_; c = c_;
        c0 = (int)cntp[0]; c1 = (int)cntp[1]; c2 = (int)cntp[2]; c3 = (int)cntp[3]; c4 = (int)cntp[4]; c5 = (int)cntp[5]; c6 = (int)cntp[6]; c7 = (int)cntp[7];
        NP = ((c0 + 255) >> 8) + ((c1 + 255) >> 8) + ((c2 + 255) >> 8) + ((c3 + 255) >> 8) + ((c4 + 255) >> 8) + ((c5 + 255) >> 8) + ((c6 + 255) >> 8) + ((c7 + 255) >> 8);
        if (NP > MAXPANEL) NP = MAXPANEL;
    }
    __device__ __forceinline__ bool next(int i, Unit& u) const {
        const long L = (long)i * G + c; if (L >= (long)NP * nN) return false;
        int pm, pn; swz_order((int)L, NP, nN, pm, pn);
        int e = 0, ps = 0, ce = c0;
#define MOE_STEP(CN, CNEXT, EI) { const int np = ((CN) + 255) >> 8; if (e == (EI) - 1 && pm >= ps + np) { ps += np; e = (EI); ce = (CNEXT); } }
        MOE_STEP(c0, c1, 1) MOE_STEP(c1, c2, 2) MOE_STEP(c2, c3, 3) MOE_STEP(c3, c4, 4) MOE_STEP(c4, c5, 5) MOE_STEP(c5, c6, 6) MOE_STEP(c6, c7, 7)
#undef MOE_STEP
        const int local = pm - ps; int nv = ce - local * 256; nv = nv > 256 ? 256 : nv; nv = nv < 1 ? 1 : nv;
        u.pm = pm; u.pn = pn; u.e = e; u.nvalid = nv; u.lbase = e * MTOK + local * 256; return true;
    }
};

__device__ __forceinline__ float row_rstd(const float* SS, int row, int fq) {
    const f32x4 p = *(const f32x4*)(SS + (size_t)row * 16 + 4 * fq);
    float s = (p[0] + p[1]) + (p[2] + p[3]); s += __shfl_xor(s, 16); s += __shfl_xor(s, 32);
    return rsqrtf(s * (1.0f / DM) + EPS);
}

struct EpiIn {
    static constexpr bool PERM = true;
    bf16_t* O; int ldc; const float* SS; const float* rope; float* LOGF; float* IW; const float* bfox; int layer;
    __device__ __forceinline__ int kind_of(int g64) const {
        if (layer == 0) { if (g64 < 8) return 1; if (g64 < 16) return 3; if (g64 < 32) return 0; if (g64 < 34) return 2; if (g64 < 36) return 0; if (g64 < 40) return 4; if (g64 == 40) return 2; if (g64 == 41) return 5; return 0; }
        if (g64 >= 8 && g64 < 16) return 3; if (g64 >= 40 && g64 < 48) return 2; return 0;
    }
    __device__ __forceinline__ void operator()(const f32x4 (&acc)[2][2][4][2], const Unit& u, int wr, int wc, int fr, int fq) const {
        const int row0 = u.pm * BM + wr * 64 + fr;
        int kind[2]; int colb[2];
#pragma unroll
        for (int bj = 0; bj < 2; ++bj) { colb[bj] = u.pn * BM + bj * HALF + wc * 32; kind[bj] = kind_of(colb[bj] >> 6); }
        const bool anyrope = (kind[0] >= 2 && kind[0] <= 4) || (kind[1] >= 2 && kind[1] <= 4);
        const int i0 = (((wc & 1) * 32) + 8 * fq) >> 1;
#pragma unroll
        for (int ai = 0; ai < 2; ++ai)
#pragma unroll
            for (int m = 0; m < 4; ++m) {
                const int row = row0 + ai * HALF + m * 16;
                const float rs = row_rstd(SS, row, fq);
                f32x4 cs0 = (f32x4){1.f, 0.f, 1.f, 0.f}, cs1 = cs0;
                if (anyrope) { const float* rp = rope + ((size_t)(row & (SEQ - 1)) * 32 + i0) * 2; cs0 = *(const f32x4*)rp; cs1 = *(const f32x4*)(rp + 4); }
#pragma unroll
                for (int bj = 0; bj < 2; ++bj) {
                    f32x4 v0 = acc[ai][bj][m][0] * rs, v1 = acc[ai][bj][m][1] * rs;
                    const int kd = kind[bj];
                    if (kd >= 2 && kd <= 4) {
                        f32x4 a, b;
                        a[0] = v0[0] * cs0[0] - v0[1] * cs0[1]; a[1] = v0[1] * cs0[0] + v0[0] * cs0[1];
                        a[2] = v0[2] * cs0[2] - v0[3] * cs0[3]; a[3] = v0[3] * cs0[2] + v0[2] * cs0[3];
                        b[0] = v1[0] * cs1[0] - v1[1] * cs1[1]; b[1] = v1[1] * cs1[0] + v1[0] * cs1[1];
                        b[2] = v1[2] * cs1[2] - v1[3] * cs1[3]; b[3] = v1[3] * cs1[2] + v1[2] * cs1[3];
                        v0 = a; v1 = b;
                    }
                    const float sc = (kd == 1 || kd == 3) ? C2 : (kd == 4 ? 0.125f : 1.0f);
                    if (kd == 5 && (wc & 1) == 0) {
                        if (fq == 0) { f32x4 l0, l1;
#pragma unroll
                            for (int j = 0; j < 4; ++j) { const float x0 = v0[j] + bfox[j], x1 = v1[j] + bfox[4 + j];
                                l0[j] = fminf(x0, 0.f) - log1pf(__expf(-fabsf(x0))); l1[j] = fminf(x1, 0.f) - log1pf(__expf(-fabsf(x1))); }
                            *(f32x4*)(LOGF + (size_t)row * 8) = l0; *(f32x4*)(LOGF + (size_t)row * 8 + 4) = l1; }
                        if (fq == 1) { *(f32x4*)(IW + (size_t)row * 4) = v0 * 0.5f; }
                    }
                    v0 = v0 * sc; v1 = v1 * sc;
                    u32x4 w; w.x = cvt_pk_bf16(v0[0], v0[1]); w.y = cvt_pk_bf16(v0[2], v0[3]); w.z = cvt_pk_bf16(v1[0], v1[1]); w.w = cvt_pk_bf16(v1[2], v1[3]);
                    *(u32x4*)(O + (size_t)row * ldc + colb[bj] + 8 * fq) = w;
                }
            }
    }
};
struct EpiRes {
    static constexpr bool PERM = false;
    const float* base; float* out; bf16_t* xb; float* SS;
    __device__ __forceinline__ void operator()(const f32x4 (&acc)[2][2][4][2], const Unit& u, int wr, int wc, int fr, int fq) const {
        const int col0 = u.pn * BM + wc * 32 + 4 * fq;
#pragma unroll
        for (int ai = 0; ai < 2; ++ai)
#pragma unroll
            for (int m = 0; m < 4; ++m) {
                const int row = u.pm * BM + ai * HALF + wr * 64 + m * 16 + fr; float ssq = 0.f;
#pragma unroll
                for (int bj = 0; bj < 2; ++bj)
#pragma unroll
                    for (int n = 0; n < 2; ++n) {
                        const size_t off = (size_t)row * DM + col0 + bj * HALF + n * 16;
                        const f32x4 o = *(const f32x4*)(base + off) + acc[ai][bj][m][n];
                        *(f32x4*)(out + off) = o; ssq += (o[0] * o[0] + o[1] * o[1]) + (o[2] * o[2] + o[3] * o[3]);
                        u32x2 w; w.x = cvt_pk_bf16(o[0], o[1]); w.y = cvt_pk_bf16(o[2], o[3]); *(u32x2*)(xb + off) = w;
                    }
                ssq += __shfl_xor(ssq, 16); ssq += __shfl_xor(ssq, 32);
                if (fq == 0) SS[(size_t)row * 16 + u.pn * 4 + wc] = ssq;
            }
    }
};
template <bool MOE> struct EpiGU {
    static constexpr bool PERM = true;
    bf16_t* H; int ldh; const float* SS; const int* list;
    __device__ __forceinline__ void operator()(const f32x4 (&acc)[2][2][4][2], const Unit& u, int wr, int wc, int fr, int fq) const {
        const int hcol = u.pn * HALF + wc * 32 + 8 * fq;
#pragma unroll
        for (int ai = 0; ai < 2; ++ai)
#pragma unroll
            for (int m = 0; m < 4; ++m) {
                const int rl = ai * HALF + wr * 64 + m * 16 + fr;
                int tok = u.pm * BM + rl;
                if (MOE) { const int rc = rl < u.nvalid ? rl : u.nvalid - 1; tok = list[u.lbase + rc]; }
                const float rs = row_rstd(SS, tok, fq);
                unsigned w[4];
#pragma unroll
                for (int n = 0; n < 2; ++n) { float h[4];
#pragma unroll
                    for (int j = 0; j < 4; ++j) { const float g = acc[ai][0][m][n][j] * rs, uu = acc[ai][1][m][n][j] * rs; h[j] = siluf_(g) * uu; }
                    w[2 * n] = cvt_pk_bf16(h[0], h[1]); w[2 * n + 1] = cvt_pk_bf16(h[2], h[3]); }
                *(u32x4*)(H + (size_t)(u.pm * BM + rl) * ldh + hcol) = (u32x4){w[0], w[1], w[2], w[3]};
            }
    }
};
struct EpiMoeDown {
    static constexpr bool PERM = false;
    float* x; const int* list; const float* gate;
    __device__ __forceinline__ void operator()(const f32x4 (&acc)[2][2][4][2], const Unit& u, int wr, int wc, int fr, int fq) const {
        const int col0 = u.pn * BM + wc * 32 + 4 * fq;
#pragma unroll
        for (int ai = 0; ai < 2; ++ai)
#pragma unroll
            for (int m = 0; m < 4; ++m) {
                const int rl = ai * HALF + wr * 64 + m * 16 + fr;
                if (rl < u.nvalid) {
                    const int tok = list[u.lbase + rl]; const float g = gate[tok];
#pragma unroll
                    for (int bj = 0; bj < 2; ++bj)
#pragma unroll
                        for (int n = 0; n < 2; ++n) { float* p = x + (size_t)tok * DM + col0 + bj * HALF + n * 16; *(f32x4*)p = *(const f32x4*)p + acc[ai][bj][m][n] * g; }
                }
            }
    }
};

template <bool GATHER> __device__ __forceinline__ void a_offsets(const Gemm& g, const Unit& u, const int (&R)[2], const int (&C)[2], unsigned (&ao)[2][2]) {
#pragma unroll
    for (int h = 0; h < 2; ++h)
#pragma unroll
        for (int i = 0; i < 2; ++i) { const int rl = h * HALF + R[i]; size_t row;
            if (GATHER) { const int rc = rl < u.nvalid ? rl : u.nvalid - 1; row = (size_t)g.list[u.lbase + rc]; } else row = (size_t)u.pm * BM + rl;
            ao[h][i] = (unsigned)((row * (size_t)g.lda + C[i]) * 2); }
}

template <class Epi, class Sched, bool GATHER, bool ALIGN_EPI>
__device__ __forceinline__ void gemm_phase(LAS unsigned char* lds, const Gemm g, const Sched& S, const Epi& E) {
    const int tid = threadIdx.x, wid = __builtin_amdgcn_readfirstlane(tid >> 6), lane = tid & 63, wr = wid >> 2, wc = wid & 3, fr = lane & 15, fq = lane >> 4;
    const int K = g.K, nt = K / BK;
    int RR[2], CC[2]; unsigned voffB[2];
#pragma unroll
    for (int i = 0; i < 2; ++i) { int R, C; stage_rc(tid * 16 + i * 8192, R, C); RR[i] = R; CC[i] = C; const int Rb = Epi::PERM ? ((R & ~31) + perm32(R & 31)) : R; voffB[i] = (unsigned)(Rb * K + C) * 2u; }
    const size_t kstep = (size_t)(BK * 2);
    const size_t hstepB = (size_t)HALF * K * 2;
    const size_t tstepB = 2 * hstepB;
    const unsigned ldsw = (unsigned)wid * 1024u;
    const int aoff = lds_byte(wr * 64 + fr, fq * 8), boff = lds_byte(wc * 32 + fr, fq * 8);
#define PG8_SA(b, h) (((b) * 2 + (h)) * HTB)
#define PG8_SB(b, h) ((4 + (b) * 2 + (h)) * HTB)
#define PG8_STAGE_B(bufoff, gbase) do { _Pragma("unroll") for (int _i = 0; _i < 2; ++_i) \
        __builtin_amdgcn_global_load_lds((const unsigned*)((const char*)(gbase) + voffB[_i]), (LAS unsigned*)(lds + (bufoff) + ldsw + _i * 8192), 16, 0, 0); } while (0)
#define PG8_STAGE_A(bufoff, kb, AO) do { _Pragma("unroll") for (int _i = 0; _i < 2; ++_i) \
        __builtin_amdgcn_global_load_lds((const unsigned*)(Ab + (kb) + (AO)[_i]), (LAS unsigned*)(lds + (bufoff) + ldsw + _i * 8192), 16, 0, 0); } while (0)
#define PG8_LDA(dst, b, h) do { _Pragma("unroll") for (int m = 0; m < 4; ++m) _Pragma("unroll") for (int k = 0; k < 2; ++k) dst[m][k] = *(const LAS bf16x8*)(lds + PG8_SA(b, h) + aoff + m * 2048 + k * 1024); } while (0)
#define PG8_LDB(dst, b, h) do { _Pragma("unroll") for (int n = 0; n < 2; ++n) _Pragma("unroll") for (int k = 0; k < 2; ++k) dst[n][k] = *(const LAS bf16x8*)(lds + PG8_SB(b, h) + boff + n * 2048 + k * 1024); } while (0)
#define PG8_MMA(ai, bj, At, Bt) do { __builtin_amdgcn_s_setprio(1); _Pragma("unroll") for (int m = 0; m < 4; ++m) _Pragma("unroll") for (int n = 0; n < 2; ++n) _Pragma("unroll") for (int k = 0; k < 2; ++k) \
        acc[ai][bj][m][n] = __builtin_amdgcn_mfma_f32_16x16x32_bf16(Bt[n][k], At[m][k], acc[ai][bj][m][n], 0, 0, 0); __builtin_amdgcn_s_setprio(0); } while (0)
#define PG8_WAIT_V(n) asm volatile("s_waitcnt vmcnt(" #n ")" ::: "memory")
#define PG8_WAIT_L(n) asm volatile("s_waitcnt lgkmcnt(" #n ")" ::: "memory")
#define PG8_BAR __builtin_amdgcn_s_barrier()
#define PG8_SCHED __builtin_amdgcn_sched_barrier(0)
    Unit cur, nxt; int ui = 0;
    if (!S.next(0, cur)) return;
    f32x4 acc[2][2][4][2];
#pragma unroll
    for (int a = 0; a < 2; ++a)
#pragma unroll
        for (int b = 0; b < 2; ++b)
#pragma unroll
            for (int m = 0; m < 4; ++m)
#pragma unroll
                for (int n = 0; n < 2; ++n) acc[a][b][m][n] = (f32x4){0.f, 0.f, 0.f, 0.f};
    bf16x8 At[4][2], B0[2][2], B1[2][2];
    unsigned cao[2][2], nao[2][2];
    a_offsets<GATHER>(g, cur, RR, CC, cao);
    const char* Ab = (const char*)g.A;
    const char* cB = (const char*)g.Bt + ((size_t)cur.e * g.bstride_e) * 2 + (size_t)cur.pn * tstepB;
    PG8_STAGE_B(PG8_SB(0, 0), cB); PG8_STAGE_B(PG8_SB(0, 1), cB + hstepB); PG8_STAGE_A(PG8_SA(0, 0), 0, cao[0]); PG8_STAGE_A(PG8_SA(0, 1), 0, cao[1]);
    if (wr == 1) PG8_BAR;
    PG8_WAIT_V(2); PG8_BAR;
    PG8_STAGE_B(PG8_SB(1, 0), cB + kstep); PG8_STAGE_A(PG8_SA(1, 0), kstep, cao[0]); PG8_STAGE_B(PG8_SB(1, 1), cB + hstepB + kstep);
    PG8_WAIT_V(6); PG8_BAR;
    for (;;) {
        const bool has_next = S.next(ui + 1, nxt);
        if (has_next) a_offsets<GATHER>(g, nxt, RR, CC, nao);
        else {
#pragma unroll
            for (int h = 0; h < 2; ++h)
#pragma unroll
                for (int i = 0; i < 2; ++i) nao[h][i] = cao[h][i]; }
        const char* nB = has_next ? (const char*)g.Bt + ((size_t)nxt.e * g.bstride_e) * 2 + (size_t)nxt.pn * tstepB : cB;
        for (int t = 0; t < nt; t += 2) {
            const bool last = (t == nt - 2);
            const size_t ka1 = (size_t)(t + 1) * kstep;
            const size_t ka2 = last ? 0 : (size_t)(t + 2) * kstep; const char* b2 = last ? nB : cB + (size_t)(t + 2) * kstep;
            const size_t ka3 = ka2 + kstep; const char* b3 = b2 + kstep;
            unsigned ao2[2][2];
#pragma unroll
            for (int h = 0; h < 2; ++h)
#pragma unroll
                for (int i = 0; i < 2; ++i) ao2[h][i] = last ? nao[h][i] : cao[h][i];
            PG8_LDB(B0, 0, 0); PG8_LDB(B1, 0, 1); PG8_SCHED; PG8_LDA(At, 0, 0); PG8_STAGE_A(PG8_SA(1, 1), ka1, cao[1]);
            PG8_WAIT_V(8); PG8_WAIT_L(0); PG8_BAR; PG8_MMA(0, 0, At, B0); PG8_MMA(0, 1, At, B1); PG8_BAR; PG8_SCHED;
            PG8_LDA(At, 0, 1); PG8_STAGE_B(PG8_SB(0, 0), b2); PG8_STAGE_B(PG8_SB(0, 1), b2 + hstepB); PG8_STAGE_A(PG8_SA(0, 0), ka2, ao2[0]);
            PG8_WAIT_V(8); PG8_WAIT_L(0); PG8_BAR; PG8_MMA(1, 0, At, B0); PG8_MMA(1, 1, At, B1); PG8_BAR; PG8_SCHED;
            PG8_LDB(B0, 1, 0); PG8_LDB(B1, 1, 1); PG8_SCHED; PG8_LDA(At, 1, 0); PG8_STAGE_A(PG8_SA(0, 1), ka2, ao2[1]);
            PG8_WAIT_V(8); PG8_WAIT_L(0); PG8_BAR; PG8_MMA(0, 0, At, B0); PG8_MMA(0, 1, At, B1); PG8_BAR; PG8_SCHED;
            PG8_LDA(At, 1, 1); PG8_STAGE_B(PG8_SB(1, 0), b3); PG8_STAGE_B(PG8_SB(1, 1), b3 + hstepB); PG8_STAGE_A(PG8_SA(1, 0), ka3, ao2[0]);
            PG8_WAIT_V(8); PG8_WAIT_L(0); PG8_BAR; PG8_MMA(1, 0, At, B0); PG8_MMA(1, 1, At, B1); PG8_BAR; PG8_SCHED;
        }
        if constexpr (ALIGN_EPI) { if (wr == 0) PG8_BAR; }
        E(acc, cur, wr, wc, fr, fq);
        if (!has_next) break;
#pragma unroll
        for (int a = 0; a < 2; ++a)
#pragma unroll
            for (int b = 0; b < 2; ++b)
#pragma unroll
                for (int m = 0; m < 4; ++m)
#pragma unroll
                    for (int n = 0; n < 2; ++n) acc[a][b][m][n] = (f32x4){0.f, 0.f, 0.f, 0.f};
        cur = nxt; cB = nB; ++ui;
#pragma unroll
        for (int h = 0; h < 2; ++h)
#pragma unroll
            for (int i = 0; i < 2; ++i) cao[h][i] = nao[h][i];
        if constexpr (ALIGN_EPI) { if (wr == 1) PG8_BAR; }
    }
    PG8_WAIT_V(0);
    if constexpr (!ALIGN_EPI) { if (wr == 0) PG8_BAR; }
    PG8_BAR;
#undef PG8_SA
#undef PG8_SB
#undef PG8_STAGE_A
#undef PG8_STAGE_B
#undef PG8_LDA
#undef PG8_LDB
#undef PG8_MMA
#undef PG8_WAIT_V
#undef PG8_WAIT_L
#undef PG8_BAR
#undef PG8_SCHED
}
}

#define XB_TMO      128
#define XB_XCNT(j)  (256  + 64 * (j))
#define XB_XSUB(j)  (1280 + 64 * (j))
#define XB_XGEN(j)  (2304 + 64 * (j))
#define XB_TOP      3328
#define XB_TOPGEN   3392
#define XCD_BAR_WORDS 3456
#define XB_SPIN_CAP (1u << 18)
__device__ __forceinline__ unsigned xb_ld(unsigned* p)              { return __hip_atomic_load(p, __ATOMIC_RELAXED, __HIP_MEMORY_SCOPE_AGENT); }
__device__ __forceinline__ unsigned xb_add(unsigned* p, unsigned v) { return __hip_atomic_fetch_add(p, v, __ATOMIC_RELAXED, __HIP_MEMORY_SCOPE_AGENT); }
__device__ __forceinline__ unsigned xb_xcc_id() { return (unsigned)__builtin_amdgcn_s_getreg((3 << 11) | 20) & 0xFu; }
#define XB_SPIN(cond, bar) do { unsigned _sp = 0; while (cond) { __builtin_amdgcn_s_sleep(1); \
    if ((++_sp & 255u) == 0u) { if (xb_ld(&(bar)[XB_TMO])) break; if (_sp > XB_SPIN_CAP) { atomicAdd(&(bar)[XB_TMO], 1u); break; } } } } while (0)
struct XcdBarrier { unsigned* bar; unsigned x; volatile LAS unsigned* st; };
__device__ __forceinline__ XcdBarrier xcd_barrier_post(unsigned* bar, volatile LAS unsigned* st) {
    XcdBarrier b; b.bar = bar; b.x = xb_xcc_id(); b.st = st;
    if (threadIdx.x == 0) (void)xb_add(&bar[XB_XCNT(b.x)], 1u);
    return b;
}
__device__ __forceinline__ void xcd_barrier_complete(unsigned* bar, unsigned x, unsigned& nloc, unsigned& nx) {
    const unsigned G = gridDim.x * gridDim.y * gridDim.z;
    unsigned sum, cnt, mine, sp = 0u;
    for (;;) {
        sum = 0u; cnt = 0u; mine = 0u;
#pragma unroll
        for (unsigned j = 0; j < 16; ++j) { const unsigned c = xb_ld(&bar[XB_XCNT(j)]); sum += c; cnt += (c > 0u) ? 1u : 0u; mine = (j == x) ? c : mine; }
        if (sum == G) break;
        __builtin_amdgcn_s_sleep(1);
        if ((++sp & 255u) == 0u) { if (xb_ld(&bar[XB_TMO])) break; if (sp > XB_SPIN_CAP) { atomicAdd(&bar[XB_TMO], 1u); break; } }
    }
    nloc = mine > 0u ? mine : 1u; nx = cnt > 0u ? cnt : 1u;
}
__device__ __forceinline__ void xcd_barrier(const XcdBarrier& b) {
    asm volatile("s_waitcnt vmcnt(0)" ::: "memory");
    __syncthreads();
    if (threadIdx.x == 0) {
        unsigned* bar = b.bar;
        __builtin_amdgcn_s_waitcnt(0);
        unsigned nloc = b.st[0], nx = b.st[1];
        if (nloc == 0u) { xcd_barrier_complete(bar, b.x, nloc, nx); b.st[0] = nloc; b.st[1] = nx; }
        const unsigned old = xb_add(&bar[XB_XSUB(b.x)], 1u);
        const unsigned gen = old / nloc;
        if (old + 1u == (gen + 1u) * nloc) {
            __builtin_amdgcn_fence(__ATOMIC_RELEASE, "agent");
            asm volatile("s_waitcnt vmcnt(0)" ::: "memory");
            const unsigned og = xb_add(&bar[XB_TOP], 1u);
            const unsigned tg = og / nx;
            if (og + 1u == (tg + 1u) * nx) xb_add(&bar[XB_TOPGEN], 1u);
            else XB_SPIN(xb_ld(&bar[XB_TOPGEN]) == tg, bar);
            __builtin_amdgcn_fence(__ATOMIC_ACQUIRE, "agent");
            xb_add(&bar[XB_XGEN(b.x)], 1u);
            asm volatile("s_waitcnt vmcnt(0)" ::: "memory");
        } else {
            XB_SPIN(xb_ld(&bar[XB_XGEN(b.x)]) == gen, bar);
            __builtin_amdgcn_fence(__ATOMIC_ACQUIRE, "agent");
            asm volatile("s_waitcnt vmcnt(0)" ::: "memory");
        }
    }
    __syncthreads();
}

struct Frame {
    LAS unsigned char* lds;
    unsigned* ctl;
    int tid, lane, wave, vcu, G;
    const float* const* inp; float* out; unsigned char* ws;
};
enum { I_X = 0, I_LN_MIX_E, I_W_IN_E, I_B_FOX, I_W_OUT_E, I_LN_FFN_E, I_W_GATE, I_W_UP, I_W_DOWN, I_LN_MIX_O, I_W_IN_O, I_LB, I_HGRN_G, I_LAM, I_DIFF_G, I_W_OUT_O, I_LN_FFN_O, I_W_ROUTER, I_WE_GATE, I_WE_UP, I_WE_DOWN, I_LN_FINAL };

__device__ __forceinline__ int dim_of_pos(int p) { return (p >> 1) + 32 * (p & 1); }
__device__ __forceinline__ int srccol_in0(int j) {
    if (j < 512) return j;
    if (j < 1024) { const int o = j - 512; return 1544 + (o & ~63) + dim_of_pos(o & 63); }
    if (j < 1536) return 512 + (j - 1024);
    if (j < 2048) return 1024 + (j - 1536);
    if (j < 2176) { const int o = j - 2048; return 2056 + (o & ~63) + dim_of_pos(o & 63); }
    if (j < 2304) return 2184 + (j - 2176);
    if (j < 2560) { const int o = j - 2304; return 2312 + (o & ~63) + dim_of_pos(o & 63); }
    if (j < 2624) { const int o = j - 2560; return 2568 + dim_of_pos(o); }
    if (j < 2632) return 1536 + (j - 2624);
    if (j < 2636) return 2632 + (j - 2632);
    return -1;
}
__device__ __forceinline__ int srccol_in1(int j) {
    if (j < 512) return j;
    if (j < 1024) { const int o = j - 512; return 2048 + (o & ~63) + dim_of_pos(o & 63); }
    if (j < 1536) return 512 + (j - 1024);
    if (j < 2048) return 1024 + (j - 1536);
    if (j < 2560) return 1536 + (j - 2048);
    if (j < 3072) { const int o = j - 2560; return 2560 + (o & ~63) + dim_of_pos(o & 63); }
    return 3072 + (j - 3072);
}
__device__ __forceinline__ void p0_item(const float* W, int Nsrc, int sc, const float* gain, bf16_t* WT, int K, int n0, int k0, LAS float* scr, int lane) {
    const float gk = gain ? gain[k0 + lane] : 1.0f;
    const float* src = W + (size_t)k0 * Nsrc + (sc >= 0 ? sc : 0);
#pragma unroll 16
    for (int kk = 0; kk < 64; ++kk) { const float gkk = __shfl(gk, kk); float v = src[(size_t)kk * Nsrc] * gkk; v = (sc >= 0) ? v : 0.f; scr[kk * 65 + lane] = v; }
    LDS_WAIT(); asm volatile("" ::: "memory");
    const int c = lane & 7;
#pragma unroll
    for (int j = 0; j < 8; ++j) { const int n = (lane >> 3) + 8 * j; const LAS float* s = scr + (8 * c) * 65 + n;
        u32x4 o; o.x = cvt_pk_bf16(s[0 * 65], s[1 * 65]); o.y = cvt_pk_bf16(s[2 * 65], s[3 * 65]); o.z = cvt_pk_bf16(s[4 * 65], s[5 * 65]); o.w = cvt_pk_bf16(s[6 * 65], s[7 * 65]);
        *(u32x4*)(WT + (size_t)(n0 + n) * K + k0 + 8 * c) = o; }
    LDS_WAIT(); asm volatile("" ::: "memory");
}
__device__ __forceinline__ void p0_prologue(Frame& F) {
    LAS float* scr = (LAS float*)(F.lds + F.wave * 16640);
    const int gw = F.vcu * NWAVES + F.wave, NGW = F.G * NWAVES, lane = F.lane;
    unsigned char* ws = F.ws;
    constexpr int I0 = 16 * 44, I1 = 16 * 16, I2 = 16 * 88, I3 = 44 * 16, I4 = 16 * 56, I5 = 16 * 16, I6 = 8 * 16 * 112, I7 = 8 * 56 * 16;
    constexpr int NITEMS = I0 + I1 + I2 + I3 + I4 + I5 + I6 + I7;
    for (int it = gw; it < NITEMS; it += NGW) {
        int r = it;
        if (r < I0) { const int kb = r / 44, nb = r % 44; const int j = nb * 64 + lane; p0_item(F.inp[I_W_IN_E], N0SRC, srccol_in0(j), F.inp[I_LN_MIX_E], (bf16_t*)(ws + WS_WIN0), DM, nb * 64, kb * 64, scr, lane); continue; } r -= I0;
        if (r < I1) { const int kb = r / 16, nb = r % 16; p0_item(F.inp[I_W_OUT_E], DM, nb * 64 + lane, nullptr, (bf16_t*)(ws + WS_WOUT0), DM, nb * 64, kb * 64, scr, lane); continue; } r -= I1;
        if (r < I2) { const int kb = r / 88, nb = r % 88; const int j = nb * 64, pn = j >> 8, rr = j & 255; const float* W = (rr < 128) ? F.inp[I_W_GATE] : F.inp[I_W_UP];
            p0_item(W, FF, pn * 128 + (rr & 127) + lane, F.inp[I_LN_FFN_E], (bf16_t*)(ws + WS_WGU0), DM, j, kb * 64, scr, lane); continue; } r -= I2;
        if (r < I3) { const int kb = r / 16, nb = r % 16; p0_item(F.inp[I_W_DOWN], DM, nb * 64 + lane, nullptr, (bf16_t*)(ws + WS_WDN0), FF, nb * 64, kb * 64, scr, lane); continue; } r -= I3;
        if (r < I4) { const int kb = r / 56, nb = r % 56; const int j = nb * 64 + lane; p0_item(F.inp[I_W_IN_O], N1, srccol_in1(j), F.inp[I_LN_MIX_O], (bf16_t*)(ws + WS_WIN1), DM, nb * 64, kb * 64, scr, lane); continue; } r -= I4;
        if (r < I5) { const int kb = r / 16, nb = r % 16; p0_item(F.inp[I_W_OUT_O], DM, nb * 64 + lane, nullptr, (bf16_t*)(ws + WS_WOUT1), DM, nb * 64, kb * 64, scr, lane); continue; } r -= I5;
        if (r < I6) { const int e = r / (16 * 112), q = r % (16 * 112), kb = q / 112, nb = q % 112; const int j = nb * 64, pn = j >> 8, rr = j & 255;
            const float* W = ((rr < 128) ? F.inp[I_WE_GATE] : F.inp[I_WE_UP]) + (size_t)e * DM * FFE;
            p0_item(W, FFE, pn * 128 + (rr & 127) + lane, F.inp[I_LN_FFN_O], (bf16_t*)(ws + WS_WEGU) + (size_t)e * 7168 * DM, DM, j, kb * 64, scr, lane); continue; } r -= I6;
        { const int e = r / (56 * 16), q = r % (56 * 16), kb = q / 16, nb = q % 16;
            p0_item(F.inp[I_WE_DOWN] + (size_t)e * FFE * DM, DM, nb * 64 + lane, nullptr, (bf16_t*)(ws + WS_WEDN) + (size_t)e * DM * FFE, FFE, nb * 64, kb * 64, scr, lane); }
    }
    { bf16_t* XB = (bf16_t*)(ws + WS_XB); float* SS = (float*)(ws + WS_SS);
      for (int m = gw; m < MTOK; m += NGW) {
        const f32x4* xr = (const f32x4*)(F.inp[I_X] + (size_t)m * DM) + lane; float s = 0.f; f32x4 v[4];
#pragma unroll
        for (int j = 0; j < 4; ++j) { v[j] = xr[64 * j]; s += (v[j][0] * v[j][0] + v[j][1] * v[j][1]) + (v[j][2] * v[j][2] + v[j][3] * v[j][3]); }
        s = wave_sum(s);
        u32x2* o = (u32x2*)(XB + (size_t)m * DM) + lane;
#pragma unroll
        for (int j = 0; j < 4; ++j) { u32x2 w; w.x = cvt_pk_bf16(v[j][0], v[j][1]); w.y = cvt_pk_bf16(v[j][2], v[j][3]); o[64 * j] = w; }
        if (lane < 16) SS[(size_t)m * 16 + lane] = (lane == 0) ? s : 0.f;
      } }
    { float* rope = (float*)(ws + WS_ROPE); const int gt = gw * 64 + lane, NT = NGW * 64;
      for (int i = gt; i < SEQ * 32; i += NT) { const int t = i >> 5, p = i & 31; const float inv = powf(10000.0f, -(float)p * 2.0f / 64.0f); const float ang = (float)t * inv;
          rope[2 * i] = cosf(ang); rope[2 * i + 1] = sinf(ang); }
      float* wrt = (float*)(ws + WS_WRT);
      for (int i = gt; i < 8 * DM; i += NT) { const int e = i >> 10, k = i & 1023; wrt[i] = F.inp[I_W_ROUTER][k * 8 + e] * F.inp[I_LN_FFN_O][k]; } }
}

__device__ __forceinline__ void fox_cumsum_unit(Frame& F, int bh) {
    const float* LOGF = (const float*)(F.ws + WS_LOGF); float* CB = (float*)(F.ws + WS_CB);
    LAS float* wt = (LAS float*)(F.lds);
    const int b = bh >> 3, h = bh & 7, tid = F.tid;
    float v[4]; float run = 0.f;
#pragma unroll
    for (int j = 0; j < 4; ++j) { v[j] = LOGF[((size_t)b * SEQ + 4 * tid + j) * 8 + h]; run += v[j]; v[j] = run; }
    float incl = run;
#pragma unroll
    for (int o = 1; o < 64; o <<= 1) { const float t = __shfl_up(incl, o); if (F.lane >= o) incl += t; }
    if (F.lane == 63) wt[F.wave] = incl;
    __syncthreads();
    float woff = 0.f;
    for (int w = 0; w < F.wave; ++w) woff += wt[w];
    const float base = woff + incl - run;
    f32x4 o = (f32x4){base + v[0], base + v[1], base + v[2], base + v[3]};
    *(f32x4*)(CB + (size_t)bh * SEQ + 4 * tid) = o;
    __syncthreads();
}
__device__ __forceinline__ unsigned sortable(float f) { const unsigned u = __float_as_uint(f + 0.0f); return (u & 0x80000000u) ? ~u : (u | 0x80000000u); }
constexpr int SCP = 2052;
__device__ __forceinline__ void idx_unit(Frame& F, int b, int qt) {
    const bf16_t* QKV = (const bf16_t*)(F.ws + WS_BIG); const float* IW = (const float*)(F.ws + WS_IW);
    u64* MASKT = (u64*)(F.ws + WS_XB);
    LAS float* Sc = (LAS float*)F.lds;
    const int lane = F.lane, fr = lane & 15, fq = lane >> 4, q0 = qt * 16, nkeys = q0 + 16;
    const size_t rowq = (size_t)b * SEQ + q0 + fr;
    bf16x8 qf[4][2];
#pragma unroll
    for (int h = 0; h < 4; ++h)
#pragma unroll
        for (int ks = 0; ks < 2; ++ks) qf[h][ks] = *(const bf16x8*)(QKV + rowq * N0 + C0_IQ + h * 64 + ks * 32 + fq * 8);
    const f32x4 w4 = *(const f32x4*)(IW + rowq * 4);
    for (int kb = F.wave; kb * 16 < nkeys; kb += NWAVES) {
        const size_t rowk = (size_t)b * SEQ + kb * 16 + fr;
        const bf16x8 k0 = *(const bf16x8*)(QKV + rowk * N0 + C0_IK + fq * 8), k1 = *(const bf16x8*)(QKV + rowk * N0 + C0_IK + 32 + fq * 8);
        f32x4 sc = (f32x4){0.f, 0.f, 0.f, 0.f};
#pragma unroll
        for (int h = 0; h < 4; ++h) { f32x4 a = (f32x4){0.f, 0.f, 0.f, 0.f};
            a = __builtin_amdgcn_mfma_f32_16x16x32_bf16(k0, qf[h][0], a, 0, 0, 0); a = __builtin_amdgcn_mfma_f32_16x16x32_bf16(k1, qf[h][1], a, 0, 0, 0);
#pragma unroll
            for (int j = 0; j < 4; ++j) sc[j] += w4[h] * fmaxf(a[j], 0.f); }
        *(LAS f32x4*)(Sc + fr * SCP + kb * 16 + 4 * fq) = sc;
    }
    __syncthreads();
#pragma unroll 1
    for (int rr = 0; rr < 2; ++rr) {
        const int row = F.wave * 2 + rr, t = q0 + row;
        unsigned key[32];
#pragma unroll
        for (int i = 0; i < 32; ++i) { const int s = i * 64 + lane; key[i] = (s <= t) ? sortable(Sc[row * SCP + (s < nkeys ? s : 0)]) : 0u; }
        unsigned theta = 0u; int need = 0;
        const bool all = (t + 1 <= 256);
        if (!all) {
            unsigned prefix = 0u;
#pragma unroll 1
            for (int bit = 31; bit >= 0; --bit) { const unsigned cand = prefix | (1u << bit); int cnt = 0;
#pragma unroll
                for (int i = 0; i < 32; ++i) cnt += __popcll(__ballot(key[i] >= cand));
                if (cnt >= 256) prefix = cand; }
            theta = prefix; int ngt = 0;
#pragma unroll
            for (int i = 0; i < 32; ++i) ngt += __popcll(__ballot(key[i] > theta));
            need = 256 - ngt;
        }
        int running = 0; u64 mine = 0ull;
#pragma unroll
        for (int i = 0; i < 32; ++i) {
            bool sel;
            if (all) sel = (i * 64 + lane <= t);
            else { const u64 eq = __ballot(key[i] == theta);
                   const int rank = running + (int)__builtin_amdgcn_mbcnt_hi((unsigned)(eq >> 32), __builtin_amdgcn_mbcnt_lo((unsigned)eq, 0u));
                   sel = (key[i] > theta) || (key[i] == theta && rank < need); running += __popcll(eq); }
            const u64 w = __ballot(sel);
            if (lane == i) mine = w;
        }
        if (lane < 32) MASKT[((size_t)b * 32 + lane) * SEQ + t] = mine;
    }
    __syncthreads();
}

template <int MODE, bool KOZ = false>
__device__ __forceinline__ void naive_attn_row(const bf16_t* Qrow, const bf16_t* Kp, const bf16_t* Vp, long kvpitch, bf16_t* Orow, int t, const float* cb, const u64* maskb, int lane) {
    float q[64];
#pragma unroll
    for (int c = 0; c < 8; ++c) { const u32x4 w = *(const u32x4*)(Qrow + c * 8);
        q[8 * c + 0] = bf_lo(w.x); q[8 * c + 1] = bf_hi(w.x); q[8 * c + 2] = bf_lo(w.y); q[8 * c + 3] = bf_hi(w.y); q[8 * c + 4] = bf_lo(w.z); q[8 * c + 5] = bf_hi(w.z); q[8 * c + 6] = bf_lo(w.w); q[8 * c + 7] = bf_hi(w.w); }
    float m = -INFINITY, l = 0.f; float o[64];
#pragma unroll
    for (int d = 0; d < 64; ++d) o[d] = 0.f;
    for (int s = lane; s <= t; s += 64) {
        if (MODE == 2) { const u64 w = maskb[(size_t)(s >> 6) * SEQ + t]; if (!((w >> (s & 63)) & 1ull)) continue; }
        const bf16_t* kr = Kp + (size_t)s * kvpitch; float dot = 0.f;
#pragma unroll
        for (int c = 0; c < 8; ++c) { const u32x4 w = *(const u32x4*)(kr + c * 8);
            dot += q[8 * c + 0] * bf_lo(w.x) + q[8 * c + 1] * bf_hi(w.x) + q[8 * c + 2] * bf_lo(w.y) + q[8 * c + 3] * bf_hi(w.y) + q[8 * c + 4] * bf_lo(w.z) + q[8 * c + 5] * bf_hi(w.z) + q[8 * c + 6] * bf_lo(w.w) + q[8 * c + 7] * bf_hi(w.w); }
        if (MODE == 1) dot -= cb[s] * LOG2E;
        const float mn = fmaxf(m, dot), a = exp2f(m - mn), p = exp2f(dot - mn);
        l = l * a + p; m = mn;
        const bf16_t* vr = Vp + (size_t)s * kvpitch;
#pragma unroll
        for (int c = 0; c < 8; ++c) { const u32x4 w = *(const u32x4*)(vr + c * 8);
            o[8 * c + 0] = o[8 * c + 0] * a + p * bf_lo(w.x); o[8 * c + 1] = o[8 * c + 1] * a + p * bf_hi(w.x); o[8 * c + 2] = o[8 * c + 2] * a + p * bf_lo(w.y); o[8 * c + 3] = o[8 * c + 3] * a + p * bf_hi(w.y);
            o[8 * c + 4] = o[8 * c + 4] * a + p * bf_lo(w.z); o[8 * c + 5] = o[8 * c + 5] * a + p * bf_hi(w.z); o[8 * c + 6] = o[8 * c + 6] * a + p * bf_lo(w.w); o[8 * c + 7] = o[8 * c + 7] * a + p * bf_hi(w.w); }
    }
    const float Mx = wave_max(m); const float sc = (m == -INFINITY) ? 0.f : exp2f(m - Mx);
    const float L = wave_sum(l * sc); float res = 0.f;
#pragma unroll
    for (int d = 0; d < 64; ++d) { const float od = wave_sum(o[d] * sc); if (lane == d) res = od; }
    float r = res / L; if (KOZ) r = 0.f;
    const unsigned pk = cvt_pk_bf16(r, r);
    Orow[lane] = (bf16_t)(pk & 0xffffu);
}

__device__ __forceinline__ void hgrn_unit(Frame& F, int u) {
    bf16_t* QKV = (bf16_t*)(F.ws + WS_BIG);
    const int b = u >> 4, h = (u >> 1) & 7, vh = u & 1, tid = F.tid, lane = F.lane, vloc = lane & 31, ks = lane >> 5;
    LAS float* Qs = (LAS float*)F.lds;
    LAS float* Fs = Qs + 4096;
    LAS float* Vs = Fs + 4096;
    LAS float* Os = Vs + 2048;
    const int k0 = F.wave * 8 + ks * 4;
    float st[4] = {0.f, 0.f, 0.f, 0.f};
    const int sk = (tid & 7) * 8, stt = tid >> 3;
    float lbv[8];
#pragma unroll
    for (int j = 0; j < 8; ++j) { const int ch = h * 64 + sk + j; lbv[j] = sigmoidf_(F.inp[I_LB][512 + ch] - F.inp[I_LB][ch]); }
    for (int c = 0; c < SEQ / 64; ++c) {
        const size_t row0 = (size_t)b * SEQ + c * 64;
        { const bf16_t* rp = QKV + (row0 + stt) * N1;
          const u32x4 wq = *(const u32x4*)(rp + C1_HQ + h * 64 + sk), wf = *(const u32x4*)(rp + C1_HF + h * 64 + sk);
          const unsigned aq[4] = {wq.x, wq.y, wq.z, wq.w}, af[4] = {wf.x, wf.y, wf.z, wf.w};
          float qv[8], fv[8];
#pragma unroll
          for (int j = 0; j < 4; ++j) { qv[2 * j] = siluf_(bf_lo(aq[j])); qv[2 * j + 1] = siluf_(bf_hi(aq[j]));
              fv[2 * j] = lbv[2 * j] + (1.f - lbv[2 * j]) * sigmoidf_(bf_lo(af[j])); fv[2 * j + 1] = lbv[2 * j + 1] + (1.f - lbv[2 * j + 1]) * sigmoidf_(bf_hi(af[j])); }
          *(LAS f32x4*)(Qs + stt * 64 + sk) = (f32x4){qv[0], qv[1], qv[2], qv[3]}; *(LAS f32x4*)(Qs + stt * 64 + sk + 4) = (f32x4){qv[4], qv[5], qv[6], qv[7]};
          *(LAS f32x4*)(Fs + stt * 64 + sk) = (f32x4){fv[0], fv[1], fv[2], fv[3]}; *(LAS f32x4*)(Fs + stt * 64 + sk + 4) = (f32x4){fv[4], fv[5], fv[6], fv[7]};
          if (tid < 256) { const int vt = tid >> 2, vc = (tid & 3) * 8; const u32x4 wv = *(const u32x4*)(QKV + (row0 + vt) * N1 + C1_HI + h * 64 + vh * 32 + vc);
              *(LAS f32x4*)(Vs + vt * 32 + vc) = (f32x4){bf_lo(wv.x), bf_hi(wv.x), bf_lo(wv.y), bf_hi(wv.y)}; *(LAS f32x4*)(Vs + vt * 32 + vc + 4) = (f32x4){bf_lo(wv.z), bf_hi(wv.z), bf_lo(wv.w), bf_hi(wv.w)}; } }
        __syncthreads();
#pragma unroll 4
        for (int tt = 0; tt < 64; ++tt) {
            const f32x4 f4 = *(const LAS f32x4*)(Fs + tt * 64 + k0), q4 = *(const LAS f32x4*)(Qs + tt * 64 + k0); const float v = Vs[tt * 32 + vloc];
            float o = 0.f;
#pragma unroll
            for (int j = 0; j < 4; ++j) { st[j] = f4[j] * (st[j] - v) + v; o += st[j] * q4[j]; }
            o += __shfl_xor(o, 32);
            if (ks == 0) Os[(F.wave * 64 + tt) * 32 + vloc] = o;
        }
        __syncthreads();
        { const int ot = tid >> 3, ov = (tid & 7) * 4; f32x4 s = (f32x4){0.f, 0.f, 0.f, 0.f};
#pragma unroll
          for (int w = 0; w < 8; ++w) s += *(const LAS f32x4*)(Os + (w * 64 + ot) * 32 + ov);
          u32x2 pk; pk.x = cvt_pk_bf16(s[0], s[1]); pk.y = cvt_pk_bf16(s[2], s[3]);
          *(u32x2*)(QKV + (row0 + ot) * N1 + C1_HI + h * 64 + vh * 32 + ov) = pk; }
        __syncthreads();
    }
}

__device__ __forceinline__ void combine_rows(Frame& F) {
    bf16_t* QKV = (bf16_t*)(F.ws + WS_BIG); const bf16_t* DO = (const bf16_t*)(F.ws + WS_XB);
    const int gw = F.vcu * NWAVES + F.wave, NGW = F.G * NWAVES, lane = F.lane;
    const float* lv = F.inp[I_LAM];
    const float d01 = wave_sum(lv[lane] * lv[64 + lane]), d23 = wave_sum(lv[128 + lane] * lv[192 + lane]);
    const float lam_init = 0.8f - 0.6f * expf(-0.3f);
    const float lam = expf(d01) - expf(d23) + lam_init;
    float gh[8], gd[8];
#pragma unroll
    for (int j = 0; j < 8; ++j) { gh[j] = F.inp[I_HGRN_G][(lane & 7) * 8 + j]; gd[j] = F.inp[I_DIFF_G][(lane & 15) * 8 + j] * (1.0f - lam_init); }
    for (int m = gw; m < MTOK; m += NGW) {
        bf16_t* rp = QKV + (size_t)m * N1;
        { const u32x4 wo = *(const u32x4*)(rp + C1_HI + lane * 8), wg = *(const u32x4*)(rp + C1_HG + lane * 8);
          float o[8] = {bf_lo(wo.x), bf_hi(wo.x), bf_lo(wo.y), bf_hi(wo.y), bf_lo(wo.z), bf_hi(wo.z), bf_lo(wo.w), bf_hi(wo.w)};
          float g[8] = {bf_lo(wg.x), bf_hi(wg.x), bf_lo(wg.y), bf_hi(wg.y), bf_lo(wg.z), bf_hi(wg.z), bf_lo(wg.w), bf_hi(wg.w)};
          float ss = 0.f;
#pragma unroll
          for (int j = 0; j < 8; ++j) ss += o[j] * o[j];
          ss += __shfl_xor(ss, 1); ss += __shfl_xor(ss, 2); ss += __shfl_xor(ss, 4);
          const float rs = rsqrtf(ss * (1.0f / 64.0f) + EPS); float r[8];
#pragma unroll
          for (int j = 0; j < 8; ++j) r[j] = (KO & 8) ? 0.f : o[j] * rs * gh[j] * siluf_(g[j]);
          *(u32x4*)(rp + C1_HQ + lane * 8) = (u32x4){cvt_pk_bf16(r[0], r[1]), cvt_pk_bf16(r[2], r[3]), cvt_pk_bf16(r[4], r[5]), cvt_pk_bf16(r[6], r[7])}; }
        { const int hd = lane >> 4, dd = (lane & 15) * 8; const bf16_t* dp = DO + (size_t)m * DM + hd * 256 + dd;
          const u32x4 w1 = *(const u32x4*)dp, w2 = *(const u32x4*)(dp + 128);
          float a[8] = {bf_lo(w1.x), bf_hi(w1.x), bf_lo(w1.y), bf_hi(w1.y), bf_lo(w1.z), bf_hi(w1.z), bf_lo(w1.w), bf_hi(w1.w)};
          float c[8] = {bf_lo(w2.x), bf_hi(w2.x), bf_lo(w2.y), bf_hi(w2.y), bf_lo(w2.z), bf_hi(w2.z), bf_lo(w2.w), bf_hi(w2.w)};
          float ss = 0.f; float d[8];
#pragma unroll
          for (int j = 0; j < 8; ++j) { d[j] = a[j] - lam * c[j]; ss += d[j] * d[j]; }
          ss += __shfl_xor(ss, 1); ss += __shfl_xor(ss, 2); ss += __shfl_xor(ss, 4); ss += __shfl_xor(ss, 8);
          const float rs = rsqrtf(ss * (1.0f / 128.0f) + EPS); float r[8];
#pragma unroll
          for (int j = 0; j < 8; ++j) r[j] = (KO & 16) ? 0.f : d[j] * rs * gd[j];
          *(u32x4*)(rp + C1_Q + hd * 128 + dd) = (u32x4){cvt_pk_bf16(r[0], r[1]), cvt_pk_bf16(r[2], r[3]), cvt_pk_bf16(r[4], r[5]), cvt_pk_bf16(r[6], r[7])}; }
    }
}

__device__ __forceinline__ void router_rows(Frame& F) {
    const bf16_t* XB = (const bf16_t*)(F.ws + WS_XB); const float* SS = (const float*)(F.ws + WS_SS); const float* WRT = (const float*)(F.ws + WS_WRT);
    float* GATE = (float*)(F.ws + WS_GATE); int* LIST = (int*)(F.ws + WS_LIST); unsigned* cnt = F.ctl + CW_CNT;
    LAS float* Ws = (LAS float*)F.lds;
    for (int i = F.tid; i < 8 * DM; i += NTHR) Ws[i] = WRT[i];
    __syncthreads();
    const int gw = F.vcu * NWAVES + F.wave, NGW = F.G * NWAVES, lane = F.lane;
    for (int m = gw; m < MTOK; m += NGW) {
        const u32x4 w0 = *(const u32x4*)(XB + (size_t)m * DM + lane * 8), w1 = *(const u32x4*)(XB + (size_t)m * DM + 512 + lane * 8);
        const float x[16] = {bf_lo(w0.x), bf_hi(w0.x), bf_lo(w0.y), bf_hi(w0.y), bf_lo(w0.z), bf_hi(w0.z), bf_lo(w0.w), bf_hi(w0.w), bf_lo(w1.x), bf_hi(w1.x), bf_lo(w1.y), bf_hi(w1.y), bf_lo(w1.z), bf_hi(w1.z), bf_lo(w1.w), bf_hi(w1.w)};
        float ssum = (lane < 16) ? SS[(size_t)m * 16 + lane] : 0.f; ssum = wave_sum(ssum);
        const float rs = rsqrtf(ssum * (1.0f / DM) + EPS);
        float lg[8];
#pragma unroll
        for (int e = 0; e < 8; ++e) { const LAS float* wp = Ws + e * DM + lane * 8; float s = 0.f;
            const f32x4 a0 = *(const LAS f32x4*)wp, a1 = *(const LAS f32x4*)(wp + 4), b0 = *(const LAS f32x4*)(wp + 512), b1 = *(const LAS f32x4*)(wp + 516);
            s += x[0] * a0[0] + x[1] * a0[1] + x[2] * a0[2] + x[3] * a0[3] + x[4] * a1[0] + x[5] * a1[1] + x[6] * a1[2] + x[7] * a1[3];
            s += x[8] * b0[0] + x[9] * b0[1] + x[10] * b0[2] + x[11] * b0[3] + x[12] * b1[0] + x[13] * b1[1] + x[14] * b1[2] + x[15] * b1[3];
            lg[e] = wave_sum(s) * rs; }
        int i1 = 0; float l1 = lg[0];
#pragma unroll
        for (int e = 1; e < 8; ++e) if (lg[e] > l1) { l1 = lg[e]; i1 = e; }
        int i2 = -1; float l2 = -INFINITY;
#pragma unroll
        for (int e = 0; e < 8; ++e) if (e != i1 && lg[e] > l2) { l2 = lg[e]; i2 = e; }
        const float g1 = 1.0f / (1.0f + __expf(l2 - l1)), g2 = 1.0f - g1;
        if (lane == 0) {
            const unsigned s1 = __hip_atomic_fetch_add(cnt + i1, 1u, RLX_AGENT); LIST[(size_t)i1 * MTOK + s1] = m; GATE[m] = g1;
            const unsigned s2 = __hip_atomic_fetch_add(cnt + 8 + i2, 1u, RLX_AGENT); LIST[(size_t)(8 + i2) * MTOK + s2] = m; GATE[MTOK + m] = g2;
        }
    }
}

__device__ __forceinline__ void final_norm(Frame& F) {
    const int gw = F.vcu * NWAVES + F.wave, NGW = F.G * NWAVES, lane = F.lane;
    f32x4 g[4];
#pragma unroll
    for (int j = 0; j < 4; ++j) g[j] = *((const f32x4*)F.inp[I_LN_FINAL] + lane + 64 * j);
    for (int m = gw; m < MTOK; m += NGW) {
        f32x4* xr = (f32x4*)(F.out + (size_t)m * DM) + lane; f32x4 v[4]; float s = 0.f;
#pragma unroll
        for (int j = 0; j < 4; ++j) { v[j] = xr[64 * j]; s += (v[j][0] * v[j][0] + v[j][1] * v[j][1]) + (v[j][2] * v[j][2] + v[j][3] * v[j][3]); }
        const float rs = rsqrtf(wave_sum(s) * (1.0f / DM) + EPS);
#pragma unroll
        for (int j = 0; j < 4; ++j) xr[64 * j] = v[j] * rs * g[j];
    }
}

constexpr int NPH = 17;
struct Args { const float* in[22]; float* out; unsigned char* ws; int ph_lo, ph_hi, li, pad; };
__global__ void __launch_bounds__(NTHR, 2) trunk_fwd(Args args) {
    extern __shared__ __attribute__((aligned(16))) unsigned char lds[];
    Frame F;
    F.lds = (LAS unsigned char*)lds;
    F.tid = threadIdx.x; F.lane = F.tid & 63; F.wave = __builtin_amdgcn_readfirstlane(F.tid >> 6);
    F.G = gridDim.x; { const int bx = blockIdx.x; F.vcu = (F.G % 8 == 0) ? (bx % 8) * (F.G / 8) + bx / 8 : bx; }
    F.ws = args.ws; F.out = args.out; F.ctl = (unsigned*)(args.ws + WS_CTL);
    F.inp = args.in;
    volatile LAS unsigned* MISC = (volatile LAS unsigned*)(F.lds + MISC_OFF);
    for (int u = F.tid; u < (LDS_BYTES - LDSCTL_OFF) / 4; u += NTHR) ((LAS unsigned*)(F.lds + LDSCTL_OFF))[u] = 0u;
    __syncthreads();
    XcdBarrier bar; bar.bar = F.ctl + CW_BAR; bar.x = 0; bar.st = nullptr;
    if (!MK_PER_PHASE) bar = xcd_barrier_post(F.ctl + CW_BAR, MISC + 8);
#define GRID_BAR() do { if (MK_PER_PHASE) { if (F.tid == 0) __hip_atomic_store(F.ctl + CW_TMO, 0xBADBA0u, RLX_AGENT); } else { xcd_barrier(bar); } } while (0)
    const int lo = args.ph_lo, hi = args.ph_hi;
#ifndef PH_MASK
#define PH_MASK 0x1ffff
#endif
#define IN(k) ((((PH_MASK) >> (k)) & 1) && lo <= (k) && (k) < hi)
#define BOTH(k) (IN(k) && IN((k) + 1))
    unsigned char* ws = args.ws;
    bf16_t* XB = (bf16_t*)(ws + WS_XB); float* SS = (float*)(ws + WS_SS); bf16_t* BIG = (bf16_t*)(ws + WS_BIG);
    const int c = (int)blockIdx.x, G = F.G;

    if (IN(0)) { p0_prologue(F); if (BOTH(0)) GRID_BAR(); }
    if (IN(1)) {
        pg8::Gemm g{XB, (const bf16_t*)(ws + WS_WIN0), DM, DM, 0, nullptr}; pg8::StaticOrder S; S.init(MTOK, N0, G, c);
        pg8::EpiIn E{BIG, N0, SS, (const float*)(ws + WS_ROPE), (float*)(ws + WS_LOGF), (float*)(ws + WS_IW), F.inp[I_B_FOX], 0};
        pg8::gemm_phase<pg8::EpiIn, pg8::StaticOrder, false, true>(F.lds, g, S, E);
        if (BOTH(1)) GRID_BAR();
    }
    if (IN(2)) {
        for (int u = c; u < 128; u += G) fox_cumsum_unit(F, u);
        for (int i = 0; ; ++i) { const int L = i * G + c; if (L >= 2048) break; const int b = L & 15, j = L >> 4; const int qt = (j & 1) ? 127 - (j >> 1) : (j >> 1); idx_unit(F, b, qt); }
        if (BOTH(2)) GRID_BAR();
    }
    if (IN(3)) {
        const int gw = F.vcu * NWAVES + F.wave, NGW = G * NWAVES;
        for (int id = gw; id < 256 * SEQ; id += NGW) {
            const int combo = id & 255, t = id >> 8; const int typ = combo >> 7, b = (combo >> 3) & 15, h = combo & 7;
            bf16_t* rowp = BIG + ((size_t)b * SEQ + t) * N0; const bf16_t* b0 = BIG + (size_t)b * SEQ * N0;
            if (typ == 0) naive_attn_row<1, (KO & 1) != 0>(rowp + C0_FQ + h * 64, b0 + C0_FK + h * 64, b0 + C0_FV + h * 64, N0, rowp + C0_FQ + h * 64, t, (const float*)(ws + WS_CB) + (size_t)(b * 8 + h) * SEQ, nullptr, F.lane);
            else naive_attn_row<2, (KO & 2) != 0>(rowp + C0_DQ + h * 64, b0 + C0_DK + (h >> 2) * 64, b0 + C0_DV + (h >> 2) * 64, N0, rowp + C0_DQ + h * 64, t, nullptr, (const u64*)(ws + WS_XB) + (size_t)b * 32 * SEQ, F.lane);
        }
        if (BOTH(3)) GRID_BAR();
    }
    if (IN(4)) {
        pg8::Gemm g{BIG, (const bf16_t*)(ws + WS_WOUT0), N0, DM, 0, nullptr}; pg8::StaticOrder S; S.init(MTOK, DM, G, c);
        pg8::EpiRes E{F.inp[I_X], F.out, XB, SS};
        pg8::gemm_phase<pg8::EpiRes, pg8::StaticOrder, false, true>(F.lds, g, S, E);
        if (BOTH(4)) GRID_BAR();
    }
    if (IN(5) && !(KO & 4)) {
        pg8::Gemm g{XB, (const bf16_t*)(ws + WS_WGU0), DM, DM, 0, nullptr}; pg8::StaticOrder S; S.init(MTOK, 2 * FF, G, c);
        pg8::EpiGU<false> E{BIG, FF, SS, nullptr};
        pg8::gemm_phase<pg8::EpiGU<false>, pg8::StaticOrder, false, true>(F.lds, g, S, E);
        if (BOTH(5)) GRID_BAR();
    }
    if (IN(6) && !(KO & 4)) {
        pg8::Gemm g{BIG, (const bf16_t*)(ws + WS_WDN0), FF, FF, 0, nullptr}; pg8::StaticOrder S; S.init(MTOK, DM, G, c);
        pg8::EpiRes E{F.out, F.out, XB, SS};
        pg8::gemm_phase<pg8::EpiRes, pg8::StaticOrder, false, true>(F.lds, g, S, E);
        if (BOTH(6)) GRID_BAR();
    }
    if (IN(7)) {
        pg8::Gemm g{XB, (const bf16_t*)(ws + WS_WIN1), DM, DM, 0, nullptr}; pg8::StaticOrder S; S.init(MTOK, N1, G, c);
        pg8::EpiIn E{BIG, N1, SS, (const float*)(ws + WS_ROPE), nullptr, nullptr, nullptr, 1};
        pg8::gemm_phase<pg8::EpiIn, pg8::StaticOrder, false, true>(F.lds, g, S, E);
        if (BOTH(7)) GRID_BAR();
    }
    if (IN(8)) {
        for (int u = c; u < 256; u += G) hgrn_unit(F, u);
        const int gw = F.vcu * NWAVES + F.wave, NGW = G * NWAVES;
        bf16_t* DO = XB;
        for (int id = gw; id < 256 * SEQ; id += NGW) {
            const int combo = id & 255, t = id >> 8; const int b = combo >> 4, hd = (combo >> 2) & 3, mp = (combo >> 1) & 1, jv = combo & 1;
            const bf16_t* rowp = BIG + ((size_t)b * SEQ + t) * N1; const bf16_t* b0 = BIG + (size_t)b * SEQ * N1;
            naive_attn_row<0>(rowp + C1_Q + (hd * 2 + mp) * 64, b0 + C1_K + (hd * 2 + mp) * 64, b0 + C1_V + hd * 128 + jv * 64, N1,
                              DO + ((size_t)b * SEQ + t) * DM + (hd * 2 + mp) * 128 + jv * 64, t, nullptr, nullptr, F.lane);
        }
        if (BOTH(8)) GRID_BAR();
    }
    if (IN(9)) { combine_rows(F); if (BOTH(9)) GRID_BAR(); }
    if (IN(10)) {
        pg8::Gemm g{BIG, (const bf16_t*)(ws + WS_WOUT1), N1, DM, 0, nullptr}; pg8::StaticOrder S; S.init(MTOK, DM, G, c);
        pg8::EpiRes E{F.out, F.out, XB, SS};
        pg8::gemm_phase<pg8::EpiRes, pg8::StaticOrder, false, true>(F.lds, g, S, E);
        if (BOTH(10)) GRID_BAR();
    }
    if (IN(11)) { router_rows(F); if (BOTH(11)) GRID_BAR(); }
#define MOE_PHASES(k) { \
        const int* LIST = (const int*)(ws + WS_LIST) + (size_t)(k) * 8 * MTOK; \
        if (IN(12 + 2 * (k)) && !(KO & (32 << (k)))) { \
            pg8::Gemm g{XB, (const bf16_t*)(ws + WS_WEGU), DM, DM, (size_t)7168 * DM, LIST}; pg8::MoeOrder S; S.init(F.ctl + CW_CNT + 8 * (k), 28, G, c); \
            pg8::EpiGU<true> E{BIG, FFE, SS, LIST}; \
            pg8::gemm_phase<pg8::EpiGU<true>, pg8::MoeOrder, true, true>(F.lds, g, S, E); \
            if (BOTH(12 + 2 * (k))) GRID_BAR(); \
        } \
        if (IN(13 + 2 * (k)) && !(KO & (32 << (k)))) { \
            pg8::Gemm g{BIG, (const bf16_t*)(ws + WS_WEDN), FFE, FFE, (size_t)DM * FFE, nullptr}; pg8::MoeOrder S; S.init(F.ctl + CW_CNT + 8 * (k), 4, G, c); \
            pg8::EpiMoeDown E{F.out, LIST, (const float*)(ws + WS_GATE) + (size_t)(k) * MTOK}; \
            pg8::gemm_phase<pg8::EpiMoeDown, pg8::MoeOrder, false, true>(F.lds, g, S, E); \
            if (BOTH(13 + 2 * (k))) GRID_BAR(); \
        } }
    MOE_PHASES(0)
    MOE_PHASES(1)
#undef MOE_PHASES
    if (IN(16)) { final_norm(F); }
#undef IN
#undef BOTH
}


#ifndef DBG
#define DBG 0
#endif
#if DBG
constexpr int CW_CHK = 512;
constexpr size_t WS_DBG = WS_END;
__device__ __forceinline__ void chk_max(unsigned* ctl, int id, float e) { if (!(e >= 0.f)) e = 1e30f; atomicMax(ctl + CW_CHK + id, __float_as_uint(e)); }
__device__ __forceinline__ float relerr(float got, float exp_, float scale = 1.0f) { return fabsf(got - exp_) / (fabsf(exp_) + 0.5f * scale); }
__device__ __forceinline__ int dbg_row(int i) { const int rows[8] = {0, 255, 256, 1000, 2047, 2048 + 77, 16 * 2048 - 1, 20000}; return rows[i & 7]; }
__device__ float block_sum(float v, float* red) {
    v = wave_sum(v); __syncthreads(); if ((threadIdx.x & 63) == 0) red[threadIdx.x >> 6] = v; __syncthreads();
    float s = 0.f; for (int w = 0; w < 8; ++w) s += red[w]; __syncthreads(); return s;
}
__global__ void __launch_bounds__(512) dbg_check(Args args, int which) {
    __shared__ float hv[3584]; __shared__ float raw[2880]; __shared__ float red[8];
    const float* const* in = args.in; unsigned char* ws = args.ws; unsigned* ctl = (unsigned*)(ws + WS_CTL);
    const int tid = threadIdx.x; const int r = dbg_row(blockIdx.x), t = r & (SEQ - 1);
    const bf16_t* BIG = (const bf16_t*)(ws + WS_BIG); const bf16_t* XB = (const bf16_t*)(ws + WS_XB); const float* SS = (const float*)(ws + WS_SS);
    float* SCR = (float*)(ws + WS_DBG) + (size_t)blockIdx.x * 1024;
    float emax = 0.f;
    if (which == 1) {
        float ssq = 0.f; for (int k = tid; k < DM; k += 512) { const float x = in[I_X][(size_t)r * DM + k]; ssq += x * x; }
        const float rs = rsqrtf(block_sum(ssq, red) / DM + EPS);
        for (int k = tid; k < DM; k += 512) hv[k] = in[I_X][(size_t)r * DM + k] * rs * in[I_LN_MIX_E][k];
        __syncthreads();
        for (int n = tid; n < N0SRC; n += 512) { float a = 0.f; for (int k = 0; k < DM; ++k) a += hv[k] * in[I_W_IN_E][(size_t)k * N0SRC + n]; raw[n] = a; }
        __syncthreads();
        const bf16_t* q = BIG + (size_t)r * N0;
        float e1 = 0.f, e2 = 0.f, e3 = 0.f;
        for (int i = tid; i < 512; i += 512) { e1 = fmaxf(e1, relerr(bf1(q[C0_FQ + i]), raw[i] * C2, C2)); e2 = fmaxf(e2, relerr(bf1(q[C0_FK + i]), raw[512 + i])); e3 = fmaxf(e3, relerr(bf1(q[C0_FV + i]), raw[1024 + i])); }
        chk_max(ctl, 21, wave_max(e1)); chk_max(ctl, 22, wave_max(e2)); chk_max(ctl, 23, wave_max(e3));
        float e4 = 0.f; for (int i = tid; i < 128; i += 512) e4 = fmaxf(e4, relerr(bf1(q[C0_DV + i]), raw[2184 + i]));
        chk_max(ctl, 24, wave_max(e4));
        const int sb[4] = {1544, 2056, 2312, 2568}, nh[4] = {8, 2, 4, 1}, db[4] = {C0_DQ, C0_DK, C0_IQ, C0_IK}; const float scl[4] = {C2, 1.f, 0.125f, 1.f};
        for (int sg = 0; sg < 4; ++sg) { float e = 0.f; for (int i = tid; i < nh[sg] * 32; i += 512) { const int hh = i >> 5, p = i & 31;
            const float inv = powf(10000.0f, -(float)p * 2.0f / 64.0f), ang = (float)t * inv, cs = cosf(ang), sn = sinf(ang);
            const float x1 = raw[sb[sg] + hh * 64 + p], x2 = raw[sb[sg] + hh * 64 + 32 + p];
            e = fmaxf(e, relerr(bf1(q[db[sg] + hh * 64 + 2 * p]), (x1 * cs - x2 * sn) * scl[sg], scl[sg])); e = fmaxf(e, relerr(bf1(q[db[sg] + hh * 64 + 2 * p + 1]), (x2 * cs + x1 * sn) * scl[sg], scl[sg])); }
            chk_max(ctl, 25 + sg, wave_max(e)); }
        float e9 = 0.f, e10 = 0.f;
        if (tid < 8) { const float x = raw[1536 + tid] + in[I_B_FOX][tid]; const float lf = fminf(x, 0.f) - log1pf(expf(-fabsf(x))); e9 = relerr(((const float*)(ws + WS_LOGF))[(size_t)r * 8 + tid], lf); }
        if (tid < 4) e10 = relerr(((const float*)(ws + WS_IW))[(size_t)r * 4 + tid], raw[2632 + tid] * 0.5f);
        float ea = 0.f, eb = 0.f, ec = 0.f;
        if (tid < 8) { ea = relerr(bf1(q[C0_FF + tid]), raw[1536 + tid]); const float x = raw[1536 + tid]; const float lf = fminf(x, 0.f) - log1pf(expf(-fabsf(x))); eb = relerr(((const float*)(ws + WS_LOGF))[(size_t)r * 8 + tid], lf); ec = e9; }
        chk_max(ctl, 1, wave_max(ea)); chk_max(ctl, 2, wave_max(eb)); chk_max(ctl, 3, wave_max(ec)); chk_max(ctl, 4, wave_max(e10));
    } else if (which == 2) {
        const float* LOGF = (const float*)(ws + WS_LOGF); const float* CB = (const float*)(ws + WS_CB); const u64* MASKT = (const u64*)(ws + WS_XB);
        const int gid = blockIdx.x * 512 + tid;
        if (gid < 128) { const int b = gid >> 3, h = gid & 7; float c = 0.f; for (int s2 = 0; s2 < SEQ; ++s2) { c += LOGF[((size_t)b * SEQ + s2) * 8 + h]; emax = fmaxf(emax, fabsf(CB[(size_t)gid * SEQ + s2] - c) / (fabsf(c) * 1e-3f + 0.01f)); } }
        chk_max(ctl, 2, wave_max(emax));
        float e3 = 0.f;
        for (int rr = gid; rr < MTOK; rr += 8 * 512) { const int b = rr >> 11, tt = rr & 2047; int pc = 0; bool bad = false;
            for (int i = 0; i < 32; ++i) { const u64 w = MASKT[((size_t)b * 32 + i) * SEQ + tt]; pc += __popcll(w);
                const int lo = i * 64; if (lo > tt) { if (w) bad = true; } else if (tt - lo < 63) { if (w >> (tt - lo + 1)) bad = true; } }
            const int want = (tt + 1 < 256) ? tt + 1 : 256; if (pc != want || bad) e3 = 1.f; }
        chk_max(ctl, 3, wave_max(e3));
    } else if (which == 4) {
        for (int k = tid; k < DM; k += 512) hv[k] = bf1(BIG[(size_t)r * N0 + k]);
        __syncthreads();
        float ssq = 0.f;
        for (int n = tid; n < DM; n += 512) { float a = in[I_X][(size_t)r * DM + n]; for (int k = 0; k < DM; ++k) a += hv[k] * in[I_W_OUT_E][(size_t)k * DM + n];
            emax = fmaxf(emax, relerr(args.out[(size_t)r * DM + n], a)); emax = fmaxf(emax, relerr(bf1(XB[(size_t)r * DM + n]), a)); ssq += a * a; }
        ssq = block_sum(ssq, red); float s16 = 0.f; for (int i = 0; i < 16; ++i) s16 += SS[(size_t)r * 16 + i];
        emax = fmaxf(emax, fabsf(s16 - ssq) / ssq * 10.f);
        chk_max(ctl, 4, wave_max(emax));
    } else if (which == 5) {
        float ssq = 0.f; for (int k = tid; k < DM; k += 512) { const float x = args.out[(size_t)r * DM + k]; ssq += x * x; }
        const float rs = rsqrtf(block_sum(ssq, red) / DM + EPS);
        for (int k = tid; k < DM; k += 512) hv[k] = args.out[(size_t)r * DM + k] * rs * in[I_LN_FFN_E][k];
        __syncthreads();
        for (int n = tid; n < FF; n += 512) { float g = 0.f, u = 0.f; for (int k = 0; k < DM; ++k) { g += hv[k] * in[I_W_GATE][(size_t)k * FF + n]; u += hv[k] * in[I_W_UP][(size_t)k * FF + n]; }
            const float h = g / (1.f + expf(-g)) * u; emax = fmaxf(emax, relerr(bf1(BIG[(size_t)r * FF + n]), h)); }
        __syncthreads();
        for (int k = tid; k < FF; k += 512) hv[k] = bf1(BIG[(size_t)r * FF + k]);
        __syncthreads();
        for (int n = tid; n < DM; n += 512) { float a = args.out[(size_t)r * DM + n]; for (int k = 0; k < FF; ++k) a += hv[k] * in[I_W_DOWN][(size_t)k * DM + n]; SCR[n] = a; }
        chk_max(ctl, 5, wave_max(emax));
    } else if (which == 6) {
        for (int n = tid; n < DM; n += 512) emax = fmaxf(emax, relerr(args.out[(size_t)r * DM + n], SCR[n]));
        chk_max(ctl, 6, wave_max(emax));
    }
}
__global__ void __launch_bounds__(512) dbg_encode(Args args, int nchk, int total) {
    const unsigned* ctl = (const unsigned*)(args.ws + WS_CTL);
    int idx = 0, mag = 0;
    for (int i = 1; i <= nchk; ++i) { const float e = __uint_as_float(ctl[CW_CHK + i]); if (e > 0.06f) { idx = i; mag = 0; float th = 1.0f; while (mag < 9 && e < th) { th *= 0.5f; ++mag; } break; } }
    const float s = sqrtf((float)(10 * idx + mag));
    for (int i = blockIdx.x * 512 + threadIdx.x; i < total; i += gridDim.x * 512) args.out[i] = s;
}
#endif
extern "C" void kernel_launch(void* const* d_in, const int* in_sizes, int n_in, void* d_out, int out_size, void* d_ws, size_t ws_size, hipStream_t stream) {
    static int grid = 0;
    if (grid == 0) {
        if (n_in != 22 || in_sizes[0] != MTOK * DM || out_size != MTOK * DM || ws_size < WS_END) { fprintf(stderr, "kernel_launch: unexpected shapes / workspace (%zu < %zu)\n", ws_size, (size_t)WS_END); grid = -1; return; }
        int dev = 0, cus = 0, per_cu = 0;
        if (hipGetDevice(&dev) != hipSuccess || hipDeviceGetAttribute(&cus, hipDeviceAttributeMultiprocessorCount, dev) != hipSuccess) { grid = -1; return; }
        if (hipFuncSetAttribute((const void*)trunk_fwd, hipFuncAttributeMaxDynamicSharedMemorySize, LDS_BYTES) != hipSuccess) { grid = -1; return; }
        if (hipOccupancyMaxActiveBlocksPerMultiprocessor(&per_cu, (const void*)trunk_fwd, NTHR, LDS_BYTES) != hipSuccess || per_cu < 1) { fprintf(stderr, "kernel_launch: occupancy query says %d\n", per_cu); }
        (void)hipGetLastError();
        grid = cus;
    }
    if (grid < 0) return;
    if (hipMemsetAsync((char*)d_ws + WS_CTL, 0, CTL_ZERO_BYTES, stream) != hipSuccess) return;
    Args a{};
    for (int i = 0; i < 22; ++i) a.in[i] = (const float*)d_in[i];
    a.out = (float*)d_out; a.ws = (unsigned char*)d_ws; a.pad = 0;
#if MK_PER_PHASE
    for (int p = 0; p < NPH; ++p) { a.ph_lo = p; a.ph_hi = p + 1; a.li = p; hipLaunchKernelGGL(trunk_fwd, dim3(grid), dim3(NTHR), LDS_BYTES, stream, a);
#if DBG
        if (p == 1 || p == 2 || p == 4 || p == 5 || p == 6) hipLaunchKernelGGL(dbg_check, dim3(8), dim3(512), 0, stream, a, p);
        if (p == DBG_LAST) { hipLaunchKernelGGL(dbg_encode, dim3(1024), dim3(512), 0, stream, a, 9, MTOK * DM); break; }
#endif
    }
#else
    a.ph_lo = 0; a.ph_hi = NPH; a.li = 0;
    hipLaunchKernelGGL(trunk_fwd, dim3(grid), dim3(NTHR), LDS_BYTES, stream, a);
#endif
}
```

```cpp
#include <hip/hip_runtime.h>
#include <hip/hip_bf16.h>
#include <cstdio>
#include <cstdint>

#ifndef MK_PER_PHASE
#define MK_PER_PHASE 0
#endif
#ifndef KO
#define KO 0
#endif
#define DBG 0
#define DBG_LAST 1
#ifndef FAST_ATTN
#define FAST_ATTN 0
#endif

#define LAS __attribute__((address_space(3)))
#define GAS __attribute__((address_space(1)))
typedef unsigned short bf16_t;
typedef short bf16x8 __attribute__((ext_vector_type(8)));
typedef float f32x4 __attribute__((ext_vector_type(4)));
typedef float f32x2 __attribute__((ext_vector_type(2)));
typedef unsigned u32x4 __attribute__((ext_vector_type(4)));
typedef unsigned u32x2 __attribute__((ext_vector_type(2)));
typedef unsigned long long u64;

constexpr int NB = 16, SEQ = 2048, DM = 1024, MTOK = NB * SEQ;
constexpr int N0 = 2816;
constexpr int N0SRC = 2636, N1 = 3584, FF = 2816, FFE = 3584, NEXP = 8;
constexpr float EPS = 1e-6f;
constexpr float LOG2E = 1.4426950408889634f;
constexpr float C2 = 0.125f * LOG2E;
constexpr int C0_FQ = 0, C0_DQ = 512, C0_FK = 1024, C0_FV = 1536, C0_DK = 2048, C0_DV = 2176, C0_IQ = 2304, C0_IK = 2560, C0_FF = 2624, C0_IW = 2632;
constexpr int C1_HQ = 0, C1_Q = 512, C1_HF = 1024, C1_HI = 1536, C1_HG = 2048, C1_K = 2560, C1_V = 3072;

constexpr size_t MiB = 1u << 20;
constexpr size_t WS_CTL = 0, CTL_ZERO_BYTES = 1 * MiB;
constexpr size_t WS_ROPE = 1 * MiB;
constexpr size_t WS_IW   = WS_ROPE + 512 * 1024;
constexpr size_t WS_LOGF = 2 * MiB;
constexpr size_t WS_CB   = 3 * MiB;
constexpr size_t WS_SS   = 4 * MiB;
constexpr size_t WS_WRT  = 6 * MiB;
constexpr size_t WS_GATE = 6 * MiB + 256 * 1024;
constexpr size_t WS_LIST = 7 * MiB;
constexpr size_t WS_WIN0 = 10 * MiB;
constexpr size_t WS_WOUT0 = 16 * MiB;
constexpr size_t WS_WGU0 = 18 * MiB;
constexpr size_t WS_WDN0 = 29 * MiB;
constexpr size_t WS_WIN1 = 35 * MiB;
constexpr size_t WS_WOUT1 = 42 * MiB;
constexpr size_t WS_WEGU = 44 * MiB;
constexpr size_t WS_WEDN = 156 * MiB;
constexpr size_t WS_XB = 212 * MiB;
constexpr size_t WS_BIG = 276 * MiB;
constexpr size_t WS_END = 514 * MiB;
constexpr int MAXPANEL = 136;
static_assert(WS_BIG + (size_t)MAXPANEL * 256 * FFE * 2 <= WS_END && WS_BIG + (size_t)MTOK * N1 * 2 <= WS_END, "ws map");
constexpr int CW_TMO = 0, CW_CODE = 1;
constexpr int CW_CNT = 64;
constexpr int CW_BAR = 4096;

constexpr int RING_BYTES = 135168;
constexpr int LDSCTL_OFF = RING_BYTES, MISC_OFF = LDSCTL_OFF + 320;
constexpr int LDS_BYTES = 147456;
constexpr int NWAVES = 8, NTHR = 512;

#define RLX_AGENT __ATOMIC_RELAXED, __HIP_MEMORY_SCOPE_AGENT
#define LDS_WAIT() asm volatile("s_waitcnt lgkmcnt(0)" ::: "memory")
__device__ __forceinline__ unsigned cvt_pk_bf16(float lo, float hi) { unsigned r; asm volatile("v_cvt_pk_bf16_f32 %0, %1, %2" : "=v"(r) : "v"(lo), "v"(hi)); return r; }
__device__ __forceinline__ float bf_lo(unsigned u) { return __uint_as_float(u << 16); }
__device__ __forceinline__ float bf_hi(unsigned u) { return __uint_as_float(u & 0xffff0000u); }
__device__ __forceinline__ float bf1(bf16_t u) { return __uint_as_float(((unsigned)u) << 16); }
__device__ __forceinline__ float wave_sum(float v) {
#pragma unroll
    for (int o = 1; o < 64; o <<= 1) v += __shfl_xor(v, o);
    return v;
}
__device__ __forceinline__ float wave_max(float v) {
#pragma unroll
    for (int o = 1; o < 64; o <<= 1) v = fmaxf(v, __shfl_xor(v, o));
    return v;
}
__device__ __forceinline__ float sigmoidf_(float x) { return 1.0f / (1.0f + __expf(-x)); }
__device__ __forceinline__ float siluf_(float x) { return x / (1.0f + __expf(-x)); }

namespace pg8 {
constexpr int BM = 256, BK = 64, HALF = 128, HTB = HALF * BK * 2, STAGE_BYTES = 8 * HTB, NXCD = 8, WGM = 8;
__host__ __device__ __forceinline__ int lds_byte(int r, int c) { const int st = (r >> 4) * 2 + (c >> 5), rr = r & 15, cc = c & 31, ob = rr * 64 + cc * 2; return st * 1024 + (ob ^ (((ob >> 9) & 1) << 5)); }
__host__ __device__ __forceinline__ void stage_rc(int b, int& R, int& C) { const int st = b / 1024, sb = b % 1024, swz = sb ^ (((sb >> 9) & 1) << 5); R = (st >> 1) * 16 + swz / 64; C = (st & 1) * 32 + (swz % 64) / 2; }
__host__ __device__ __forceinline__ int perm32(int rho) { const int n = rho >> 4, i = rho & 15; return 8 * (i >> 2) + 4 * n + (i & 3); }

struct Unit { int pm, pn, e, nvalid, lbase; };
struct Gemm { const bf16_t* A; const bf16_t* Bt; int lda; int K; size_t bstride_e; const int* list; };

__device__ __forceinline__ void swz_order(int L, int nM, int nN, int& pm, int& pn) {
    const int nwg = nM * nN; int wgid = L;
    { const int q = nwg / NXCD, r = nwg % NXCD, xcd = wgid % NXCD, off = wgid / NXCD; wgid = (xcd < r ? xcd * (q + 1) : r * (q + 1) + (xcd - r) * q) + off; }
    const int nig = WGM * nN, gid = wgid / nig, fm = gid * WGM, gsz = (nM - fm) < WGM ? (nM - fm) : WGM;
    pm = fm + ((wgid % nig) % gsz); pn = (wgid % nig) / gsz;
}
struct StaticOrder {
    int nM, nN, nwg, G, c;
    __device__ __forceinline__ void init(int M, int N, int G_, int c_) { nM = M / BM; nN = N / BM; nwg = nM * nN; G = G_; c = c_; }
    __device__ __forceinline__ bool next(int i, Unit& u) const {
        const long L = (long)i * G + c; if (L >= nwg) return false;
        swz_order((int)L, nM, nN, u.pm, u.pn); u.e = 0; u.nvalid = BM; u.lbase = 0; return true;
    }
};
struct MoeOrder {
    int nN, NP, G, c; int c0, c1, c2, c3, c4, c5, c6, c7;
    __device__ __forceinline__ void init(const unsigned* cntp, int nN_, int G_, int c_) {
        nN = nN_; G = G_; c = c_;
        c0 = (int)cntp[0]; c1 = (int)cntp[1]; c2 = (int)cntp[2]; c3 = (int)cntp[3]; c4 = (int)cntp[4]; c5 = (int)cntp[5]; c6 = (int)cntp[6]; c7 = (int)cntp[7];
        NP = ((c0 + 255) >> 8) + ((c1 + 255) >> 8) + ((c2 + 255) >> 8) + ((c3 + 255) >> 8) + ((c4 + 255) >> 8) + ((c5 + 255) >> 8) + ((c6 + 255) >> 8) + ((c7 + 255) >> 8);
        if (NP > MAXPANEL) NP = MAXPANEL;
    }
    __device__ __forceinline__ bool next(int i, Unit& u) const {
        const long L = (long)i * G + c; if (L >= (long)NP * nN) return false;
        int pm, pn; swz_order((int)L, NP, nN, pm, pn);
        int e = 0, ps = 0, ce = c0;
#define MOE_STEP(CN, CNEXT, EI) { const int np = ((CN) + 255) >> 8; if (e == (EI) - 1 && pm >= ps + np) { ps += np; e = (EI); ce = (CNEXT); } }
        MOE_STEP(c0, c1, 1) MOE_STEP(c1, c2, 2) MOE_STEP(c2, c3, 3) MOE_STEP(c3, c4, 4) MOE_STEP(c4, c5, 5) MOE_STEP(c5, c6, 6) MOE_STEP(c6, c7, 7)
#undef MOE_STEP
        const int local = pm - ps; int nv = ce - local * 256; nv = nv > 256 ? 256 : nv; nv = nv < 1 ? 1 : nv;
        u.pm = pm; u.pn = pn; u.e = e; u.nvalid = nv; u.lbase = e * MTOK + local * 256; return true;
    }
};

__device__ __forceinline__ float row_rstd(const float* SS, int row, int fq) {
    const f32x4 p = *(const f32x4*)(SS + (size_t)row * 16 + 4 * fq);
    float s = (p[0] + p[1]) + (p[2] + p[3]); s += __shfl_xor(s, 16); s += __shfl_xor(s, 32);
    return rsqrtf(s * (1.0f / DM) + EPS);
}

struct EpiIn {
    static constexpr bool PERM = true;
    bf16_t* O; int ldc; const float* SS; const float* rope; float* LOGF; float* IW; const float* bfox; int layer;
    __device__ __forceinline__ int kind_of(int g64) const {
        if (layer == 0) { if (g64 < 8) return 1; if (g64 < 16) return 3; if (g64 < 32) return 0; if (g64 < 34) return 2; if (g64 < 36) return 0; if (g64 < 40) return 4; if (g64 == 40) return 2; if (g64 == 41) return 5; return 0; }
        if (g64 >= 8 && g64 < 16) return 3; if (g64 >= 40 && g64 < 48) return 2; return 0;
    }
    __device__ __forceinline__ void operator()(const f32x4 (&acc)[2][2][4][2], const Unit& u, int wr, int wc, int fr, int fq) const {
        const int row0 = u.pm * BM + wr * 64 + fr;
        int kind[2]; int colb[2];
#pragma unroll
        for (int bj = 0; bj < 2; ++bj) { colb[bj] = u.pn * BM + bj * HALF + wc * 32; kind[bj] = kind_of(colb[bj] >> 6); }
        const bool anyrope = (kind[0] >= 2 && kind[0] <= 4) || (kind[1] >= 2 && kind[1] <= 4);
        const int i0 = (((wc & 1) * 32) + 8 * fq) >> 1;
#pragma unroll
        for (int ai = 0; ai < 2; ++ai)
#pragma unroll
            for (int m = 0; m < 4; ++m) {
                const int row = row0 + ai * HALF + m * 16;
                const float rs = row_rstd(SS, row, fq);
                f32x4 cs0 = (f32x4){1.f, 0.f, 1.f, 0.f}, cs1 = cs0;
                if (anyrope) { const float* rp = rope + ((size_t)(row & (SEQ - 1)) * 32 + i0) * 2; cs0 = *(const f32x4*)rp; cs1 = *(const f32x4*)(rp + 4); }
#pragma unroll
                for (int bj = 0; bj < 2; ++bj) {
                    f32x4 v0 = acc[ai][bj][m][0] * rs, v1 = acc[ai][bj][m][1] * rs;
                    const int kd = kind[bj];
                    if (kd >= 2 && kd <= 4) {
                        f32x4 a, b;
                        a[0] = v0[0] * cs0[0] - v0[1] * cs0[1]; a[1] = v0[1] * cs0[0] + v0[0] * cs0[1];
                        a[2] = v0[2] * cs0[2] - v0[3] * cs0[3]; a[3] = v0[3] * cs0[2] + v0[2] * cs0[3];
                        b[0] = v1[0] * cs1[0] - v1[1] * cs1[1]; b[1] = v1[1] * cs1[0] + v1[0] * cs1[1];
                        b[2] = v1[2] * cs1[2] - v1[3] * cs1[3]; b[3] = v1[3] * cs1[2] + v1[2] * cs1[3];
                        v0 = a; v1 = b;
                    }
                    const float sc = (kd == 1 || kd == 3) ? C2 : (kd == 4 ? 0.125f : 1.0f);
                    if (kd == 5 && (wc & 1) == 0) {
                        if (fq == 0) { f32x4 l0, l1;
#pragma unroll
                            for (int j = 0; j < 4; ++j) { const float x0 = v0[j] + bfox[j], x1 = v1[j] + bfox[4 + j];
                                l0[j] = fminf(x0, 0.f) - log1pf(__expf(-fabsf(x0))); l1[j] = fminf(x1, 0.f) - log1pf(__expf(-fabsf(x1))); }
                            *(f32x4*)(LOGF + (size_t)row * 8) = l0; *(f32x4*)(LOGF + (size_t)row * 8 + 4) = l1; }
                        if (fq == 1) { *(f32x4*)(IW + (size_t)row * 4) = v0 * 0.5f; }
                    }
                    v0 = v0 * sc; v1 = v1 * sc;
                    u32x4 w; w.x = cvt_pk_bf16(v0[0], v0[1]); w.y = cvt_pk_bf16(v0[2], v0[3]); w.z = cvt_pk_bf16(v1[0], v1[1]); w.w = cvt_pk_bf16(v1[2], v1[3]);
                    *(u32x4*)(O + (size_t)row * ldc + colb[bj] + 8 * fq) = w;
                }
            }
    }
};
struct EpiRes {
    static constexpr bool PERM = false;
    const float* base; float* out; bf16_t* xb; float* SS;
    __device__ __forceinline__ void operator()(const f32x4 (&acc)[2][2][4][2], const Unit& u, int wr, int wc, int fr, int fq) const {
        const int col0 = u.pn * BM + wc * 32 + 4 * fq;
#pragma unroll
        for (int ai = 0; ai < 2; ++ai)
#pragma unroll
            for (int m = 0; m < 4; ++m) {
                const int row = u.pm * BM + ai * HALF + wr * 64 + m * 16 + fr; float ssq = 0.f;
#pragma unroll
                for (int bj = 0; bj < 2; ++bj)
#pragma unroll
                    for (int n = 0; n < 2; ++n) {
                        const size_t off = (size_t)row * DM + col0 + bj * HALF + n * 16;
                        const f32x4 o = *(const f32x4*)(base + off) + acc[ai][bj][m][n];
                        *(f32x4*)(out + off) = o; ssq += (o[0] * o[0] + o[1] * o[1]) + (o[2] * o[2] + o[3] * o[3]);
                        u32x2 w; w.x = cvt_pk_bf16(o[0], o[1]); w.y = cvt_pk_bf16(o[2], o[3]); *(u32x2*)(xb + off) = w;
                    }
                ssq += __shfl_xor(ssq, 16); ssq += __shfl_xor(ssq, 32);
                if (fq == 0) SS[(size_t)row * 16 + u.pn * 4 + wc] = ssq;
            }
    }
};
template <bool MOE> struct EpiGU {
    static constexpr bool PERM = true;
    bf16_t* H; int ldh; const float* SS; const int* list;
    __device__ __forceinline__ void operator()(const f32x4 (&acc)[2][2][4][2], const Unit& u, int wr, int wc, int fr, int fq) const {
        const int hcol = u.pn * HALF + wc * 32 + 8 * fq;
#pragma unroll
        for (int ai = 0; ai < 2; ++ai)
#pragma unroll
            for (int m = 0; m < 4; ++m) {
                const int rl = ai * HALF + wr * 64 + m * 16 + fr;
                int tok = u.pm * BM + rl;
                if (MOE) { const int rc = rl < u.nvalid ? rl : u.nvalid - 1; tok = list[u.lbase + rc]; }
                const float rs = row_rstd(SS, tok, fq);
                unsigned w[4];
#pragma unroll
                for (int n = 0; n < 2; ++n) { float h[4];
#pragma unroll
                    for (int j = 0; j < 4; ++j) { const float g = acc[ai][0][m][n][j] * rs, uu = acc[ai][1][m][n][j] * rs; h[j] = siluf_(g) * uu; }
                    w[2 * n] = cvt_pk_bf16(h[0], h[1]); w[2 * n + 1] = cvt_pk_bf16(h[2], h[3]); }
                *(u32x4*)(H + (size_t)(u.pm * BM + rl) * ldh + hcol) = (u32x4){w[0], w[1], w[2], w[3]};
            }
    }
};
struct EpiMoeDown {
    static constexpr bool PERM = false;
    float* x; const int* list; const float* gate;
    __device__ __forceinline__ void operator()(const f32x4 (&acc)[2][2][4][2], const Unit& u, int wr, int wc, int fr, int fq) const {
        const int col0 = u.pn * BM + wc * 32 + 4 * fq;
#pragma unroll
        for (int ai = 0; ai < 2; ++ai)
#pragma unroll
            for (int m = 0; m < 4; ++m) {
                const int rl = ai * HALF + wr * 64 + m * 16 + fr;
                if (rl < u.nvalid) {
                    const int tok = list[u.lbase + rl]; const float g = gate[tok];
#pragma unroll
                    for (int bj = 0; bj < 2; ++bj)
#pragma unroll
                        for (int n = 0; n < 2; ++n) { float* p = x + (size_t)tok * DM + col0 + bj * HALF + n * 16; *(f32x4*)p = *(const f32x4*)p + acc[ai][bj][m][n] * g; }
                }
            }
    }
};

template <bool GATHER> __device__ __forceinline__ void a_offsets(const Gemm& g, const Unit& u, const int (&R)[2], const int (&C)[2], unsigned (&ao)[2][2]) {
#pragma unroll
    for (int h = 0; h < 2; ++h)
#pragma unroll
        for (int i = 0; i < 2; ++i) { const int rl = h * HALF + R[i]; size_t row;
            if (GATHER) { const int rc = rl < u.nvalid ? rl : u.nvalid - 1; row = (size_t)g.list[u.lbase + rc]; } else row = (size_t)u.pm * BM + rl;
            ao[h][i] = (unsigned)((row * (size_t)g.lda + C[i]) * 2); }
}

template <class Epi, class Sched, bool GATHER, bool ALIGN_EPI>
__device__ __forceinline__ void gemm_phase(LAS unsigned char* lds, const Gemm g, const Sched& S, const Epi& E) {
    const int tid = threadIdx.x, wid = __builtin_amdgcn_readfirstlane(tid >> 6), lane = tid & 63, wr = wid >> 2, wc = wid & 3, fr = lane & 15, fq = lane >> 4;
    const int K = g.K, nt = K / BK;
    int RR[2], CC[2]; unsigned voffB[2];
#pragma unroll
    for (int i = 0; i < 2; ++i) { int R, C; stage_rc(tid * 16 + i * 8192, R, C); RR[i] = R; CC[i] = C; const int Rb = Epi::PERM ? ((R & ~31) + perm32(R & 31)) : R; voffB[i] = (unsigned)(Rb * K + C) * 2u; }
    const size_t kstep = (size_t)(BK * 2);
    const size_t hstepB = (size_t)HALF * K * 2;
    const size_t tstepB = 2 * hstepB;
    const unsigned ldsw = (unsigned)wid * 1024u;
    const int aoff = lds_byte(wr * 64 + fr, fq * 8), boff = lds_byte(wc * 32 + fr, fq * 8);
#define PG8_SA(b, h) (((b) * 2 + (h)) * HTB)
#define PG8_SB(b, h) ((4 + (b) * 2 + (h)) * HTB)
#define PG8_STAGE_B(bufoff, gbase) do { _Pragma("unroll") for (int _i = 0; _i < 2; ++_i) \
        __builtin_amdgcn_global_load_lds((const unsigned*)((const char*)(gbase) + voffB[_i]), (LAS unsigned*)(lds + (bufoff) + ldsw + _i * 8192), 16, 0, 0); } while (0)
#define PG8_STAGE_A(bufoff, kb, AO) do { _Pragma("unroll") for (int _i = 0; _i < 2; ++_i) \
        __builtin_amdgcn_global_load_lds((const unsigned*)(Ab + (kb) + (AO)[_i]), (LAS unsigned*)(lds + (bufoff) + ldsw + _i * 8192), 16, 0, 0); } while (0)
#define PG8_LDA(dst, b, h) do { _Pragma("unroll") for (int m = 0; m < 4; ++m) _Pragma("unroll") for (int k = 0; k < 2; ++k) dst[m][k] = *(const LAS bf16x8*)(lds + PG8_SA(b, h) + aoff + m * 2048 + k * 1024); } while (0)
#define PG8_LDB(dst, b, h) do { _Pragma("unroll") for (int n = 0; n < 2; ++n) _Pragma("unroll") for (int k = 0; k < 2; ++k) dst[n][k] = *(const LAS bf16x8*)(lds + PG8_SB(b, h) + boff + n * 2048 + k * 1024); } while (0)
#define PG8_MMA(ai, bj, At, Bt) do { __builtin_amdgcn_s_setprio(1); _Pragma("unroll") for (int m = 0; m < 4; ++m) _Pragma("unroll") for (int n = 0; n < 2; ++n) _Pragma("unroll") for (int k = 0; k < 2; ++k) \
        acc[ai][bj][m][n] = __builtin_amdgcn_mfma_f32_16x16x32_bf16(Bt[n][k], At[m][k], acc[ai][bj][m][n], 0, 0, 0); __builtin_amdgcn_s_setprio(0); } while (0)
#define PG8_WAIT_V(n) asm volatile("s_waitcnt vmcnt(" #n ")" ::: "memory")
#define PG8_WAIT_L(n) asm volatile("s_waitcnt lgkmcnt(" #n ")" ::: "memory")
#define PG8_BAR __builtin_amdgcn_s_barrier()
#define PG8_SCHED __builtin_amdgcn_sched_barrier(0)
    Unit cur, nxt; int ui = 0;
    if (!S.next(0, cur)) return;
    f32x4 acc[2][2][4][2];
#pragma unroll
    for (int a = 0; a < 2; ++a)
#pragma unroll
        for (int b = 0; b < 2; ++b)
#pragma unroll
            for (int m = 0; m < 4; ++m)
#pragma unroll
                for (int n = 0; n < 2; ++n) acc[a][b][m][n] = (f32x4){0.f, 0.f, 0.f, 0.f};
    bf16x8 At[4][2], B0[2][2], B1[2][2];
    unsigned cao[2][2], nao[2][2];
    a_offsets<GATHER>(g, cur, RR, CC, cao);
    const char* Ab = (const char*)g.A;
    const char* cB = (const char*)g.Bt + ((size_t)cur.e * g.bstride_e) * 2 + (size_t)cur.pn * tstepB;
    PG8_STAGE_B(PG8_SB(0, 0), cB); PG8_STAGE_B(PG8_SB(0, 1), cB + hstepB); PG8_STAGE_A(PG8_SA(0, 0), 0, cao[0]); PG8_STAGE_A(PG8_SA(0, 1), 0, cao[1]);
    if (wr == 1) PG8_BAR;
    PG8_WAIT_V(2); PG8_BAR;
    PG8_STAGE_B(PG8_SB(1, 0), cB + kstep); PG8_STAGE_A(PG8_SA(1, 0), kstep, cao[0]); PG8_STAGE_B(PG8_SB(1, 1), cB + hstepB + kstep);
    PG8_WAIT_V(6); PG8_BAR;
    for (;;) {
        const bool has_next = S.next(ui + 1, nxt);
        if (has_next) a_offsets<GATHER>(g, nxt, RR, CC, nao);
        else {
#pragma unroll
            for (int h = 0; h < 2; ++h)
#pragma unroll
                for (int i = 0; i < 2; ++i) nao[h][i] = cao[h][i]; }
        const char* nB = has_next ? (const char*)g.Bt + ((size_t)nxt.e * g.bstride_e) * 2 + (size_t)nxt.pn * tstepB : cB;
        for (int t = 0; t < nt; t += 2) {
            const bool last = (t == nt - 2);
            const size_t ka1 = (size_t)(t + 1) * kstep;
            const size_t ka2 = last ? 0 : (size_t)(t + 2) * kstep; const char* b2 = last ? nB : cB + (size_t)(t + 2) * kstep;
            const size_t ka3 = ka2 + kstep; const char* b3 = b2 + kstep;
            unsigned ao2[2][2];
#pragma unroll
            for (int h = 0; h < 2; ++h)
#pragma unroll
                for (int i = 0; i < 2; ++i) ao2[h][i] = last ? nao[h][i] : cao[h][i];
            PG8_LDB(B0, 0, 0); PG8_LDB(B1, 0, 1); PG8_SCHED; PG8_LDA(At, 0, 0); PG8_STAGE_A(PG8_SA(1, 1), ka1, cao[1]);
            PG8_WAIT_V(8); PG8_WAIT_L(0); PG8_BAR; PG8_MMA(0, 0, At, B0); PG8_MMA(0, 1, At, B1); PG8_BAR; PG8_SCHED;
            PG8_LDA(At, 0, 1); PG8_STAGE_B(PG8_SB(0, 0), b2); PG8_STAGE_B(PG8_SB(0, 1), b2 + hstepB); PG8_STAGE_A(PG8_SA(0, 0), ka2, ao2[0]);
            PG8_WAIT_V(8); PG8_WAIT_L(0); PG8_BAR; PG8_MMA(1, 0, At, B0); PG8_MMA(1, 1, At, B1); PG8_BAR; PG8_SCHED;
            PG8_LDB(B0, 1, 0); PG8_LDB(B1, 1, 1); PG8_SCHED; PG8_LDA(At, 1, 0); PG8_STAGE_A(PG8_SA(0, 1), ka2, ao2[1]);
            PG8_WAIT_V(8); PG8_WAIT_L(0); PG8_BAR; PG8_MMA(0, 0, At, B0); PG8_MMA(0, 1, At, B1); PG8_BAR; PG8_SCHED;
            PG8_LDA(At, 1, 1); PG8_STAGE_B(PG8_SB(1, 0), b3); PG8_STAGE_B(PG8_SB(1, 1), b3 + hstepB); PG8_STAGE_A(PG8_SA(1, 0), ka3, ao2[0]);
            PG8_WAIT_V(8); PG8_WAIT_L(0); PG8_BAR; PG8_MMA(1, 0, At, B0); PG8_MMA(1, 1, At, B1); PG8_BAR; PG8_SCHED;
        }
        if constexpr (ALIGN_EPI) { if (wr == 0) PG8_BAR; }
        E(acc, cur, wr, wc, fr, fq);
        if (!has_next) break;
#pragma unroll
        for (int a = 0; a < 2; ++a)
#pragma unroll
            for (int b = 0; b < 2; ++b)
#pragma unroll
                for (int m = 0; m < 4; ++m)
#pragma unroll
                    for (int n = 0; n < 2; ++n) acc[a][b][m][n] = (f32x4){0.f, 0.f, 0.f, 0.f};
        cur = nxt; cB = nB; ++ui;
#pragma unroll
        for (int h = 0; h < 2; ++h)
#pragma unroll
            for (int i = 0; i < 2; ++i) cao[h][i] = nao[h][i];
        if constexpr (ALIGN_EPI) { if (wr == 1) PG8_BAR; }
    }
    PG8_WAIT_V(0);
    if constexpr (!ALIGN_EPI) { if (wr == 0) PG8_BAR; }
    PG8_BAR;
#undef PG8_SA
#undef PG8_SB
#undef PG8_STAGE_A
#undef PG8_STAGE_B
#undef PG8_LDA
#undef PG8_LDB
#undef PG8_MMA
#undef PG8_WAIT_V
#undef PG8_WAIT_L
#undef PG8_BAR
#undef PG8_SCHED
}
}

#define XB_TMO      128
#define XB_XCNT(j)  (256  + 64 * (j))
#define XB_XSUB(j)  (1280 + 64 * (j))
#define XB_XGEN(j)  (2304 + 64 * (j))
#define XB_TOP      3328
#define XB_TOPGEN   3392
#define XCD_BAR_WORDS 3456
#define XB_SPIN_CAP (1u << 18)
__device__ __forceinline__ unsigned xb_ld(unsigned* p)              { return __hip_atomic_load(p, __ATOMIC_RELAXED, __HIP_MEMORY_SCOPE_AGENT); }
__device__ __forceinline__ unsigned xb_add(unsigned* p, unsigned v) { return __hip_atomic_fetch_add(p, v, __ATOMIC_RELAXED, __HIP_MEMORY_SCOPE_AGENT); }
__device__ __forceinline__ unsigned xb_xcc_id() { return (unsigned)__builtin_amdgcn_s_getreg((3 << 11) | 20) & 0xFu; }
#define XB_SPIN(cond, bar) do { unsigned _sp = 0; while (cond) { __builtin_amdgcn_s_sleep(1); \
    if ((++_sp & 255u) == 0u) { if (xb_ld(&(bar)[XB_TMO])) break; if (_sp > XB_SPIN_CAP) { atomicAdd(&(bar)[XB_TMO], 1u); break; } } } } while (0)
struct XcdBarrier { unsigned* bar; unsigned x; volatile LAS unsigned* st; };
__device__ __forceinline__ XcdBarrier xcd_barrier_post(unsigned* bar, volatile LAS unsigned* st) {
    XcdBarrier b; b.bar = bar; b.x = xb_xcc_id(); b.st = st;
    if (threadIdx.x == 0) (void)xb_add(&bar[XB_XCNT(b.x)], 1u);
    return b;
}
__device__ __forceinline__ void xcd_barrier_complete(unsigned* bar, unsigned x, unsigned& nloc, unsigned& nx) {
    const unsigned G = gridDim.x * gridDim.y * gridDim.z;
    unsigned sum, cnt, mine, sp = 0u;
    for (;;) {
        sum = 0u; cnt = 0u; mine = 0u;
#pragma unroll
        for (unsigned j = 0; j < 16; ++j) { const unsigned c = xb_ld(&bar[XB_XCNT(j)]); sum += c; cnt += (c > 0u) ? 1u : 0u; mine = (j == x) ? c : mine; }
        if (sum == G) break;
        __builtin_amdgcn_s_sleep(1);
        if ((++sp & 255u) == 0u) { if (xb_ld(&bar[XB_TMO])) break; if (sp > XB_SPIN_CAP) { atomicAdd(&bar[XB_TMO], 1u); break; } }
    }
    nloc = mine > 0u ? mine : 1u; nx = cnt > 0u ? cnt : 1u;
}
__device__ __forceinline__ void xcd_barrier(const XcdBarrier& b) {
    asm volatile("s_waitcnt vmcnt(0)" ::: "memory");
    __syncthreads();
    if (threadIdx.x == 0) {
        unsigned* bar = b.bar;
        __builtin_amdgcn_s_waitcnt(0);
        unsigned nloc = b.st[0], nx = b.st[1];
        if (nloc == 0u) { xcd_barrier_complete(bar, b.x, nloc, nx); b.st[0] = nloc; b.st[1] = nx; }
        const unsigned old = xb_add(&bar[XB_XSUB(b.x)], 1u);
        const unsigned gen = old / nloc;
        if (old + 1u == (gen + 1u) * nloc) {
            __builtin_amdgcn_fence(__ATOMIC_RELEASE, "agent");
            asm volatile("s_waitcnt vmcnt(0)" ::: "memory");
            const unsigned og = xb_add(&bar[XB_TOP], 1u);
            const unsigned tg = og / nx;
            if (og + 1u == (tg + 1u) * nx) xb_add(&bar[XB_TOPGEN], 1u);
            else XB_SPIN(xb_ld(&bar[XB_TOPGEN]) == tg, bar);
            __builtin_amdgcn_fence(__ATOMIC_ACQUIRE, "agent");
            xb_add(&bar[XB_XGEN(b.x)], 1u);
            asm volatile("s_waitcnt vmcnt(0)" ::: "memory");
        } else {
            XB_SPIN(xb_ld(&bar[XB_XGEN(b.x)]) == gen, bar);
            __builtin_amdgcn_fence(__ATOMIC_ACQUIRE, "agent");
            asm volatile("s_waitcnt vmcnt(0)" ::: "memory");
        }
    }
    __syncthreads();
}

struct Frame {
    LAS unsigned char* lds;
    unsigned* ctl;
    int tid, lane, wave, vcu, G;
    const float* const* inp; float* out; unsigned char* ws;
};
enum { I_X = 0, I_LN_MIX_E, I_W_IN_E, I_B_FOX, I_W_OUT_E, I_LN_FFN_E, I_W_GATE, I_W_UP, I_W_DOWN, I_LN_MIX_O, I_W_IN_O, I_LB, I_HGRN_G, I_LAM, I_DIFF_G, I_W_OUT_O, I_LN_FFN_O, I_W_ROUTER, I_WE_GATE, I_WE_UP, I_WE_DOWN, I_LN_FINAL };

__device__ __forceinline__ int dim_of_pos(int p) { return (p >> 1) + 32 * (p & 1); }
__device__ __forceinline__ int srccol_in0(int j) {
    if (j < 512) return j;
    if (j < 1024) { const int o = j - 512; return 1544 + (o & ~63) + dim_of_pos(o & 63); }
    if (j < 1536) return 512 + (j - 1024);
    if (j < 2048) return 1024 + (j - 1536);
    if (j < 2176) { const int o = j - 2048; return 2056 + (o & ~63) + dim_of_pos(o & 63); }
    if (j < 2304) return 2184 + (j - 2176);
    if (j < 2560) { const int o = j - 2304; return 2312 + (o & ~63) + dim_of_pos(o & 63); }
    if (j < 2624) { const int o = j - 2560; return 2568 + dim_of_pos(o); }
    if (j < 2632) return 1536 + (j - 2624);
    if (j < 2636) return 2632 + (j - 2632);
    return -1;
}
__device__ __forceinline__ int srccol_in1(int j) {
    if (j < 512) return j;
    if (j < 1024) { const int o = j - 512; return 2048 + (o & ~63) + dim_of_pos(o & 63); }
    if (j < 1536) return 512 + (j - 1024);
    if (j < 2048) return 1024 + (j - 1536);
    if (j < 2560) return 1536 + (j - 2048);
    if (j < 3072) { const int o = j - 2560; return 2560 + (o & ~63) + dim_of_pos(o & 63); }
    return 3072 + (j - 3072);
}
__device__ __forceinline__ void p0_item(const float* W, int Nsrc, int sc, const float* gain, bf16_t* WT, int K, int n0, int k0, LAS float* scr, int lane) {
    const float gk = gain ? gain[k0 + lane] : 1.0f;
    const float* src = W + (size_t)k0 * Nsrc + (sc >= 0 ? sc : 0);
#pragma unroll 16
    for (int kk = 0; kk < 64; ++kk) { const float gkk = __shfl(gk, kk); float v = src[(size_t)kk * Nsrc] * gkk; v = (sc >= 0) ? v : 0.f; scr[kk * 65 + lane] = v; }
    LDS_WAIT(); asm volatile("" ::: "memory");
    const int c = lane & 7;
#pragma unroll
    for (int j = 0; j < 8; ++j) { const int n = (lane >> 3) + 8 * j; const LAS float* s = scr + (8 * c) * 65 + n;
        u32x4 o; o.x = cvt_pk_bf16(s[0 * 65], s[1 * 65]); o.y = cvt_pk_bf16(s[2 * 65], s[3 * 65]); o.z = cvt_pk_bf16(s[4 * 65], s[5 * 65]); o.w = cvt_pk_bf16(s[6 * 65], s[7 * 65]);
        *(u32x4*)(WT + (size_t)(n0 + n) * K + k0 + 8 * c) = o; }
    LDS_WAIT(); asm volatile("" ::: "memory");
}
__device__ __forceinline__ void p0_prologue(Frame& F) {
    LAS float* scr = (LAS float*)(F.lds + F.wave * 16640);
    const int gw = F.vcu * NWAVES + F.wave, NGW = F.G * NWAVES, lane = F.lane;
    unsigned char* ws = F.ws;
    constexpr int I0 = 16 * 44, I1 = 16 * 16, I2 = 16 * 88, I3 = 44 * 16, I4 = 16 * 56, I5 = 16 * 16, I6 = 8 * 16 * 112, I7 = 8 * 56 * 16;
    constexpr int NITEMS = I0 + I1 + I2 + I3 + I4 + I5 + I6 + I7;
    for (int it = gw; it < NITEMS; it += NGW) {
        int r = it;
        if (r < I0) { const int kb = r / 44, nb = r % 44; const int j = nb * 64 + lane; p0_item(F.inp[I_W_IN_E], N0SRC, srccol_in0(j), F.inp[I_LN_MIX_E], (bf16_t*)(ws + WS_WIN0), DM, nb * 64, kb * 64, scr, lane); continue; } r -= I0;
        if (r < I1) { const int kb = r / 16, nb = r % 16; p0_item(F.inp[I_W_OUT_E], DM, nb * 64 + lane, nullptr, (bf16_t*)(ws + WS_WOUT0), DM, nb * 64, kb * 64, scr, lane); continue; } r -= I1;
        if (r < I2) { const int kb = r / 88, nb = r % 88; const int j = nb * 64, pn = j >> 8, rr = j & 255; const float* W = (rr < 128) ? F.inp[I_W_GATE] : F.inp[I_W_UP];
            p0_item(W, FF, pn * 128 + (rr & 127) + lane, F.inp[I_LN_FFN_E], (bf16_t*)(ws + WS_WGU0), DM, j, kb * 64, scr, lane); continue; } r -= I2;
        if (r < I3) { const int kb = r / 16, nb = r % 16; p0_item(F.inp[I_W_DOWN], DM, nb * 64 + lane, nullptr, (bf16_t*)(ws + WS_WDN0), FF, nb * 64, kb * 64, scr, lane); continue; } r -= I3;
        if (r < I4) { const int kb = r / 56, nb = r % 56; const int j = nb * 64 + lane; p0_item(F.inp[I_W_IN_O], N1, srccol_in1(j), F.inp[I_LN_MIX_O], (bf16_t*)(ws + WS_WIN1), DM, nb * 64, kb * 64, scr, lane); continue; } r -= I4;
        if (r < I5) { const int kb = r / 16, nb = r % 16; p0_item(F.inp[I_W_OUT_O], DM, nb * 64 + lane, nullptr, (bf16_t*)(ws + WS_WOUT1), DM, nb * 64, kb * 64, scr, lane); continue; } r -= I5;
        if (r < I6) { const int e = r / (16 * 112), q = r % (16 * 112), kb = q / 112, nb = q % 112; const int j = nb * 64, pn = j >> 8, rr = j & 255;
            const float* W = ((rr < 128) ? F.inp[I_WE_GATE] : F.inp[I_WE_UP]) + (size_t)e * DM * FFE;
            p0_item(W, FFE, pn * 128 + (rr & 127) + lane, F.inp[I_LN_FFN_O], (bf16_t*)(ws + WS_WEGU) + (size_t)e * 7168 * DM, DM, j, kb * 64, scr, lane); continue; } r -= I6;
        { const int e = r / (56 * 16), q = r % (56 * 16), kb = q / 16, nb = q % 16;
            p0_item(F.inp[I_WE_DOWN] + (size_t)e * FFE * DM, DM, nb * 64 + lane, nullptr, (bf16_t*)(ws + WS_WEDN) + (size_t)e * DM * FFE, FFE, nb * 64, kb * 64, scr, lane); }
    }
    { bf16_t* XB = (bf16_t*)(ws + WS_XB); float* SS = (float*)(ws + WS_SS);
      for (int m = gw; m < MTOK; m += NGW) {
        const f32x4* xr = (const f32x4*)(F.inp[I_X] + (size_t)m * DM) + lane; float s = 0.f; f32x4 v[4];
#pragma unroll
        for (int j = 0; j < 4; ++j) { v[j] = xr[64 * j]; s += (v[j][0] * v[j][0] + v[j][1] * v[j][1]) + (v[j][2] * v[j][2] + v[j][3] * v[j][3]); }
        s = wave_sum(s);
        u32x2* o = (u32x2*)(XB + (size_t)m * DM) + lane;
#pragma unroll
        for (int j = 0; j < 4; ++j) { u32x2 w; w.x = cvt_pk_bf16(v[j][0], v[j][1]); w.y = cvt_pk_bf16(v[j][2], v[j][3]); o[64 * j] = w; }
        if (lane < 16) SS[(size_t)m * 16 + lane] = (lane == 0) ? s : 0.f;
      } }
    { float* rope = (float*)(ws + WS_ROPE); const int gt = gw * 64 + lane, NT = NGW * 64;
      for (int i = gt; i < SEQ * 32; i += NT) { const int t = i >> 5, p = i & 31; const float inv = powf(10000.0f, -(float)p * 2.0f / 64.0f); const float ang = (float)t * inv;
          rope[2 * i] = cosf(ang); rope[2 * i + 1] = sinf(ang); }
      float* wrt = (float*)(ws + WS_WRT);
      for (int i = gt; i < 8 * DM; i += NT) { const int e = i >> 10, k = i & 1023; wrt[i] = F.inp[I_W_ROUTER][k * 8 + e] * F.inp[I_LN_FFN_O][k]; } }
}

__device__ __forceinline__ void fox_cumsum_unit(Frame& F, int bh) {
    const float* LOGF = (const float*)(F.ws + WS_LOGF); float* CB = (float*)(F.ws + WS_CB);
    LAS float* wt = (LAS float*)(F.lds);
    const int b = bh >> 3, h = bh & 7, tid = F.tid;
    float v[4]; float run = 0.f;
#pragma unroll
    for (int j = 0; j < 4; ++j) { v[j] = LOGF[((size_t)b * SEQ + 4 * tid + j) * 8 + h]; run += v[j]; v[j] = run; }
    float incl = run;
#pragma unroll
    for (int o = 1; o < 64; o <<= 1) { const float t = __shfl_up(incl, o); if (F.lane >= o) incl += t; }
    if (F.lane == 63) wt[F.wave] = incl;
    __syncthreads();
    float woff = 0.f;
    for (int w = 0; w < F.wave; ++w) woff += wt[w];
    const float base = woff + incl - run;
    f32x4 o = (f32x4){base + v[0], base + v[1], base + v[2], base + v[3]};
    *(f32x4*)(CB + (size_t)bh * SEQ + 4 * tid) = o;
    __syncthreads();
}
__device__ __forceinline__ unsigned sortable(float f) { const unsigned u = __float_as_uint(f + 0.0f); return (u & 0x80000000u) ? ~u : (u | 0x80000000u); }
constexpr int SCP = 2052;
__device__ __forceinline__ void idx_unit(Frame& F, int b, int qt) {
    const bf16_t* QKV = (const bf16_t*)(F.ws + WS_BIG); const float* IW = (const float*)(F.ws + WS_IW);
    u64* MASKT = (u64*)(F.ws + WS_XB);
    LAS float* Sc = (LAS float*)F.lds;
    const int lane = F.lane, fr = lane & 15, fq = lane >> 4, q0 = qt * 16, nkeys = q0 + 16;
    const size_t rowq = (size_t)b * SEQ + q0 + fr;
    bf16x8 qf[4][2];
#pragma unroll
    for (int h = 0; h < 4; ++h)
#pragma unroll
        for (int ks = 0; ks < 2; ++ks) qf[h][ks] = *(const bf16x8*)(QKV + rowq * N0 + C0_IQ + h * 64 + ks * 32 + fq * 8);
    const f32x4 w4 = *(const f32x4*)(IW + rowq * 4);
    for (int kb = F.wave; kb * 16 < nkeys; kb += NWAVES) {
        const size_t rowk = (size_t)b * SEQ + kb * 16 + fr;
        const bf16x8 k0 = *(const bf16x8*)(QKV + rowk * N0 + C0_IK + fq * 8), k1 = *(const bf16x8*)(QKV + rowk * N0 + C0_IK + 32 + fq * 8);
        f32x4 sc = (f32x4){0.f, 0.f, 0.f, 0.f};
#pragma unroll
        for (int h = 0; h < 4; ++h) { f32x4 a = (f32x4){0.f, 0.f, 0.f, 0.f};
            a = __builtin_amdgcn_mfma_f32_16x16x32_bf16(k0, qf[h][0], a, 0, 0, 0); a = __builtin_amdgcn_mfma_f32_16x16x32_bf16(k1, qf[h][1], a, 0, 0, 0);
#pragma unroll
            for (int j = 0; j < 4; ++j) sc[j] += w4[h] * fmaxf(a[j], 0.f); }
        *(LAS f32x4*)(Sc + fr * SCP + kb * 16 + 4 * fq) = sc;
    }
    __syncthreads();
#pragma unroll 1
    for (int rr = 0; rr < 2; ++rr) {
        const int row = F.wave * 2 + rr, t = q0 + row;
        unsigned key[32];
#pragma unroll
        for (int i = 0; i < 32; ++i) { const int s = i * 64 + lane; key[i] = (s <= t) ? sortable(Sc[row * SCP + (s < nkeys ? s : 0)]) : 0u; }
        unsigned theta = 0u; int need = 0;
        const bool all = (t + 1 <= 256);
        if (!all) {
            unsigned prefix = 0u;
#pragma unroll 1
            for (int bit = 31; bit >= 0; --bit) { const unsigned cand = prefix | (1u << bit); int cnt = 0;
#pragma unroll
                for (int i = 0; i < 32; ++i) cnt += __popcll(__ballot(key[i] >= cand));
                if (cnt >= 256) prefix = cand; }
            theta = prefix; int ngt = 0;
#pragma unroll
            for (int i = 0; i < 32; ++i) ngt += __popcll(__ballot(key[i] > theta));
            need = 256 - ngt;
        }
        int running = 0; u64 mine = 0ull;
#pragma unroll
        for (int i = 0; i < 32; ++i) {
            bool sel;
            if (all) sel = (i * 64 + lane <= t);
            else { const u64 eq = __ballot(key[i] == theta);
                   const int rank = running + (int)__builtin_amdgcn_mbcnt_hi((unsigned)(eq >> 32), __builtin_amdgcn_mbcnt_lo((unsigned)eq, 0u));
                   sel = (key[i] > theta) || (key[i] == theta && rank < need); running += __popcll(eq); }
            const u64 w = __ballot(sel);
            if (lane == i) mine = w;
        }
        if (lane < 32) MASKT[((size_t)b * 32 + lane) * SEQ + t] = mine;
    }
    __syncthreads();
}

template <int MODE, bool KOZ = false>
__device__ __forceinline__ void naive_attn_row(const bf16_t* Qrow, const bf16_t* Kp, const bf16_t* Vp, long kvpitch, bf16_t* Orow, int t, const float* cb, const u64* maskb, int lane) {
    float q[64];
#pragma unroll
    for (int c = 0; c < 8; ++c) { const u32x4 w = *(const u32x4*)(Qrow + c * 8);
        q[8 * c + 0] = bf_lo(w.x); q[8 * c + 1] = bf_hi(w.x); q[8 * c + 2] = bf_lo(w.y); q[8 * c + 3] = bf_hi(w.y); q[8 * c + 4] = bf_lo(w.z); q[8 * c + 5] = bf_hi(w.z); q[8 * c + 6] = bf_lo(w.w); q[8 * c + 7] = bf_hi(w.w); }
    float m = -INFINITY, l = 0.f; float o[64];
#pragma unroll
    for (int d = 0; d < 64; ++d) o[d] = 0.f;
    for (int s = lane; s <= t; s += 64) {
        if (MODE == 2) { const u64 w = maskb[(size_t)(s >> 6) * SEQ + t]; if (!((w >> (s & 63)) & 1ull)) continue; }
        const bf16_t* kr = Kp + (size_t)s * kvpitch; float dot = 0.f;
#pragma unroll
        for (int c = 0; c < 8; ++c) { const u32x4 w = *(const u32x4*)(kr + c * 8);
            dot += q[8 * c + 0] * bf_lo(w.x) + q[8 * c + 1] * bf_hi(w.x) + q[8 * c + 2] * bf_lo(w.y) + q[8 * c + 3] * bf_hi(w.y) + q[8 * c + 4] * bf_lo(w.z) + q[8 * c + 5] * bf_hi(w.z) + q[8 * c + 6] * bf_lo(w.w) + q[8 * c + 7] * bf_hi(w.w); }
        if (MODE == 1) dot -= cb[s] * LOG2E;
        const float mn = fmaxf(m, dot), a = exp2f(m - mn), p = exp2f(dot - mn);
        l = l * a + p; m = mn;
        const bf16_t* vr = Vp + (size_t)s * kvpitch;
#pragma unroll
        for (int c = 0; c < 8; ++c) { const u32x4 w = *(const u32x4*)(vr + c * 8);
            o[8 * c + 0] = o[8 * c + 0] * a + p * bf_lo(w.x); o[8 * c + 1] = o[8 * c + 1] * a + p * bf_hi(w.x); o[8 * c + 2] = o[8 * c + 2] * a + p * bf_lo(w.y); o[8 * c + 3] = o[8 * c + 3] * a + p * bf_hi(w.y);
            o[8 * c + 4] = o[8 * c + 4] * a + p * bf_lo(w.z); o[8 * c + 5] = o[8 * c + 5] * a + p * bf_hi(w.z); o[8 * c + 6] = o[8 * c + 6] * a + p * bf_lo(w.w); o[8 * c + 7] = o[8 * c + 7] * a + p * bf_hi(w.w); }
    }
    const float Mx = wave_max(m); const float sc = (m == -INFINITY) ? 0.f : exp2f(m - Mx);
    const float L = wave_sum(l * sc); float res = 0.f;
#pragma unroll
    for (int d = 0; d < 64; ++d) { const float od = wave_sum(o[d] * sc); if (lane == d) res = od; }
    float r = res / L; if (KOZ) r = 0.f;
    const unsigned pk = cvt_pk_bf16(r, r);
    Orow[lane] = (bf16_t)(pk & 0xffffu);
}

__device__ __forceinline__ void hgrn_unit(Frame& F, int u) {
    bf16_t* QKV = (bf16_t*)(F.ws + WS_BIG);
    const int b = u >> 4, h = (u >> 1) & 7, vh = u & 1, tid = F.tid, lane = F.lane, vloc = lane & 31, ks = lane >> 5;
    LAS float* Qs = (LAS float*)F.lds;
    LAS float* Fs = Qs + 4096;
    LAS float* Vs = Fs + 4096;
    LAS float* Os = Vs + 2048;
    const int k0 = F.wave * 8 + ks * 4;
    float st[4] = {0.f, 0.f, 0.f, 0.f};
    const int sk = (tid & 7) * 8, stt = tid >> 3;
    float lbv[8];
#pragma unroll
    for (int j = 0; j < 8; ++j) { const int ch = h * 64 + sk + j; lbv[j] = sigmoidf_(F.inp[I_LB][512 + ch] - F.inp[I_LB][ch]); }
    for (int c = 0; c < SEQ / 64; ++c) {
        const size_t row0 = (size_t)b * SEQ + c * 64;
        { const bf16_t* rp = QKV + (row0 + stt) * N1;
          const u32x4 wq = *(const u32x4*)(rp + C1_HQ + h * 64 + sk), wf = *(const u32x4*)(rp + C1_HF + h * 64 + sk);
          const unsigned aq[4] = {wq.x, wq.y, wq.z, wq.w}, af[4] = {wf.x, wf.y, wf.z, wf.w};
          float qv[8], fv[8];
#pragma unroll
          for (int j = 0; j < 4; ++j) { qv[2 * j] = siluf_(bf_lo(aq[j])); qv[2 * j + 1] = siluf_(bf_hi(aq[j]));
              fv[2 * j] = lbv[2 * j] + (1.f - lbv[2 * j]) * sigmoidf_(bf_lo(af[j])); fv[2 * j + 1] = lbv[2 * j + 1] + (1.f - lbv[2 * j + 1]) * sigmoidf_(bf_hi(af[j])); }
          *(LAS f32x4*)(Qs + stt * 64 + sk) = (f32x4){qv[0], qv[1], qv[2], qv[3]}; *(LAS f32x4*)(Qs + stt * 64 + sk + 4) = (f32x4){qv[4], qv[5], qv[6], qv[7]};
          *(LAS f32x4*)(Fs + stt * 64 + sk) = (f32x4){fv[0], fv[1], fv[2], fv[3]}; *(LAS f32x4*)(Fs + stt * 64 + sk + 4) = (f32x4){fv[4], fv[5], fv[6], fv[7]};
          if (tid < 256) { const int vt = tid >> 2, vc = (tid & 3) * 8; const u32x4 wv = *(const u32x4*)(QKV + (row0 + vt) * N1 + C1_HI + h * 64 + vh * 32 + vc);
              *(LAS f32x4*)(Vs + vt * 32 + vc) = (f32x4){bf_lo(wv.x), bf_hi(wv.x), bf_lo(wv.y), bf_hi(wv.y)}; *(LAS f32x4*)(Vs + vt * 32 + vc + 4) = (f32x4){bf_lo(wv.z), bf_hi(wv.z), bf_lo(wv.w), bf_hi(wv.w)}; } }
        __syncthreads();
#pragma unroll 4
        for (int tt = 0; tt < 64; ++tt) {
            const f32x4 f4 = *(const LAS f32x4*)(Fs + tt * 64 + k0), q4 = *(const LAS f32x4*)(Qs + tt * 64 + k0); const float v = Vs[tt * 32 + vloc];
            float o = 0.f;
#pragma unroll
            for (int j = 0; j < 4; ++j) { st[j] = f4[j] * (st[j] - v) + v; o += st[j] * q4[j]; }
            o += __shfl_xor(o, 32);
            if (ks == 0) Os[(F.wave * 64 + tt) * 32 + vloc] = o;
        }
        __syncthreads();
        { const int ot = tid >> 3, ov = (tid & 7) * 4; f32x4 s = (f32x4){0.f, 0.f, 0.f, 0.f};
#pragma unroll
          for (int w = 0; w < 8; ++w) s += *(const LAS f32x4*)(Os + (w * 64 + ot) * 32 + ov);
          u32x2 pk; pk.x = cvt_pk_bf16(s[0], s[1]); pk.y = cvt_pk_bf16(s[2], s[3]);
          *(u32x2*)(QKV + (row0 + ot) * N1 + C1_HI + h * 64 + vh * 32 + ov) = pk; }
        __syncthreads();
    }
}

__device__ __forceinline__ void combine_rows(Frame& F) {
    bf16_t* QKV = (bf16_t*)(F.ws + WS_BIG); const bf16_t* DO = (const bf16_t*)(F.ws + WS_XB);
    const int gw = F.vcu * NWAVES + F.wave, NGW = F.G * NWAVES, lane = F.lane;
    const float* lv = F.inp[I_LAM];
    const float d01 = wave_sum(lv[lane] * lv[64 + lane]), d23 = wave_sum(lv[128 + lane] * lv[192 + lane]);
    const float lam_init = 0.8f - 0.6f * expf(-0.3f);
    const float lam = expf(d01) - expf(d23) + lam_init;
    float gh[8], gd[8];
#pragma unroll
    for (int j = 0; j < 8; ++j) { gh[j] = F.inp[I_HGRN_G][(lane & 7) * 8 + j]; gd[j] = F.inp[I_DIFF_G][(lane & 15) * 8 + j] * (1.0f - lam_init); }
    for (int m = gw; m < MTOK; m += NGW) {
        bf16_t* rp = QKV + (size_t)m * N1;
        { const u32x4 wo = *(const u32x4*)(rp + C1_HI + lane * 8), wg = *(const u32x4*)(rp + C1_HG + lane * 8);
          float o[8] = {bf_lo(wo.x), bf_hi(wo.x), bf_lo(wo.y), bf_hi(wo.y), bf_lo(wo.z), bf_hi(wo.z), bf_lo(wo.w), bf_hi(wo.w)};
          float g[8] = {bf_lo(wg.x), bf_hi(wg.x), bf_lo(wg.y), bf_hi(wg.y), bf_lo(wg.z), bf_hi(wg.z), bf_lo(wg.w), bf_hi(wg.w)};
          float ss = 0.f;
#pragma unroll
          for (int j = 0; j < 8; ++j) ss += o[j] * o[j];
          ss += __shfl_xor(ss, 1); ss += __shfl_xor(ss, 2); ss += __shfl_xor(ss, 4);
          const float rs = rsqrtf(ss * (1.0f / 64.0f) + EPS); float r[8];
#pragma unroll
          for (int j = 0; j < 8; ++j) r[j] = (KO & 8) ? 0.f : o[j] * rs * gh[j] * siluf_(g[j]);
          *(u32x4*)(rp + C1_HQ + lane * 8) = (u32x4){cvt_pk_bf16(r[0], r[1]), cvt_pk_bf16(r[2], r[3]), cvt_pk_bf16(r[4], r[5]), cvt_pk_bf16(r[6], r[7])}; }
        { const int hd = lane >> 4, dd = (lane & 15) * 8; const bf16_t* dp = DO + (size_t)m * DM + hd * 256 + dd;
          const u32x4 w1 = *(const u32x4*)dp, w2 = *(const u32x4*)(dp + 128);
          float a[8] = {bf_lo(w1.x), bf_hi(w1.x), bf_lo(w1.y), bf_hi(w1.y), bf_lo(w1.z), bf_hi(w1.z), bf_lo(w1.w), bf_hi(w1.w)};
          float c[8] = {bf_lo(w2.x), bf_hi(w2.x), bf_lo(w2.y), bf_hi(w2.y), bf_lo(w2.z), bf_hi(w2.z), bf_lo(w2.w), bf_hi(w2.w)};
          float ss = 0.f; float d[8];
#pragma unroll
          for (int j = 0; j < 8; ++j) { d[j] = a[j] - lam * c[j]; ss += d[j] * d[j]; }
          ss += __shfl_xor(ss, 1); ss += __shfl_xor(ss, 2); ss += __shfl_xor(ss, 4); ss += __shfl_xor(ss, 8);
          const float rs = rsqrtf(ss * (1.0f / 128.0f) + EPS); float r[8];
#pragma unroll
          for (int j = 0; j < 8; ++j) r[j] = (KO & 16) ? 0.f : d[j] * rs * gd[j];
          *(u32x4*)(rp + C1_Q + hd * 128 + dd) = (u32x4){cvt_pk_bf16(r[0], r[1]), cvt_pk_bf16(r[2], r[3]), cvt_pk_bf16(r[4], r[5]), cvt_pk_bf16(r[6], r[7])}; }
    }
}

__device__ __forceinline__ void router_rows(Frame& F) {
    const bf16_t* XB = (const bf16_t*)(F.ws + WS_XB); const float* SS = (const float*)(F.ws + WS_SS); const float* WRT = (const float*)(F.ws + WS_WRT);
    float* GATE = (float*)(F.ws + WS_GATE); int* LIST = (int*)(F.ws + WS_LIST); unsigned* cnt = F.ctl + CW_CNT;
    LAS float* Ws = (LAS float*)F.lds;
    for (int i = F.tid; i < 8 * DM; i += NTHR) Ws[i] = WRT[i];
    __syncthreads();
    const int gw = F.vcu * NWAVES + F.wave, NGW = F.G * NWAVES, lane = F.lane;
    for (int m = gw; m < MTOK; m += NGW) {
        const u32x4 w0 = *(const u32x4*)(XB + (size_t)m * DM + lane * 8), w1 = *(const u32x4*)(XB + (size_t)m * DM + 512 + lane * 8);
        const float x[16] = {bf_lo(w0.x), bf_hi(w0.x), bf_lo(w0.y), bf_hi(w0.y), bf_lo(w0.z), bf_hi(w0.z), bf_lo(w0.w), bf_hi(w0.w), bf_lo(w1.x), bf_hi(w1.x), bf_lo(w1.y), bf_hi(w1.y), bf_lo(w1.z), bf_hi(w1.z), bf_lo(w1.w), bf_hi(w1.w)};
        float ssum = (lane < 16) ? SS[(size_t)m * 16 + lane] : 0.f; ssum = wave_sum(ssum);
        const float rs = rsqrtf(ssum * (1.0f / DM) + EPS);
        float lg[8];
#pragma unroll
        for (int e = 0; e < 8; ++e) { const LAS float* wp = Ws + e * DM + lane * 8; float s = 0.f;
            const f32x4 a0 = *(const LAS f32x4*)wp, a1 = *(const LAS f32x4*)(wp + 4), b0 = *(const LAS f32x4*)(wp + 512), b1 = *(const LAS f32x4*)(wp + 516);
            s += x[0] * a0[0] + x[1] * a0[1] + x[2] * a0[2] + x[3] * a0[3] + x[4] * a1[0] + x[5] * a1[1] + x[6] * a1[2] + x[7] * a1[3];
            s += x[8] * b0[0] + x[9] * b0[1] + x[10] * b0[2] + x[11] * b0[3] + x[12] * b1[0] + x[13] * b1[1] + x[14] * b1[2] + x[15] * b1[3];
            lg[e] = wave_sum(s) * rs; }
        int i1 = 0; float l1 = lg[0];
#pragma unroll
        for (int e = 1; e < 8; ++e) if (lg[e] > l1) { l1 = lg[e]; i1 = e; }
        int i2 = -1; float l2 = -INFINITY;
#pragma unroll
        for (int e = 0; e < 8; ++e) if (e != i1 && lg[e] > l2) { l2 = lg[e]; i2 = e; }
        const float g1 = 1.0f / (1.0f + __expf(l2 - l1)), g2 = 1.0f - g1;
        if (lane == 0) {
            const unsigned s1 = __hip_atomic_fetch_add(cnt + i1, 1u, RLX_AGENT); LIST[(size_t)i1 * MTOK + s1] = m; GATE[m] = g1;
            const unsigned s2 = __hip_atomic_fetch_add(cnt + 8 + i2, 1u, RLX_AGENT); LIST[(size_t)(8 + i2) * MTOK + s2] = m; GATE[MTOK + m] = g2;
        }
    }
}

__device__ __forceinline__ void final_norm(Frame& F) {
    const int gw = F.vcu * NWAVES + F.wave, NGW = F.G * NWAVES, lane = F.lane;
    f32x4 g[4];
#pragma unroll
    for (int j = 0; j < 4; ++j) g[j] = *((const f32x4*)F.inp[I_LN_FINAL] + lane + 64 * j);
    for (int m = gw; m < MTOK; m += NGW) {
        f32x4* xr = (f32x4*)(F.out + (size_t)m * DM) + lane; f32x4 v[4]; float s = 0.f;
#pragma unroll
        for (int j = 0; j < 4; ++j) { v[j] = xr[64 * j]; s += (v[j][0] * v[j][0] + v[j][1] * v[j][1]) + (v[j][2] * v[j][2] + v[j][3] * v[j][3]); }
        const float rs = rsqrtf(wave_sum(s) * (1.0f / DM) + EPS);
#pragma unroll
        for (int j = 0; j < 4; ++j) xr[64 * j] = v[j] * rs * g[j];
    }
}

constexpr int NPH = 17;
struct Args { const float* in[22]; float* out; unsigned char* ws; int ph_lo, ph_hi, li, pad; };
__global__ void __launch_bounds__(NTHR, 2) trunk_fwd(Args args) {
    extern __shared__ __attribute__((aligned(16))) unsigned char lds[];
    Frame F;
    F.lds = (LAS unsigned char*)lds;
    F.tid = threadIdx.x; F.lane = F.tid & 63; F.wave = __builtin_amdgcn_readfirstlane(F.tid >> 6);
    F.G = gridDim.x; { const int bx = blockIdx.x; F.vcu = (F.G % 8 == 0) ? (bx % 8) * (F.G / 8) + bx / 8 : bx; }
    F.ws = args.ws; F.out = args.out; F.ctl = (unsigned*)(args.ws + WS_CTL);
    F.inp = args.in;
    volatile LAS unsigned* MISC = (volatile LAS unsigned*)(F.lds + MISC_OFF);
    for (int u = F.tid; u < (LDS_BYTES - LDSCTL_OFF) / 4; u += NTHR) ((LAS unsigned*)(F.lds + LDSCTL_OFF))[u] = 0u;
    __syncthreads();
    XcdBarrier bar; bar.bar = F.ctl + CW_BAR; bar.x = 0; bar.st = nullptr;
    if (!MK_PER_PHASE) bar = xcd_barrier_post(F.ctl + CW_BAR, MISC + 8);
#define GRID_BAR() do { if (MK_PER_PHASE) { if (F.tid == 0) __hip_atomic_store(F.ctl + CW_TMO, 0xBADBA0u, RLX_AGENT); } else { xcd_barrier(bar); } } while (0)
    const int lo = args.ph_lo, hi = args.ph_hi;
#ifndef PH_MASK
#define PH_MASK 0x1ffff
#endif
#define IN(k) ((((PH_MASK) >> (k)) & 1) && lo <= (k) && (k) < hi)
#define BOTH(k) (IN(k) && IN((k) + 1))
    unsigned char* ws = args.ws;
    bf16_t* XB = (bf16_t*)(ws + WS_XB); float* SS = (float*)(ws + WS_SS); bf16_t* BIG = (bf16_t*)(ws + WS_BIG);
    const int c = (int)blockIdx.x, G = F.G;

    if (IN(0)) { p0_prologue(F); if (BOTH(0)) GRID_BAR(); }
    if (IN(1)) {
        pg8::Gemm g{XB, (const bf16_t*)(ws + WS_WIN0), DM, DM, 0, nullptr}; pg8::StaticOrder S; S.init(MTOK, N0, G, c);
        pg8::EpiIn E{BIG, N0, SS, (const float*)(ws + WS_ROPE), (float*)(ws + WS_LOGF), (float*)(ws + WS_IW), F.inp[I_B_FOX], 0};
        pg8::gemm_phase<pg8::EpiIn, pg8::StaticOrder, false, true>(F.lds, g, S, E);
        if (BOTH(1)) GRID_BAR();
    }
    if (IN(2)) {
        for (int u = c; u < 128; u += G) fox_cumsum_unit(F, u);
        for (int i = 0; ; ++i) { const int L = i * G + c; if (L >= 2048) break; const int b = L & 15, j = L >> 4; const int qt = (j & 1) ? 127 - (j >> 1) : (j >> 1); idx_unit(F, b, qt); }
        if (BOTH(2)) GRID_BAR();
    }
    if (IN(3)) {
        const int gw = F.vcu * NWAVES + F.wave, NGW = G * NWAVES;
        for (int id = gw; id < 256 * SEQ; id += NGW) {
            const int combo = id & 255, t = id >> 8; const int typ = combo >> 7, b = (combo >> 3) & 15, h = combo & 7;
            bf16_t* rowp = BIG + ((size_t)b * SEQ + t) * N0; const bf16_t* b0 = BIG + (size_t)b * SEQ * N0;
            if (typ == 0) naive_attn_row<1, (KO & 1) != 0>(rowp + C0_FQ + h * 64, b0 + C0_FK + h * 64, b0 + C0_FV + h * 64, N0, rowp + C0_FQ + h * 64, t, (const float*)(ws + WS_CB) + (size_t)(b * 8 + h) * SEQ, nullptr, F.lane);
            else naive_attn_row<2, (KO & 2) != 0>(rowp + C0_DQ + h * 64, b0 + C0_DK + (h >> 2) * 64, b0 + C0_DV + (h >> 2) * 64, N0, rowp + C0_DQ + h * 64, t, nullptr, (const u64*)(ws + WS_XB) + (size_t)b * 32 * SEQ, F.lane);
        }
        if (BOTH(3)) GRID_BAR();
    }
    if (IN(4)) {
        pg8::Gemm g{BIG, (const bf16_t*)(ws + WS_WOUT0), N0, DM, 0, nullptr}; pg8::StaticOrder S; S.init(MTOK, DM, G, c);
        pg8::EpiRes E{F.inp[I_X], F.out, XB, SS};
        pg8::gemm_phase<pg8::EpiRes, pg8::StaticOrder, false, true>(F.lds, g, S, E);
        if (BOTH(4)) GRID_BAR();
    }
    if (IN(5) && !(KO & 4)) {
        pg8::Gemm g{XB, (const bf16_t*)(ws + WS_WGU0), DM, DM, 0, nullptr}; pg8::StaticOrder S; S.init(MTOK, 2 * FF, G, c);
        pg8::EpiGU<false> E{BIG, FF, SS, nullptr};
        pg8::gemm_phase<pg8::EpiGU<false>, pg8::StaticOrder, false, true>(F.lds, g, S, E);
        if (BOTH(5)) GRID_BAR();
    }
    if (IN(6) && !(KO & 4)) {
        pg8::Gemm g{BIG, (const bf16_t*)(ws + WS_WDN0), FF, FF, 0, nullptr}; pg8::StaticOrder S; S.init(MTOK, DM, G, c);
        pg8::EpiRes E{F.out, F.out, XB, SS};
        pg8::gemm_phase<pg8::EpiRes, pg8::StaticOrder, false, true>(F.lds, g, S, E);
        if (BOTH(6)) GRID_BAR();
    }
    if (IN(7)) {
        pg8::Gemm g{XB, (const bf16_t*)(ws + WS_WIN1), DM, DM, 0, nullptr}; pg8::StaticOrder S; S.init(MTOK, N1, G, c);
        pg8::EpiIn E{BIG, N1, SS, (const float*)(ws + WS_ROPE), nullptr, nullptr, nullptr, 1};
        pg8::gemm_phase<pg8::EpiIn, pg8::StaticOrder, false, true>(F.lds, g, S, E);
        if (BOTH(7)) GRID_BAR();
    }
    if (IN(8)) {
        for (int u = c; u < 256; u += G) hgrn_unit(F, u);
        const int gw = F.vcu * NWAVES + F.wave, NGW = G * NWAVES;
        bf16_t* DO = XB;
        for (int id = gw; id < 256 * SEQ; id += NGW) {
            const int combo = id & 255, t = id >> 8; const int b = combo >> 4, hd = (combo >> 2) & 3, mp = (combo >> 1) & 1, jv = combo & 1;
            const bf16_t* rowp = BIG + ((size_t)b * SEQ + t) * N1; const bf16_t* b0 = BIG + (size_t)b * SEQ * N1;
            naive_attn_row<0>(rowp + C1_Q + (hd * 2 + mp) * 64, b0 + C1_K + (hd * 2 + mp) * 64, b0 + C1_V + hd * 128 + jv * 64, N1,
                              DO + ((size_t)b * SEQ + t) * DM + (hd * 2 + mp) * 128 + jv * 64, t, nullptr, nullptr, F.lane);
        }
        if (BOTH(8)) GRID_BAR();
    }
    if (IN(9)) { combine_rows(F); if (BOTH(9)) GRID_BAR(); }
    if (IN(10)) {
        pg8::Gemm g{BIG, (const bf16_t*)(ws + WS_WOUT1), N1, DM, 0, nullptr}; pg8::StaticOrder S; S.init(MTOK, DM, G, c);
        pg8::EpiRes E{F.out, F.out, XB, SS};
        pg8::gemm_phase<pg8::EpiRes, pg8::StaticOrder, false, true>(F.lds, g, S, E);
        if (BOTH(10)) GRID_BAR();
    }
    if (IN(11)) { router_rows(F); if (BOTH(11)) GRID_BAR(); }
#define MOE_PHASES(k) { \
        const int* LIST = (const int*)(ws + WS_LIST) + (size_t)(k) * 8 * MTOK; \
        if (IN(12 + 2 * (k)) && !(KO & (32 << (k)))) { \
            pg8::Gemm g{XB, (const bf16_t*)(ws + WS_WEGU), DM, DM, (size_t)7168 * DM, LIST}; pg8::MoeOrder S; S.init(F.ctl + CW_CNT + 8 * (k), 28, G, c); \
            pg8::EpiGU<true> E{BIG, FFE, SS, LIST}; \
            pg8::gemm_phase<pg8::EpiGU<true>, pg8::MoeOrder, true, true>(F.lds, g, S, E); \
            if (BOTH(12 + 2 * (k))) GRID_BAR(); \
        } \
        if (IN(13 + 2 * (k)) && !(KO & (32 << (k)))) { \
            pg8::Gemm g{BIG, (const bf16_t*)(ws + WS_WEDN), FFE, FFE, (size_t)DM * FFE, nullptr}; pg8::MoeOrder S; S.init(F.ctl + CW_CNT + 8 * (k), 4, G, c); \
            pg8::EpiMoeDown E{F.out, LIST, (const float*)(ws + WS_GATE) + (size_t)(k) * MTOK}; \
            pg8::gemm_phase<pg8::EpiMoeDown, pg8::MoeOrder, false, true>(F.lds, g, S, E); \
            if (BOTH(13 + 2 * (k))) GRID_BAR(); \
        } }
    MOE_PHASES(0)
    MOE_PHASES(1)
#undef MOE_PHASES
    if (IN(16)) { final_norm(F); }
#undef IN
#undef BOTH
}


#ifndef DBG
#define DBG 0
#endif
#if DBG
constexpr int CW_CHK = 512;
constexpr size_t WS_DBG = WS_END;
__device__ __forceinline__ void chk_max(unsigned* ctl, int id, float e) { if (!(e >= 0.f)) e = 1e30f; atomicMax(ctl + CW_CHK + id, __float_as_uint(e)); }
__device__ __forceinline__ float relerr(float got, float exp_, float scale = 1.0f) { return fabsf(got - exp_) / (fabsf(exp_) + 0.5f * scale); }
__device__ __forceinline__ int dbg_row(int i) { const int rows[8] = {0, 255, 256, 1000, 2047, 2048 + 77, 16 * 2048 - 1, 20000}; return rows[i & 7]; }
__device__ float block_sum(float v, float* red) {
    v = wave_sum(v); __syncthreads(); if ((threadIdx.x & 63) == 0) red[threadIdx.x >> 6] = v; __syncthreads();
    float s = 0.f; for (int w = 0; w < 8; ++w) s += red[w]; __syncthreads(); return s;
}
__global__ void __launch_bounds__(512) dbg_check(Args args, int which) {
    __shared__ float hv[3584]; __shared__ float raw[2880]; __shared__ float red[8];
    const float* const* in = args.in; unsigned char* ws = args.ws; unsigned* ctl = (unsigned*)(ws + WS_CTL);
    const int tid = threadIdx.x; const int r = dbg_row(blockIdx.x), t = r & (SEQ - 1);
    const bf16_t* BIG = (const bf16_t*)(ws + WS_BIG); const bf16_t* XB = (const bf16_t*)(ws + WS_XB); const float* SS = (const float*)(ws + WS_SS);
    float* SCR = (float*)(ws + WS_DBG) + (size_t)blockIdx.x * 1024;
    float emax = 0.f;
    if (which == 1) {
        float ssq = 0.f; for (int k = tid; k < DM; k += 512) { const float x = in[I_X][(size_t)r * DM + k]; ssq += x * x; }
        const float rs = rsqrtf(block_sum(ssq, red) / DM + EPS);
        for (int k = tid; k < DM; k += 512) hv[k] = in[I_X][(size_t)r * DM + k] * rs * in[I_LN_MIX_E][k];
        __syncthreads();
        for (int n = tid; n < N0SRC; n += 512) { float a = 0.f; for (int k = 0; k < DM; ++k) a += hv[k] * in[I_W_IN_E][(size_t)k * N0SRC + n]; raw[n] = a; }
        __syncthreads();
        const bf16_t* q = BIG + (size_t)r * N0;
        float e1 = 0.f, e2 = 0.f, e3 = 0.f;
        for (int i = tid; i < 512; i += 512) { e1 = fmaxf(e1, relerr(bf1(q[C0_FQ + i]), raw[i] * C2, C2)); e2 = fmaxf(e2, relerr(bf1(q[C0_FK + i]), raw[512 + i])); e3 = fmaxf(e3, relerr(bf1(q[C0_FV + i]), raw[1024 + i])); }
        chk_max(ctl, 21, wave_max(e1)); chk_max(ctl, 22, wave_max(e2)); chk_max(ctl, 23, wave_max(e3));
        float e4 = 0.f; for (int i = tid; i < 128; i += 512) e4 = fmaxf(e4, relerr(bf1(q[C0_DV + i]), raw[2184 + i]));
        chk_max(ctl, 24, wave_max(e4));
        const int sb[4] = {1544, 2056, 2312, 2568}, nh[4] = {8, 2, 4, 1}, db[4] = {C0_DQ, C0_DK, C0_IQ, C0_IK}; const float scl[4] = {C2, 1.f, 0.125f, 1.f};
        for (int sg = 0; sg < 4; ++sg) { float e = 0.f; for (int i = tid; i < nh[sg] * 32; i += 512) { const int hh = i >> 5, p = i & 31;
            const float inv = powf(10000.0f, -(float)p * 2.0f / 64.0f), ang = (float)t * inv, cs = cosf(ang), sn = sinf(ang);
            const float x1 = raw[sb[sg] + hh * 64 + p], x2 = raw[sb[sg] + hh * 64 + 32 + p];
            e = fmaxf(e, relerr(bf1(q[db[sg] + hh * 64 + 2 * p]), (x1 * cs - x2 * sn) * scl[sg], scl[sg])); e = fmaxf(e, relerr(bf1(q[db[sg] + hh * 64 + 2 * p + 1]), (x2 * cs + x1 * sn) * scl[sg], scl[sg])); }
            chk_max(ctl, 25 + sg, wave_max(e)); }
        float e9 = 0.f, e10 = 0.f;
        if (tid < 8) { const float x = raw[1536 + tid] + in[I_B_FOX][tid]; const float lf = fminf(x, 0.f) - log1pf(expf(-fabsf(x))); e9 = relerr(((const float*)(ws + WS_LOGF))[(size_t)r * 8 + tid], lf); }
        if (tid < 4) e10 = relerr(((const float*)(ws + WS_IW))[(size_t)r * 4 + tid], raw[2632 + tid] * 0.5f);
        float ea = 0.f, eb = 0.f, ec = 0.f;
        if (tid < 8) { ea = relerr(bf1(q[C0_FF + tid]), raw[1536 + tid]); const float x = raw[1536 + tid]; const float lf = fminf(x, 0.f) - log1pf(expf(-fabsf(x))); eb = relerr(((const float*)(ws + WS_LOGF))[(size_t)r * 8 + tid], lf); ec = e9; }
        chk_max(ctl, 1, wave_max(ea)); chk_max(ctl, 2, wave_max(eb)); chk_max(ctl, 3, wave_max(ec)); chk_max(ctl, 4, wave_max(e10));
    } else if (which == 2) {
        const float* LOGF = (const float*)(ws + WS_LOGF); const float* CB = (const float*)(ws + WS_CB); const u64* MASKT = (const u64*)(ws + WS_XB);
        const int gid = blockIdx.x * 512 + tid;
        if (gid < 128) { const int b = gid >> 3, h = gid & 7; float c = 0.f; for (int s2 = 0; s2 < SEQ; ++s2) { c += LOGF[((size_t)b * SEQ + s2) * 8 + h]; emax = fmaxf(emax, fabsf(CB[(size_t)gid * SEQ + s2] - c) / (fabsf(c) * 1e-3f + 0.01f)); } }
        chk_max(ctl, 2, wave_max(emax));
        float e3 = 0.f;
        for (int rr = gid; rr < MTOK; rr += 8 * 512) { const int b = rr >> 11, tt = rr & 2047; int pc = 0; bool bad = false;
            for (int i = 0; i < 32; ++i) { const u64 w = MASKT[((size_t)b * 32 + i) * SEQ + tt]; pc += __popcll(w);
                const int lo = i * 64; if (lo > tt) { if (w) bad = true; } else if (tt - lo < 63) { if (w >> (tt - lo + 1)) bad = true; } }
            const int want = (tt + 1 < 256) ? tt + 1 : 256; if (pc != want || bad) e3 = 1.f; }
        chk_max(ctl, 3, wave_max(e3));
    } else if (which == 4) {
        for (int k = tid; k < DM; k += 512) hv[k] = bf1(BIG[(size_t)r * N0 + k]);
        __syncthreads();
        float ssq = 0.f;
        for (int n = tid; n < DM; n += 512) { float a = in[I_X][(size_t)r * DM + n]; for (int k = 0; k < DM; ++k) a += hv[k] * in[I_W_OUT_E][(size_t)k * DM + n];
            emax = fmaxf(emax, relerr(args.out[(size_t)r * DM + n], a)); emax = fmaxf(emax, relerr(bf1(XB[(size_t)r * DM + n]), a)); ssq += a * a; }
        ssq = block_sum(ssq, red); float s16 = 0.f; for (int i = 0; i < 16; ++i) s16 += SS[(size_t)r * 16 + i];
        emax = fmaxf(emax, fabsf(s16 - ssq) / ssq * 10.f);
        chk_max(ctl, 4, wave_max(emax));
    } else if (which == 5) {
        float ssq = 0.f; for (int k = tid; k < DM; k += 512) { const float x = args.out[(size_t)r * DM + k]; ssq += x * x; }
        const float rs = rsqrtf(block_sum(ssq, red) / DM + EPS);
        for (int k = tid; k < DM; k += 512) hv[k] = args.out[(size_t)r * DM + k] * rs * in[I_LN_FFN_E][k];
        __syncthreads();
        for (int n = tid; n < FF; n += 512) { float g = 0.f, u = 0.f; for (int k = 0; k < DM; ++k) { g += hv[k] * in[I_W_GATE][(size_t)k * FF + n]; u += hv[k] * in[I_W_UP][(size_t)k * FF + n]; }
            const float h = g / (1.f + expf(-g)) * u; emax = fmaxf(emax, relerr(bf1(BIG[(size_t)r * FF + n]), h)); }
        __syncthreads();
        for (int k = tid; k < FF; k += 512) hv[k] = bf1(BIG[(size_t)r * FF + k]);
        __syncthreads();
        for (int n = tid; n < DM; n += 512) { float a = args.out[(size_t)r * DM + n]; for (int k = 0; k < FF; ++k) a += hv[k] * in[I_W_DOWN][(size_t)k * DM + n]; SCR[n] = a; }
        chk_max(ctl, 5, wave_max(emax));
    } else if (which == 6) {
        for (int n = tid; n < DM; n += 512) emax = fmaxf(emax, relerr(args.out[(size_t)r * DM + n], SCR[n]));
        chk_max(ctl, 6, wave_max(emax));
    }
}
__global__ void __launch_bounds__(512) dbg_encode(Args args, int nchk, int total) {
    const unsigned* ctl = (const unsigned*)(args.ws + WS_CTL);
    int idx = 0, mag = 0;
    for (int i = 1; i <= nchk; ++i) { const float e = __uint_as_float(ctl[CW_CHK + i]); if (e > 0.06f) { idx = i; mag = 0; float th = 1.0f; while (mag < 9 && e < th) { th *= 0.5f; ++mag; } break; } }
    const float s = sqrtf((float)(10 * idx + mag));
    for (int i = blockIdx.x * 512 + threadIdx.x; i < total; i += gridDim.x * 512) args.out[i] = s;
}
#endif
extern "C" void kernel_launch(void* const* d_in, const int* in_sizes, int n_in, void* d_out, int out_size, void* d_ws, size_t ws_size, hipStream_t stream) {
    static int grid = 0;
    if (grid == 0) {
        if (n_in != 22 || in_sizes[0] != MTOK * DM || out_size != MTOK * DM || ws_size < WS_END) { fprintf(stderr, "kernel_launch: unexpected shapes / workspace (%zu < %zu)\n", ws_size, (size_t)WS_END); grid = -1; return; }
        int dev = 0, cus = 0, per_cu = 0;
        if (hipGetDevice(&dev) != hipSuccess || hipDeviceGetAttribute(&cus, hipDeviceAttributeMultiprocessorCount, dev) != hipSuccess) { grid = -1; return; }
        if (hipFuncSetAttribute((const void*)trunk_fwd, hipFuncAttributeMaxDynamicSharedMemorySize, LDS_BYTES) != hipSuccess) { grid = -1; return; }
        if (hipOccupancyMaxActiveBlocksPerMultiprocessor(&per_cu, (const void*)trunk_fwd, NTHR, LDS_BYTES) != hipSuccess || per_cu < 1) { fprintf(stderr, "kernel_launch: occupancy query says %d\n", per_cu); }
        (void)hipGetLastError();
        grid = cus;
    }
    if (grid < 0) return;
    if (hipMemsetAsync((char*)d_ws + WS_CTL, 0, CTL_ZERO_BYTES, stream) != hipSuccess) return;
    Args a{};
    for (int i = 0; i < 22; ++i) a.in[i] = (const float*)d_in[i];
    a.out = (float*)d_out; a.ws = (unsigned char*)d_ws; a.pad = 0;
#if MK_PER_PHASE
    for (int p = 0; p < NPH; ++p) { a.ph_lo = p; a.ph_hi = p + 1; a.li = p; hipLaunchKernelGGL(trunk_fwd, dim3(grid), dim3(NTHR), LDS_BYTES, stream, a);
#if DBG
        if (p == 1 || p == 2 || p == 4 || p == 5 || p == 6) hipLaunchKernelGGL(dbg_check, dim3(8), dim3(512), 0, stream, a, p);
        if (p == DBG_LAST) { hipLaunchKernelGGL(dbg_encode, dim3(1024), dim3(512), 0, stream, a, 9, MTOK * DM); break; }
#endif
    }
#else
    a.ph_lo = 0; a.ph_hi = NPH; a.li = 0;
    hipLaunchKernelGGL(trunk_fwd, dim3(grid), dim3(NTHR), LDS_BYTES, stream, a);
#endif
}
```

```cpp
#include <hip/hip_runtime.h>
#include <hip/hip_bf16.h>
#include <cstdio>
#include <cstdint>

#ifndef MK_PER_PHASE
#define MK_PER_PHASE 0
#endif
#ifndef KO
#define KO 0
#endif
#define DBG 0
#define DBG_LAST 1
#ifndef FAST_ATTN
#define FAST_ATTN 1
#endif

#define LAS __attribute__((address_space(3)))
#define GAS __attribute__((address_space(1)))
typedef unsigned short bf16_t;
typedef short bf16x8 __attribute__((ext_vector_type(8)));
typedef float f32x4 __attribute__((ext_vector_type(4)));
typedef float f32x2 __attribute__((ext_vector_type(2)));
typedef unsigned u32x4 __attribute__((ext_vector_type(4)));
typedef unsigned u32x2 __attribute__((ext_vector_type(2)));
typedef unsigned long long u64;

constexpr int NB = 16, SEQ = 2048, DM = 1024, MTOK = NB * SEQ;
constexpr int N0 = 2816;
constexpr int N0SRC = 2636, N1 = 3584, FF = 2816, FFE = 3584, NEXP = 8;
constexpr float EPS = 1e-6f;
constexpr float LOG2E = 1.4426950408889634f;
constexpr float C2 = 0.125f * LOG2E;
constexpr int C0_FQ = 0, C0_DQ = 512, C0_FK = 1024, C0_FV = 1536, C0_DK = 2048, C0_DV = 2176, C0_IQ = 2304, C0_IK = 2560, C0_FF = 2624, C0_IW = 2632;
constexpr int C1_HQ = 0, C1_Q = 512, C1_HF = 1024, C1_HI = 1536, C1_HG = 2048, C1_K = 2560, C1_V = 3072;

constexpr size_t MiB = 1u << 20;
constexpr size_t WS_CTL = 0, CTL_ZERO_BYTES = 1 * MiB;
constexpr size_t WS_ROPE = 1 * MiB;
constexpr size_t WS_IW   = WS_ROPE + 512 * 1024;
constexpr size_t WS_LOGF = 2 * MiB;
constexpr size_t WS_CB   = 3 * MiB;
constexpr size_t WS_SS   = 4 * MiB;
constexpr size_t WS_WRT  = 6 * MiB;
constexpr size_t WS_GATE = 6 * MiB + 256 * 1024;
constexpr size_t WS_LIST = 7 * MiB;
constexpr size_t WS_WIN0 = 10 * MiB;
constexpr size_t WS_WOUT0 = 16 * MiB;
constexpr size_t WS_WGU0 = 18 * MiB;
constexpr size_t WS_WDN0 = 29 * MiB;
constexpr size_t WS_WIN1 = 35 * MiB;
constexpr size_t WS_WOUT1 = 42 * MiB;
constexpr size_t WS_WEGU = 44 * MiB;
constexpr size_t WS_WEDN = 156 * MiB;
constexpr size_t WS_XB = 212 * MiB;
constexpr size_t WS_BIG = 276 * MiB;
constexpr size_t WS_END = 514 * MiB;
constexpr int MAXPANEL = 136;
static_assert(WS_BIG + (size_t)MAXPANEL * 256 * FFE * 2 <= WS_END && WS_BIG + (size_t)MTOK * N1 * 2 <= WS_END, "ws map");
constexpr int CW_TMO = 0, CW_CODE = 1;
constexpr int CW_CNT = 64;
constexpr int CW_BAR = 4096;

constexpr int RING_BYTES = 151552;
constexpr int LDSCTL_OFF = RING_BYTES, MISC_OFF = LDSCTL_OFF + 320;
constexpr int LDS_BYTES = 155648;
constexpr int NWAVES = 8, NTHR = 512;

#define RLX_AGENT __ATOMIC_RELAXED, __HIP_MEMORY_SCOPE_AGENT
#define LDS_WAIT() asm volatile("s_waitcnt lgkmcnt(0)" ::: "memory")
__device__ __forceinline__ unsigned cvt_pk_bf16(float lo, float hi) { unsigned r; asm volatile("v_cvt_pk_bf16_f32 %0, %1, %2" : "=v"(r) : "v"(lo), "v"(hi)); return r; }
__device__ __forceinline__ float bf_lo(unsigned u) { return __uint_as_float(u << 16); }
__device__ __forceinline__ float bf_hi(unsigned u) { return __uint_as_float(u & 0xffff0000u); }
__device__ __forceinline__ float bf1(bf16_t u) { return __uint_as_float(((unsigned)u) << 16); }
__device__ __forceinline__ float wave_sum(float v) {
#pragma unroll
    for (int o = 1; o < 64; o <<= 1) v += __shfl_xor(v, o);
    return v;
}
__device__ __forceinline__ float wave_max(float v) {
#pragma unroll
    for (int o = 1; o < 64; o <<= 1) v = fmaxf(v, __shfl_xor(v, o));
    return v;
}
__device__ __forceinline__ float sigmoidf_(float x) { return 1.0f / (1.0f + __expf(-x)); }
__device__ __forceinline__ float siluf_(float x) { return x / (1.0f + __expf(-x)); }

namespace pg8 {
constexpr int BM = 256, BK = 64, HALF = 128, HTB = HALF * BK * 2, STAGE_BYTES = 8 * HTB, NXCD = 8, WGM = 8;
__host__ __device__ __forceinline__ int lds_byte(int r, int c) { const int st = (r >> 4) * 2 + (c >> 5), rr = r & 15, cc = c & 31, ob = rr * 64 + cc * 2; return st * 1024 + (ob ^ (((ob >> 9) & 1) << 5)); }
__host__ __device__ __forceinline__ void stage_rc(int b, int& R, int& C) { const int st = b / 1024, sb = b % 1024, swz = sb ^ (((sb >> 9) & 1) << 5); R = (st >> 1) * 16 + swz / 64; C = (st & 1) * 32 + (swz % 64) / 2; }
__host__ __device__ __forceinline__ int perm32(int rho) { const int n = rho >> 4, i = rho & 15; return 8 * (i >> 2) + 4 * n + (i & 3); }

struct Unit { int pm, pn, e, nvalid, lbase; };
struct Gemm { const bf16_t* A; const bf16_t* Bt; int lda; int K; size_t bstride_e; const int* list; };

__device__ __forceinline__ void swz_order(int L, int nM, int nN, int& pm, int& pn) {
    const int nwg = nM * nN; int wgid = L;
    { const int q = nwg / NXCD, r = nwg % NXCD, xcd = wgid % NXCD, off = wgid / NXCD; wgid = (xcd < r ? xcd * (q + 1) : r * (q + 1) + (xcd - r) * q) + off; }
    const int nig = WGM * nN, gid = wgid / nig, fm = gid * WGM, gsz = (nM - fm) < WGM ? (nM - fm) : WGM;
    pm = fm + ((wgid % nig) % gsz); pn = (wgid % nig) / gsz;
}
struct StaticOrder {
    int nM, nN, nwg, G, c;
    __device__ __forceinline__ void init(int M, int N, int G_, int c_) { nM = M / BM; nN = N / BM; nwg = nM * nN; G = G_; c = c_; }
    __device__ __forceinline__ bool next(int i, Unit& u) const {
        const long L = (long)i * G + c; if (L >= nwg) return false;
        swz_order((int)L, nM, nN, u.pm, u.pn); u.e = 0; u.nvalid = BM; u.lbase = 0; return true;
    }
};
struct MoeOrder {
    int nN, NP, G, c; int c0, c1, c2, c3, c4, c5, c6, c7;
    __device__ __forceinline__ void init(const unsigned* cntp, int nN_, int G_, int c_) {
        nN = nN_; G = G_; c = c_;
        c0 = (int)cntp[0]; c1 = (int)cntp[1]; c2 = (int)cntp[2]; c3 = (int)cntp[3]; c4 = (int)cntp[4]; c5 = (int)cntp[5]; c6 = (int)cntp[6]; c7 = (int)cntp[7];
        NP = ((c0 + 255) >> 8) + ((c1 + 255) >> 8) + ((c2 + 255) >> 8) + ((c3 + 255) >> 8) + ((c4 + 255) >> 8) + ((c5 + 255) >> 8) + ((c6 + 255) >> 8) + ((c7 + 255) >> 8);
        if (NP > MAXPANEL) NP = MAXPANEL;
    }
    __device__ __forceinline__ bool next(int i, Unit& u) const {
        const long L = (long)i * G + c; if (L >= (long)NP * nN) return false;
        int pm, pn; swz_order((int)L, NP, nN, pm, pn);
        int e = 0, ps = 0, ce = c0;
#define MOE_STEP(CN, CNEXT, EI) { const int np = ((CN) + 255) >> 8; if (e == (EI) - 1 && pm >= ps + np) { ps += np; e = (EI); ce = (CNEXT); } }
        MOE_STEP(c0, c1, 1) MOE_STEP(c1, c2, 2) MOE_STEP(c2, c3, 3) MOE_STEP(c3, c4, 4) MOE_STEP(c4, c5, 5) MOE_STEP(c5, c6, 6) MOE_STEP(c6, c7, 7)
#undef MOE_STEP
        const int local = pm - ps; int nv = ce - local * 256; nv = nv > 256 ? 256 : nv; nv = nv < 1 ? 1 : nv;
        u.pm = pm; u.pn = pn; u.e = e; u.nvalid = nv; u.lbase = e * MTOK + local * 256; return true;
    }
};

__device__ __forceinline__ float row_rstd(const float* SS, int row, int fq) {
    const f32x4 p = *(const f32x4*)(SS + (size_t)row * 16 + 4 * fq);
    float s = (p[0] + p[1]) + (p[2] + p[3]); s += __shfl_xor(s, 16); s += __shfl_xor(s, 32);
    return rsqrtf(s * (1.0f / DM) + EPS);
}

struct EpiIn {
    static constexpr bool PERM = true;
    bf16_t* O; int ldc; const float* SS; const float* rope; float* LOGF; float* IW; const float* bfox; int layer;
    __device__ __forceinline__ int kind_of(int g64) const {
        if (layer == 0) { if (g64 < 8) return 1; if (g64 < 16) return 3; if (g64 < 32) return 0; if (g64 < 34) return 2; if (g64 < 36) return 0; if (g64 < 40) return 4; if (g64 == 40) return 2; if (g64 == 41) return 5; return 0; }
        if (g64 >= 8 && g64 < 16) return 3; if (g64 >= 40 && g64 < 48) return 2; return 0;
    }
    __device__ __forceinline__ void operator()(const f32x4 (&acc)[2][2][4][2], const Unit& u, int wr, int wc, int fr, int fq) const {
        const int row0 = u.pm * BM + wr * 64 + fr;
        int kind[2]; int colb[2];
#pragma unroll
        for (int bj = 0; bj < 2; ++bj) { colb[bj] = u.pn * BM + bj * HALF + wc * 32; kind[bj] = kind_of(colb[bj] >> 6); }
        const bool anyrope = (kind[0] >= 2 && kind[0] <= 4) || (kind[1] >= 2 && kind[1] <= 4);
        const int i0 = (((wc & 1) * 32) + 8 * fq) >> 1;
#pragma unroll
        for (int ai = 0; ai < 2; ++ai)
#pragma unroll
            for (int m = 0; m < 4; ++m) {
                const int row = row0 + ai * HALF + m * 16;
                const float rs = row_rstd(SS, row, fq);
                f32x4 cs0 = (f32x4){1.f, 0.f, 1.f, 0.f}, cs1 = cs0;
                if (anyrope) { const float* rp = rope + ((size_t)(row & (SEQ - 1)) * 32 + i0) * 2; cs0 = *(const f32x4*)rp; cs1 = *(const f32x4*)(rp + 4); }
#pragma unroll
                for (int bj = 0; bj < 2; ++bj) {
                    f32x4 v0 = acc[ai][bj][m][0] * rs, v1 = acc[ai][bj][m][1] * rs;
                    const int kd = kind[bj];
                    if (kd >= 2 && kd <= 4) {
                        f32x4 a, b;
                        a[0] = v0[0] * cs0[0] - v0[1] * cs0[1]; a[1] = v0[1] * cs0[0] + v0[0] * cs0[1];
                        a[2] = v0[2] * cs0[2] - v0[3] * cs0[3]; a[3] = v0[3] * cs0[2] + v0[2] * cs0[3];
                        b[0] = v1[0] * cs1[0] - v1[1] * cs1[1]; b[1] = v1[1] * cs1[0] + v1[0] * cs1[1];
                        b[2] = v1[2] * cs1[2] - v1[3] * cs1[3]; b[3] = v1[3] * cs1[2] + v1[2] * cs1[3];
                        v0 = a; v1 = b;
                    }
                    const float sc = (kd == 1 || kd == 3) ? C2 : (kd == 4 ? 0.125f : 1.0f);
                    if (kd == 5 && (wc & 1) == 0) {
                        if (fq == 0) { f32x4 l0, l1;
#pragma unroll
                            for (int j = 0; j < 4; ++j) { const float x0 = v0[j] + bfox[j], x1 = v1[j] + bfox[4 + j];
                                l0[j] = fminf(x0, 0.f) - log1pf(__expf(-fabsf(x0))); l1[j] = fminf(x1, 0.f) - log1pf(__expf(-fabsf(x1))); }
                            *(f32x4*)(LOGF + (size_t)row * 8) = l0; *(f32x4*)(LOGF + (size_t)row * 8 + 4) = l1; }
                        if (fq == 1) { *(f32x4*)(IW + (size_t)row * 4) = v0 * 0.5f; }
                    }
                    v0 = v0 * sc; v1 = v1 * sc;
                    u32x4 w; w.x = cvt_pk_bf16(v0[0], v0[1]); w.y = cvt_pk_bf16(v0[2], v0[3]); w.z = cvt_pk_bf16(v1[0], v1[1]); w.w = cvt_pk_bf16(v1[2], v1[3]);
                    *(u32x4*)(O + (size_t)row * ldc + colb[bj] + 8 * fq) = w;
                }
            }
    }
};
struct EpiRes {
    static constexpr bool PERM = false;
    const float* base; float* out; bf16_t* xb; float* SS;
    __device__ __forceinline__ void operator()(const f32x4 (&acc)[2][2][4][2], const Unit& u, int wr, int wc, int fr, int fq) const {
        const int col0 = u.pn * BM + wc * 32 + 4 * fq;
#pragma unroll
        for (int ai = 0; ai < 2; ++ai)
#pragma unroll
            for (int m = 0; m < 4; ++m) {
                const int row = u.pm * BM + ai * HALF + wr * 64 + m * 16 + fr; float ssq = 0.f;
#pragma unroll
                for (int bj = 0; bj < 2; ++bj)
#pragma unroll
                    for (int n = 0; n < 2; ++n) {
                        const size_t off = (size_t)row * DM + col0 + bj * HALF + n * 16;
                        const f32x4 o = *(const f32x4*)(base + off) + acc[ai][bj][m][n];
                        *(f32x4*)(out + off) = o; ssq += (o[0] * o[0] + o[1] * o[1]) + (o[2] * o[2] + o[3] * o[3]);
                        u32x2 w; w.x = cvt_pk_bf16(o[0], o[1]); w.y = cvt_pk_bf16(o[2], o[3]); *(u32x2*)(xb + off) = w;
                    }
                ssq += __shfl_xor(ssq, 16); ssq += __shfl_xor(ssq, 32);
                if (fq == 0) SS[(size_t)row * 16 + u.pn * 4 + wc] = ssq;
            }
    }
};
template <bool MOE> struct EpiGU {
    static constexpr bool PERM = true;
    bf16_t* H; int ldh; const float* SS; const int* list;
    __device__ __forceinline__ void operator()(const f32x4 (&acc)[2][2][4][2], const Unit& u, int wr, int wc, int fr, int fq) const {
        const int hcol = u.pn * HALF + wc * 32 + 8 * fq;
#pragma unroll
        for (int ai = 0; ai < 2; ++ai)
#pragma unroll
            for (int m = 0; m < 4; ++m) {
                const int rl = ai * HALF + wr * 64 + m * 16 + fr;
                int tok = u.pm * BM + rl;
                if (MOE) { const int rc = rl < u.nvalid ? rl : u.nvalid - 1; tok = list[u.lbase + rc]; }
                const float rs = row_rstd(SS, tok, fq);
                unsigned w[4];
#pragma unroll
                for (int n = 0; n < 2; ++n) { float h[4];
#pragma unroll
                    for (int j = 0; j < 4; ++j) { const float g = acc[ai][0][m][n][j] * rs, uu = acc[ai][1][m][n][j] * rs; h[j] = siluf_(g) * uu; }
                    w[2 * n] = cvt_pk_bf16(h[0], h[1]); w[2 * n + 1] = cvt_pk_bf16(h[2], h[3]); }
                *(u32x4*)(H + (size_t)(u.pm * BM + rl) * ldh + hcol) = (u32x4){w[0], w[1], w[2], w[3]};
            }
    }
};
struct EpiMoeDown {
    static constexpr bool PERM = false;
    float* x; const int* list; const float* gate;
    __device__ __forceinline__ void operator()(const f32x4 (&acc)[2][2][4][2], const Unit& u, int wr, int wc, int fr, int fq) const {
        const int col0 = u.pn * BM + wc * 32 + 4 * fq;
#pragma unroll
        for (int ai = 0; ai < 2; ++ai)
#pragma unroll
            for (int m = 0; m < 4; ++m) {
                const int rl = ai * HALF + wr * 64 + m * 16 + fr;
                if (rl < u.nvalid) {
                    const int tok = list[u.lbase + rl]; const float g = gate[tok];
#pragma unroll
                    for (int bj = 0; bj < 2; ++bj)
#pragma unroll
                        for (int n = 0; n < 2; ++n) { float* p = x + (size_t)tok * DM + col0 + bj * HALF + n * 16; *(f32x4*)p = *(const f32x4*)p + acc[ai][bj][m][n] * g; }
                }
            }
    }
};

template <bool GATHER> __device__ __forceinline__ void a_offsets(const Gemm& g, const Unit& u, const int (&R)[2], const int (&C)[2], unsigned (&ao)[2][2]) {
#pragma unroll
    for (int h = 0; h < 2; ++h)
#pragma unroll
        for (int i = 0; i < 2; ++i) { const int rl = h * HALF + R[i]; size_t row;
            if (GATHER) { const int rc = rl < u.nvalid ? rl : u.nvalid - 1; row = (size_t)g.list[u.lbase + rc]; } else row = (size_t)u.pm * BM + rl;
            ao[h][i] = (unsigned)((row * (size_t)g.lda + C[i]) * 2); }
}

template <class Epi, class Sched, bool GATHER, bool ALIGN_EPI>
__device__ __forceinline__ void gemm_phase(LAS unsigned char* lds, const Gemm g, const Sched& S, const Epi& E) {
    const int tid = threadIdx.x, wid = __builtin_amdgcn_readfirstlane(tid >> 6), lane = tid & 63, wr = wid >> 2, wc = wid & 3, fr = lane & 15, fq = lane >> 4;
    const int K = g.K, nt = K / BK;
    int RR[2], CC[2]; unsigned voffB[2];
#pragma unroll
    for (int i = 0; i < 2; ++i) { int R, C; stage_rc(tid * 16 + i * 8192, R, C); RR[i] = R; CC[i] = C; const int Rb = Epi::PERM ? ((R & ~31) + perm32(R & 31)) : R; voffB[i] = (unsigned)(Rb * K + C) * 2u; }
    const size_t kstep = (size_t)(BK * 2);
    const size_t hstepB = (size_t)HALF * K * 2;
    const size_t tstepB = 2 * hstepB;
    const unsigned ldsw = (unsigned)wid * 1024u;
    const int aoff = lds_byte(wr * 64 + fr, fq * 8), boff = lds_byte(wc * 32 + fr, fq * 8);
#define PG8_SA(b, h) (((b) * 2 + (h)) * HTB)
#define PG8_SB(b, h) ((4 + (b) * 2 + (h)) * HTB)
#define PG8_STAGE_B(bufoff, gbase) do { _Pragma("unroll") for (int _i = 0; _i < 2; ++_i) \
        __builtin_amdgcn_global_load_lds((const unsigned*)((const char*)(gbase) + voffB[_i]), (LAS unsigned*)(lds + (bufoff) + ldsw + _i * 8192), 16, 0, 0); } while (0)
#define PG8_STAGE_A(bufoff, kb, AO) do { _Pragma("unroll") for (int _i = 0; _i < 2; ++_i) \
        __builtin_amdgcn_global_load_lds((const unsigned*)(Ab + (kb) + (AO)[_i]), (LAS unsigned*)(lds + (bufoff) + ldsw + _i * 8192), 16, 0, 0); } while (0)
#define PG8_LDA(dst, b, h) do { _Pragma("unroll") for (int m = 0; m < 4; ++m) _Pragma("unroll") for (int k = 0; k < 2; ++k) dst[m][k] = *(const LAS bf16x8*)(lds + PG8_SA(b, h) + aoff + m * 2048 + k * 1024); } while (0)
#define PG8_LDB(dst, b, h) do { _Pragma("unroll") for (int n = 0; n < 2; ++n) _Pragma("unroll") for (int k = 0; k < 2; ++k) dst[n][k] = *(const LAS bf16x8*)(lds + PG8_SB(b, h) + boff + n * 2048 + k * 1024); } while (0)
#define PG8_MMA(ai, bj, At, Bt) do { __builtin_amdgcn_s_setprio(1); _Pragma("unroll") for (int m = 0; m < 4; ++m) _Pragma("unroll") for (int n = 0; n < 2; ++n) _Pragma("unroll") for (int k = 0; k < 2; ++k) \
        acc[ai][bj][m][n] = __builtin_amdgcn_mfma_f32_16x16x32_bf16(Bt[n][k], At[m][k], acc[ai][bj][m][n], 0, 0, 0); __builtin_amdgcn_s_setprio(0); } while (0)
#define PG8_WAIT_V(n) asm volatile("s_waitcnt vmcnt(" #n ")" ::: "memory")
#define PG8_WAIT_L(n) asm volatile("s_waitcnt lgkmcnt(" #n ")" ::: "memory")
#define PG8_BAR __builtin_amdgcn_s_barrier()
#define PG8_SCHED __builtin_amdgcn_sched_barrier(0)
    Unit cur, nxt; int ui = 0;
    if (!S.next(0, cur)) return;
    f32x4 acc[2][2][4][2];
#pragma unroll
    for (int a = 0; a < 2; ++a)
#pragma unroll
        for (int b = 0; b < 2; ++b)
#pragma unroll
            for (int m = 0; m < 4; ++m)
#pragma unroll
                for (int n = 0; n < 2; ++n) acc[a][b][m][n] = (f32x4){0.f, 0.f, 0.f, 0.f};
    bf16x8 At[4][2], B0[2][2], B1[2][2];
    unsigned cao[2][2], nao[2][2];
    a_offsets<GATHER>(g, cur, RR, CC, cao);
    const char* Ab = (const char*)g.A;
    const char* cB = (const char*)g.Bt + ((size_t)cur.e * g.bstride_e) * 2 + (size_t)cur.pn * tstepB;
    PG8_STAGE_B(PG8_SB(0, 0), cB); PG8_STAGE_B(PG8_SB(0, 1), cB + hstepB); PG8_STAGE_A(PG8_SA(0, 0), 0, cao[0]); PG8_STAGE_A(PG8_SA(0, 1), 0, cao[1]);
    if (wr == 1) PG8_BAR;
    PG8_WAIT_V(2); PG8_BAR;
    PG8_STAGE_B(PG8_SB(1, 0), cB + kstep); PG8_STAGE_A(PG8_SA(1, 0), kstep, cao[0]); PG8_STAGE_B(PG8_SB(1, 1), cB + hstepB + kstep);
    PG8_WAIT_V(6); PG8_BAR;
    for (;;) {
        const bool has_next = S.next(ui + 1, nxt);
        if (has_next) a_offsets<GATHER>(g, nxt, RR, CC, nao);
        else {
#pragma unroll
            for (int h = 0; h < 2; ++h)
#pragma unroll
                for (int i = 0; i < 2; ++i) nao[h][i] = cao[h][i]; }
        const char* nB = has_next ? (const char*)g.Bt + ((size_t)nxt.e * g.bstride_e) * 2 + (size_t)nxt.pn * tstepB : cB;
        for (int t = 0; t < nt; t += 2) {
            const bool last = (t == nt - 2);
            const size_t ka1 = (size_t)(t + 1) * kstep;
            const size_t ka2 = last ? 0 : (size_t)(t + 2) * kstep; const char* b2 = last ? nB : cB + (size_t)(t + 2) * kstep;
            const size_t ka3 = ka2 + kstep; const char* b3 = b2 + kstep;
            unsigned ao2[2][2];
#pragma unroll
            for (int h = 0; h < 2; ++h)
#pragma unroll
                for (int i = 0; i < 2; ++i) ao2[h][i] = last ? nao[h][i] : cao[h][i];
            PG8_LDB(B0, 0, 0); PG8_LDB(B1, 0, 1); PG8_SCHED; PG8_LDA(At, 0, 0); PG8_STAGE_A(PG8_SA(1, 1), ka1, cao[1]);
            PG8_WAIT_V(8); PG8_WAIT_L(0); PG8_BAR; PG8_MMA(0, 0, At, B0); PG8_MMA(0, 1, At, B1); PG8_BAR; PG8_SCHED;
            PG8_LDA(At, 0, 1); PG8_STAGE_B(PG8_SB(0, 0), b2); PG8_STAGE_B(PG8_SB(0, 1), b2 + hstepB); PG8_STAGE_A(PG8_SA(0, 0), ka2, ao2[0]);
            PG8_WAIT_V(8); PG8_WAIT_L(0); PG8_BAR; PG8_MMA(1, 0, At, B0); PG8_MMA(1, 1, At, B1); PG8_BAR; PG8_SCHED;
            PG8_LDB(B0, 1, 0); PG8_LDB(B1, 1, 1); PG8_SCHED; PG8_LDA(At, 1, 0); PG8_STAGE_A(PG8_SA(0, 1), ka2, ao2[1]);
            PG8_WAIT_V(8); PG8_WAIT_L(0); PG8_BAR; PG8_MMA(0, 0, At, B0); PG8_MMA(0, 1, At, B1); PG8_BAR; PG8_SCHED;
            PG8_LDA(At, 1, 1); PG8_STAGE_B(PG8_SB(1, 0), b3); PG8_STAGE_B(PG8_SB(1, 1), b3 + hstepB); PG8_STAGE_A(PG8_SA(1, 0), ka3, ao2[0]);
            PG8_WAIT_V(8); PG8_WAIT_L(0); PG8_BAR; PG8_MMA(1, 0, At, B0); PG8_MMA(1, 1, At, B1); PG8_BAR; PG8_SCHED;
        }
        if constexpr (ALIGN_EPI) { if (wr == 0) PG8_BAR; }
        E(acc, cur, wr, wc, fr, fq);
        if (!has_next) break;
#pragma unroll
        for (int a = 0; a < 2; ++a)
#pragma unroll
            for (int b = 0; b < 2; ++b)
#pragma unroll
                for (int m = 0; m < 4; ++m)
#pragma unroll
                    for (int n = 0; n < 2; ++n) acc[a][b][m][n] = (f32x4){0.f, 0.f, 0.f, 0.f};
        cur = nxt; cB = nB; ++ui;
#pragma unroll
        for (int h = 0; h < 2; ++h)
#pragma unroll
            for (int i = 0; i < 2; ++i) cao[h][i] = nao[h][i];
        if constexpr (ALIGN_EPI) { if (wr == 1) PG8_BAR; }
    }
    PG8_WAIT_V(0);
    if constexpr (!ALIGN_EPI) { if (wr == 0) PG8_BAR; }
    PG8_BAR;
#undef PG8_SA
#undef PG8_SB
#undef PG8_STAGE_A
#undef PG8_STAGE_B
#undef PG8_LDA
#undef PG8_LDB
#undef PG8_MMA
#undef PG8_WAIT_V
#undef PG8_WAIT_L
#undef PG8_BAR
#undef PG8_SCHED
}
}

namespace attn_body {
typedef float f32x4_t __attribute__((ext_vector_type(4)));

using bf16=__hip_bfloat16;
using bf16x8=__attribute__((ext_vector_type(8)))short;
using s16x4=__attribute__((ext_vector_type(4)))short;
using f32x16=__attribute__((ext_vector_type(16)))float;
using u32x4=__attribute__((ext_vector_type(4)))unsigned;
__device__ __forceinline__ u32x4 kbw_(unsigned long long w){ return (u32x4){(unsigned)w,(unsigned)(w>>32),0u,0u}; }
constexpr int D=64;
constexpr int NW=8,QBLK=32,QB=QBLK*NW,KVBLK=64;
__device__ __forceinline__ int crow(int r,int hi){return (r&3)+8*(r>>2)+4*hi;}
#define SBAR() __builtin_amdgcn_sched_barrier(0)
__device__ __forceinline__ void cmask(f32x16&p0,f32x16&p1,int jb,int qrel,int hi){
  const float NEG=-INFINITY; int kb=64*jb+4*hi;
  #pragma unroll
  for(int r=0;r<16;++r){int kv=kb+(r&3)+8*(r>>2); if(kv>qrel)p0[r]=NEG; if(kv+32>qrel)p1[r]=NEG;}
}

constexpr int NSLOT=3, SLOTB=8192;
constexpr int LDS_K=0, LDS_V=NSLOT*SLOTB, LDS_WS=2*NSLOT*SLOTB, LDS_OST=LDS_WS+NW*64*4, LDS_X=LDS_OST+NW*4096, LDS_BYTES=LDS_X+65536;
constexpr float C2A=0.125f*1.4426950408889634f;
__device__ __forceinline__ void glds16(const void*gsrc,unsigned lds_dst){unsigned keep;
  asm volatile("s_mov_b32 %0, m0\n\ts_mov_b32 m0, %2\n\ts_nop 0\n\tglobal_load_lds_dwordx4 %1, off\n\ts_mov_b32 m0, %0":"=&s"(keep):"v"(gsrc),"s"(lds_dst):"memory");}
__device__ __forceinline__ float max3f(float a,float b,float c){float r;asm("v_max3_f32 %0, %1, %2, %3":"=v"(r):"v"(a),"v"(b),"v"(c));return r;}
__device__ __forceinline__ float max2f(float a,float b){float r;asm("v_max_f32_e32 %0, %1, %2":"=v"(r):"v"(a),"v"(b));return r;}
__device__ __forceinline__ float fadd_s(float a,float b){float r;asm("v_add_f32_e32 %0, %1, %2":"=v"(r):"v"(a),"v"(b));return r;}
__device__ __forceinline__ float fsub_s(float a,float b){float r;asm("v_sub_f32_e32 %0, %1, %2":"=v"(r):"v"(a),"v"(b));return r;}
typedef float f32x2_t __attribute__((ext_vector_type(2))); typedef __bf16 bf16x2_t __attribute__((ext_vector_type(2)));
__device__ __forceinline__ unsigned cvtpk_s(float lo,float hi){f32x2_t v={lo,hi};bf16x2_t b=__builtin_convertvector(v,bf16x2_t);return __builtin_bit_cast(unsigned,b);}
#define WAIT_BAR(N) asm volatile("s_waitcnt vmcnt(" #N ") lgkmcnt(0)\n\ts_barrier":::"memory")

__device__ __forceinline__ void qkt(f32x16&p0,f32x16&p1,const char*Kslot,const bf16x8*qr,const f32x16&negm,int r32,int hi){
  const char*kb=Kslot+hi*1024+r32*16;
  #pragma unroll
  for(int d0=0;d0<4;++d0){
    const bf16x8 b0=*reinterpret_cast<const bf16x8*>(kb+d0*2048);
    const bf16x8 b1=*reinterpret_cast<const bf16x8*>(kb+d0*2048+512);
    if(d0==0){p0=__builtin_amdgcn_mfma_f32_32x32x16_bf16(b0,qr[0],negm,0,0,0);p1=__builtin_amdgcn_mfma_f32_32x32x16_bf16(b1,qr[0],negm,0,0,0);}
    else{p0=__builtin_amdgcn_mfma_f32_32x32x16_bf16(b0,qr[d0],p0,0,0,0);p1=__builtin_amdgcn_mfma_f32_32x32x16_bf16(b1,qr[d0],p1,0,0,0);}}
}
typedef __attribute__((address_space(3))) const char* lds_cptr;
typedef short v4i16_t __attribute__((ext_vector_type(4)));
__device__ __forceinline__ void kload8(bf16x8*kf,lds_cptr kp){
  kf[0]=*(const __attribute__((address_space(3))) bf16x8*)(kp);      kf[1]=*(const __attribute__((address_space(3))) bf16x8*)(kp+512);
  kf[2]=*(const __attribute__((address_space(3))) bf16x8*)(kp+2048); kf[3]=*(const __attribute__((address_space(3))) bf16x8*)(kp+2560);
  kf[4]=*(const __attribute__((address_space(3))) bf16x8*)(kp+4096); kf[5]=*(const __attribute__((address_space(3))) bf16x8*)(kp+4608);
  kf[6]=*(const __attribute__((address_space(3))) bf16x8*)(kp+6144); kf[7]=*(const __attribute__((address_space(3))) bf16x8*)(kp+6656);
}
__device__ __forceinline__ void kload2(bf16x8*kf,lds_cptr kp,int j){ kf[2*j]=*(const __attribute__((address_space(3))) bf16x8*)(kp+j*2048); kf[2*j+1]=*(const __attribute__((address_space(3))) bf16x8*)(kp+j*2048+512); }
__device__ __forceinline__ s16x4 vtr(lds_cptr p){ return __builtin_bit_cast(s16x4,__builtin_amdgcn_ds_read_tr16_b64_v4i16((__attribute__((address_space(3))) v4i16_t*)p)); }
__device__ __forceinline__ float rowmax(const f32x16&p0,const f32x16&p1){
  float a=max3f(p0[0],p0[1],p1[0]),b=max3f(p0[2],p0[3],p1[1]);a=max3f(a,p1[2],p1[3]);
  #pragma unroll
  for(int r=4;r<16;r+=4){a=max3f(a,p0[r],p0[r+1]);b=max3f(b,p0[r+2],p0[r+3]);a=max3f(a,p1[r],p1[r+1]);b=max3f(b,p1[r+2],p1[r+3]);}
  const float m=max2f(a,b);
  auto rr=__builtin_amdgcn_permlane32_swap(__float_as_uint(m),__float_as_uint(m),false,false);
  return max2f(__uint_as_float(rr[0]),__uint_as_float(rr[1]));
}
__device__ __forceinline__ void pv(f32x16*o,int vb,bf16x8 pa0,bf16x8 pa1,bf16x8 pa2,bf16x8 pa3){
  #pragma unroll
  for(int d0=0;d0<2;++d0){s16x4 lo[4],hi[4];
    #pragma unroll
    for(int ks=0;ks<4;++ks){
      asm volatile("ds_read_b64_tr_b16 %0,%1 offset:%c2":"=&v"(lo[ks]):"v"(vb),"i"(d0*4096+ks*1024):"memory");
      asm volatile("ds_read_b64_tr_b16 %0,%1 offset:%c2":"=&v"(hi[ks]):"v"(vb),"i"(d0*4096+ks*1024+512):"memory");}
    asm volatile("s_waitcnt lgkmcnt(0)":::"memory");SBAR();
    #define PK(k) (bf16x8){lo[k][0],lo[k][1],lo[k][2],lo[k][3],hi[k][0],hi[k][1],hi[k][2],hi[k][3]}
    o[d0]=__builtin_amdgcn_mfma_f32_32x32x16_bf16(pa0,PK(0),o[d0],0,0,0);
    o[d0]=__builtin_amdgcn_mfma_f32_32x32x16_bf16(pa1,PK(1),o[d0],0,0,0);
    o[d0]=__builtin_amdgcn_mfma_f32_32x32x16_bf16(pa2,PK(2),o[d0],0,0,0);
    o[d0]=__builtin_amdgcn_mfma_f32_32x32x16_bf16(pa3,PK(3),o[d0],0,0,0);
    #undef PK
  }
}

#ifndef ATTN_STORE16
#define ATTN_STORE16(p,v) (*(u32x4*)(p)=(v))
#endif
template<int THRL,int MODE,int qp,int kvp,int op,int QBI> __device__ __forceinline__ void attn_unit(const bf16*Qb,const bf16*__restrict__ Kb,const bf16*__restrict__ Vb,bf16*Ob,char*shm,const float*cb,const unsigned long long*maskb){
  constexpr int q0=QBI*QB;
  int tid_=threadIdx.x; asm volatile("":"+v"(tid_));
  const int tid=tid_,lane=tid&63,r32=lane&31,hi=lane>>5; const int wid=__builtin_amdgcn_readfirstlane(tid>>6);
  const bf16*Qw=Qb+(long)(q0+wid*QBLK)*qp;
  const bf16*Kh=Kb,*Vh=Vb;
  const unsigned lds0=(unsigned)(uintptr_t)shm;
  float*wsf=(float*)(shm+LDS_WS)+wid*64;
  const lds_cptr shm3=(lds_cptr)shm;
  const bf16*ksrc=Kh+(long)lane*kvp+wid*8;
  const bf16*vsrc=Vh+(long)(16*(wid&3)+(lane>>2))*kvp+(wid>>2)*32+(lane&3)*8;
  const unsigned kdst=lds0+LDS_K+wid*1024, vdst=lds0+LDS_V+wid*1024;
  #define DMA_K(t,slot) glds16(ksrc+(long)(t)*KVBLK*kvp,(unsigned)__builtin_amdgcn_readfirstlane(kdst+(slot)))
  #define DMA_V(t,slot) glds16(vsrc+(long)(t)*KVBLK*kvp,(unsigned)__builtin_amdgcn_readfirstlane(vdst+(slot)))
  const int vb0=(int)(lds0+LDS_V)+((lane>>4)&1)*32+(lane&3)*8+(4*hi+((lane&15)>>2))*64;
  const char*Kbase=shm+LDS_K; bf16x8 kf[8];
  const lds_cptr kp0=shm3+LDS_K+hi*1024+r32*16; const lds_cptr vp0=shm3+LDS_V+((lane>>4)&1)*32+(lane&3)*8+(4*hi+((lane&15)>>2))*64;
  const int NT=(q0+QB)/KVBLK;
  typedef __attribute__((address_space(3))) unsigned long long* lds_u64p;
  const lds_u64p xq=(lds_u64p)(shm3+LDS_X);
  if(MODE==1){ const int s0=4*tid; if(s0<q0+QB){ const f32x4_t c=*reinterpret_cast<const f32x4_t*>(cb+s0); unsigned w[8];
      _Pragma("unroll") for(int j=0;j<4;++j){ const float x=-c[j]*1.4426950408889634f; const unsigned p1=cvtpk_s(x,0.f)&0xffffu; const float r1=x-__uint_as_float(p1<<16);
        const unsigned p2=cvtpk_s(r1,0.f)&0xffffu; const float r2=r1-__uint_as_float(p2<<16); const unsigned p3=cvtpk_s(r2,0.f)&0xffffu; w[2*j]=p1|(p2<<16); w[2*j+1]=p3; }
      *(__attribute__((address_space(3))) u32x4*)(shm3+LDS_X+s0*8)=(u32x4){w[0],w[1],w[2],w[3]}; *(__attribute__((address_space(3))) u32x4*)(shm3+LDS_X+s0*8+16)=(u32x4){w[4],w[5],w[6],w[7]}; } }
  if(MODE==2){ const int npc=((q0+QB)/KVBLK)*128; for(int i=tid;i<npc;i+=NW*64){ const int tile=i>>7,pc=i&127;
      const u32x4 v=*reinterpret_cast<const u32x4*>(maskb+(long)tile*2048+q0+2*pc); *(__attribute__((address_space(3))) u32x4*)(shm3+LDS_X+(tile*256+2*pc)*8)=v; } }
  const unsigned long long himask=hi?0ull:~0ull;
  const bf16x8 qone=__builtin_bit_cast(bf16x8,(u32x4){0x3f803f80u,0x00003f80u,0u,0u});
  #define KBF(t,half) __builtin_bit_cast(bf16x8,kbw_((xq[(t)*64+(half)*32+r32])&himask))
  #define BIAS(P0,P1,t) do{ if(MODE==1){ P0=__builtin_amdgcn_mfma_f32_32x32x16_bf16(KBF(t,0),qone,P0,0,0,0); P1=__builtin_amdgcn_mfma_f32_32x32x16_bf16(KBF(t,1),qone,P1,0,0,0); } }while(0)
  unsigned mlo=0u,mhi=0u;
  #define MLOAD(t) do{ if(MODE==2){ const unsigned long long mw_=xq[(t)*256+wid*QBLK+r32]>>(4*hi); mlo=(unsigned)mw_; mhi=(unsigned)(mw_>>32); } }while(0)
  #define MBIT(r) (((r)&3)+8*((r)>>2))
  #define EXM(v,r,W) ((MODE==2)?__uint_as_float(__float_as_uint(__builtin_amdgcn_exp2f(v))&(unsigned)__builtin_amdgcn_sbfe((int)(W),MBIT(r),1)):__builtin_amdgcn_exp2f(v))
  DMA_K(0,0);DMA_V(0,0);DMA_K(1,SLOTB);
  bf16x8 qr[4];
  #pragma unroll
  for(int d0=0;d0<4;++d0)qr[d0]=*reinterpret_cast<const bf16x8*>(&Qw[(long)r32*qp+d0*16+hi*8]);
  float mhat=0.f,l_reg=0.f;f32x16 o[2];o[0]=f32x16{};o[1]=f32x16{};f32x16 negm=f32x16{};asm volatile("":"+v"(negm));
  const int qrel=wid*QBLK+r32;
  #define CMASK(P0,P1,t) do{ if(MODE!=2){int jb_=(t)-(NT-4); if(jb_>=0)cmask(P0,P1,jb_,qrel,hi);} }while(0)
  bool resc=false;
  #define START(P0,P1) do{ const float rm=rowmax(P0,P1); resc=false; \
    { const float dl=rm; mhat=fadd_s(mhat,dl); \
      _Pragma("unroll") for(int r=0;r<16;++r){P0[r]=fsub_s(P0[r],dl);P1[r]=fsub_s(P1[r],dl);} \
      _Pragma("unroll") for(int r=0;r<16;++r)negm[r]=-mhat; asm volatile("":"+v"(negm)); } \
    _Pragma("unroll") for(int r=0;r<16;++r)P0[r]=EXM(P0[r],r,mlo); }while(0)
  #define RESC() do{ if(resc){ asm volatile("s_waitcnt lgkmcnt(0)":::"memory"); \
      _Pragma("unroll") for(int d_=0;d_<2;++d_) _Pragma("unroll") for(int r=0;r<16;++r)o[d_][r]*=wsf[crow(r,hi)]; } }while(0)
  f32x16 pA0,pA1,pB0,pB1;
  int sl_prev=0,sl_cur=0,sl_next=SLOTB;
  #define ROT() do{sl_prev=sl_cur;sl_cur=sl_next;sl_next=(sl_next==(NSLOT-1)*SLOTB)?0:sl_next+SLOTB;}while(0)
  DMA_K(2,2*SLOTB);
  WAIT_BAR(3);
  qkt(pA0,pA1,Kbase,qr,negm,r32,hi);BIAS(pA0,pA1,0);asm volatile("s_nop 15\n\ts_nop 7":"+v"(pA0),"+v"(pA1));CMASK(pA0,pA1,0);MLOAD(0);
  START(pA0,pA1);
  _Pragma("unroll") for(int r=0;r<16;++r)pA1[r]=EXM(pA1[r],r,mhi);
  WAIT_BAR(0);
  DMA_K(3,0);DMA_V(1,SLOTB);
  ROT();
  kload8(kf,kp0+sl_cur);
  WAIT_BAR(2);
  s16x4 vlo[8],vhi[8]; u32x4 pw0,pw1,pw2,pw3;
  #define PKW(P,B) cvtpk_s(P[B],P[B+1])
  #define PAF(k) __builtin_bit_cast(bf16x8,pw##k)
  #define VFR(i) (bf16x8){vlo[i][0],vlo[i][1],vlo[i][2],vlo[i][3],vhi[i][0],vhi[i][1],vhi[i][2],vhi[i][3]}
  #define PIN(x) asm volatile("":"+v"(x))
  #define MX3(a,b,c) __builtin_fmaxf(__builtin_fmaxf((a),(b)),(c))
  #define GAPA(MF,A0,A1,A2,A3,W0,W1,PW) do{ MF; sacc+=A0; sacc+=A1; sacc+=A2; sacc+=A3; PIN(sacc); W0; W1; PIN(PW); SBAR(); }while(0)
  #define EX(v) __builtin_amdgcn_exp2f(v)
  #define GAPB(MF,X,B,W) do{ MF; X[B]=EXM(X[B],B,W); X[B+1]=EXM(X[B+1],B+1,W); X[B+2]=EXM(X[B+2],B+2,W); X[B+3]=EXM(X[B+3],B+3,W); PIN(X); SBAR(); }while(0)
  #define VRD(i) do{ vlo[i]=vtr(vp_+(((i)>>2)*4096+((i)&3)*1024)); vhi[i]=vtr(vp_+(((i)>>2)*4096+((i)&3)*1024+512)); }while(0)
  #define KRD(G,j) do{ if(G){ kload2(kf,kp0+sl_next,j); SBAR(); } }while(0)
  #define STEP(C0,C1,P0,P1,t,GK,GV,GL) do{ SBAR(); \
    const lds_cptr vp_=vp0+sl_prev; \
    VRD(0); SBAR(); float sacc=(P0[0]+P0[1]); \
    GAPA(C0=__builtin_amdgcn_mfma_f32_32x32x16_bf16(kf[0],qr[0],negm,0,0,0), P0[2],P0[3],P0[4],P0[5],     pw0[0]=PKW(P0,0), pw0[1]=PKW(P0,2), pw0); \
    VRD(4); SBAR(); GAPA(C1=__builtin_amdgcn_mfma_f32_32x32x16_bf16(kf[1],qr[0],negm,0,0,0), P0[6],P0[7],P0[8],P0[9],     pw0[2]=PKW(P0,4), pw0[3]=PKW(P0,6), pw0); \
    VRD(1); SBAR(); GAPA(C0=__builtin_amdgcn_mfma_f32_32x32x16_bf16(kf[2],qr[1],C0,0,0,0),   P0[10],P0[11],P0[12],P0[13], pw1[0]=PKW(P0,8), pw1[1]=PKW(P0,10), pw1); \
    VRD(5); SBAR(); GAPA(C1=__builtin_amdgcn_mfma_f32_32x32x16_bf16(kf[3],qr[1],C1,0,0,0),   P0[14],P0[15],P1[0],P1[1],   pw1[2]=PKW(P0,12),pw1[3]=PKW(P0,14), pw1); \
    VRD(2); SBAR(); GAPA(C0=__builtin_amdgcn_mfma_f32_32x32x16_bf16(kf[4],qr[2],C0,0,0,0),   P1[2],P1[3],P1[4],P1[5],     pw2[0]=PKW(P1,0), pw2[1]=PKW(P1,2), pw2); \
    VRD(6); SBAR(); GAPA(C1=__builtin_amdgcn_mfma_f32_32x32x16_bf16(kf[5],qr[2],C1,0,0,0),   P1[6],P1[7],P1[8],P1[9],     pw2[2]=PKW(P1,4), pw2[3]=PKW(P1,6), pw2); \
    VRD(3); SBAR(); GAPA(C0=__builtin_amdgcn_mfma_f32_32x32x16_bf16(kf[6],qr[3],C0,0,0,0),   P1[10],P1[11],P1[12],P1[13], pw3[0]=PKW(P1,8), pw3[1]=PKW(P1,10), pw3); \
    VRD(7); SBAR(); GAPA(C1=__builtin_amdgcn_mfma_f32_32x32x16_bf16(kf[7],qr[3],C1,0,0,0),   P1[14],P1[15],0.f,0.f,       pw3[2]=PKW(P1,12),pw3[3]=PKW(P1,14), pw3); \
    l_reg+=sacc; BIAS(C0,C1,t); MLOAD(t); \
    if(GK){DMA_K((t)+3,sl_cur);} if(GV){DMA_V((t)+1,sl_next);} \
    CMASK(C0,C1,t); \
    { float a=MX3(C0[0],C0[1],C1[0]),b=MX3(C0[2],C0[3],C1[1]); a=MX3(a,C1[2],C1[3]); \
      _Pragma("unroll") for(int r=4;r<16;r+=4){a=MX3(a,C0[r],C0[r+1]);b=MX3(b,C0[r+2],C0[r+3]);a=MX3(a,C1[r],C1[r+1]);b=MX3(b,C1[r+2],C1[r+3]);} \
      float rm=__builtin_fmaxf(a,b); { auto rr=__builtin_amdgcn_permlane32_swap(__float_as_uint(rm),__float_as_uint(rm),false,false); rm=__builtin_fmaxf(__uint_as_float(rr[0]),__uint_as_float(rr[1])); } \
      resc=false; \
      if(__builtin_expect(__any(rm>(float)THRL),0)){ const float dl=__builtin_fmaxf(rm,0.f); mhat+=dl; \
        _Pragma("unroll") for(int r=0;r<16;++r){C0[r]-=dl;C1[r]-=dl;} \
        _Pragma("unroll") for(int r=0;r<16;++r)negm[r]=-mhat; asm volatile("":"+v"(negm)); \
        const float f=__builtin_amdgcn_exp2f(-dl); l_reg*=f; if(hi==0)wsf[r32]=f; resc=true; } } \
    SBAR(); \
    GAPB(o[0]=__builtin_amdgcn_mfma_f32_32x32x16_bf16(PAF(0),VFR(0),o[0],0,0,0), C0,0,mlo); \
    GAPB(o[1]=__builtin_amdgcn_mfma_f32_32x32x16_bf16(PAF(0),VFR(4),o[1],0,0,0), C0,4,mlo); \
    KRD(GL,0); GAPB(o[0]=__builtin_amdgcn_mfma_f32_32x32x16_bf16(PAF(1),VFR(1),o[0],0,0,0), C0,8,mlo); \
    KRD(GL,1); GAPB(o[1]=__builtin_amdgcn_mfma_f32_32x32x16_bf16(PAF(1),VFR(5),o[1],0,0,0), C0,12,mlo); \
    KRD(GL,2); GAPB(o[0]=__builtin_amdgcn_mfma_f32_32x32x16_bf16(PAF(2),VFR(2),o[0],0,0,0), C1,0,mhi); \
    KRD(GL,3); GAPB(o[1]=__builtin_amdgcn_mfma_f32_32x32x16_bf16(PAF(2),VFR(6),o[1],0,0,0), C1,4,mhi); \
    GAPB(o[0]=__builtin_amdgcn_mfma_f32_32x32x16_bf16(PAF(3),VFR(3),o[0],0,0,0), C1,8,mhi); \
    GAPB(o[1]=__builtin_amdgcn_mfma_f32_32x32x16_bf16(PAF(3),VFR(7),o[1],0,0,0), C1,12,mhi); \
    }while(0)
  int t=1;
  #undef CMASK
  #define CMASK(P0,P1,t) do{}while(0)
  for(;t+5<NT;t+=2){
    STEP(pB0,pB1,pA0,pA1,t,true,true,true);     WAIT_BAR(2); RESC(); ROT();
    STEP(pA0,pA1,pB0,pB1,t+1,true,true,true);   WAIT_BAR(2); RESC(); ROT();
  }
  #undef CMASK
  #define CMASK(P0,P1,t) do{ if(MODE!=2){int jb_=(t)-(NT-4); if(jb_>=0)cmask(P0,P1,jb_,qrel,hi);} }while(0)
  #define ENDW(tt) do{ if((tt)+3<NT){WAIT_BAR(2);} else if((tt)+2<NT){WAIT_BAR(1);} else {WAIT_BAR(0);} }while(0)
  for(;t+1<NT;t+=2){
    STEP(pB0,pB1,pA0,pA1,t,(t+3<NT),(t+1<NT),(t+1<NT));       ENDW(t);   RESC(); ROT();
    STEP(pA0,pA1,pB0,pB1,t+1,(t+4<NT),(t+2<NT),(t+2<NT));     ENDW(t+1); RESC(); ROT();
  }
  STEP(pB0,pB1,pA0,pA1,NT-1,false,false,false); RESC();
  { float sacc=pB0[0]+pB0[1]; _Pragma("unroll") for(int r=2;r<16;++r)sacc+=pB0[r]; _Pragma("unroll") for(int r=0;r<16;++r)sacc+=pB1[r]; l_reg+=sacc;
    pw0=(u32x4){PKW(pB0,0),PKW(pB0,2),PKW(pB0,4),PKW(pB0,6)};pw1=(u32x4){PKW(pB0,8),PKW(pB0,10),PKW(pB0,12),PKW(pB0,14)};pw2=(u32x4){PKW(pB1,0),PKW(pB1,2),PKW(pB1,4),PKW(pB1,6)};pw3=(u32x4){PKW(pB1,8),PKW(pB1,10),PKW(pB1,12),PKW(pB1,14)};
    SBAR(); pv(o,vb0+sl_cur,PAF(0),PAF(1),PAF(2),PAF(3)); }
  #undef PKW
  #undef PAF
  #undef VFR
  #undef PIN
  #undef MX3
  #undef GAPA
  #undef GAPB
  #undef EX
  #undef VRD
  #undef KRD
  #undef STEP
  #undef ENDW
  {auto rr=__builtin_amdgcn_permlane32_swap(__float_as_uint(l_reg),__float_as_uint(l_reg),false,false);l_reg=__uint_as_float(rr[0])+__uint_as_float(rr[1]);}
  if(hi==0)wsf[32+r32]=l_reg;asm volatile("s_waitcnt lgkmcnt(0)":::"memory");
  float rli[16];
  #pragma unroll
  for(int r=0;r<16;++r)rli[r]=__builtin_amdgcn_rcpf(wsf[32+crow(r,hi)]);
  bf16*Ow=Ob+(long)(q0+wid*QBLK)*op;
  { bf16*stg=(bf16*)(shm+LDS_OST)+wid*2048;
    #pragma unroll
    for(int r=0;r<16;++r){const int orow=crow(r,hi);
      #pragma unroll
      for(int d0=0;d0<2;++d0)stg[orow*64+d0*32+r32]=__float2bfloat16(o[d0][r]*rli[r]);}
    asm volatile("s_waitcnt lgkmcnt(0)":::"memory");
    #pragma unroll
    for(int i=0;i<4;++i){const int row=i*8+(lane>>3),ch=lane&7; const u32x4 v=*(const u32x4*)(stg+row*64+ch*8); ATTN_STORE16(Ow+(long)row*op+ch*8,v);} }
  asm volatile("s_waitcnt lgkmcnt(0)\n\ts_barrier":::"memory");
  #undef KBF
  #undef BIAS
  #undef MLOAD
  #undef MBIT
  #undef EXM
  #undef DMA_K
  #undef DMA_V
  #undef CMASK
  #undef START
  #undef RESC
  #undef ROT
}
#undef SBAR
#undef WAIT_BAR
}

#define XB_TMO      128
#define XB_XCNT(j)  (256  + 64 * (j))
#define XB_XSUB(j)  (1280 + 64 * (j))
#define XB_XGEN(j)  (2304 + 64 * (j))
#define XB_TOP      3328
#define XB_TOPGEN   3392
#define XCD_BAR_WORDS 3456
#define XB_SPIN_CAP (1u << 18)
__device__ __forceinline__ unsigned xb_ld(unsigned* p)              { return __hip_atomic_load(p, __ATOMIC_RELAXED, __HIP_MEMORY_SCOPE_AGENT); }
__device__ __forceinline__ unsigned xb_add(unsigned* p, unsigned v) { return __hip_atomic_fetch_add(p, v, __ATOMIC_RELAXED, __HIP_MEMORY_SCOPE_AGENT); }
__device__ __forceinline__ unsigned xb_xcc_id() { return (unsigned)__builtin_amdgcn_s_getreg((3 << 11) | 20) & 0xFu; }
#define XB_SPIN(cond, bar) do { unsigned _sp = 0; while (cond) { __builtin_amdgcn_s_sleep(1); \
    if ((++_sp & 255u) == 0u) { if (xb_ld(&(bar)[XB_TMO])) break; if (_sp > XB_SPIN_CAP) { atomicAdd(&(bar)[XB_TMO], 1u); break; } } } } while (0)
struct XcdBarrier { unsigned* bar; unsigned x; volatile LAS unsigned* st; };
__device__ __forceinline__ XcdBarrier xcd_barrier_post(unsigned* bar, volatile LAS unsigned* st) {
    XcdBarrier b; b.bar = bar; b.x = xb_xcc_id(); b.st = st;
    if (threadIdx.x == 0) (void)xb_add(&bar[XB_XCNT(b.x)], 1u);
    return b;
}
__device__ __forceinline__ void xcd_barrier_complete(unsigned* bar, unsigned x, unsigned& nloc, unsigned& nx) {
    const unsigned G = gridDim.x * gridDim.y * gridDim.z;
    unsigned sum, cnt, mine, sp = 0u;
    for (;;) {
        sum = 0u; cnt = 0u; mine = 0u;
#pragma unroll
        for (unsigned j = 0; j < 16; ++j) { const unsigned c = xb_ld(&bar[XB_XCNT(j)]); sum += c; cnt += (c > 0u) ? 1u : 0u; mine = (j == x) ? c : mine; }
        if (sum == G) break;
        __builtin_amdgcn_s_sleep(1);
        if ((++sp & 255u) == 0u) { if (xb_ld(&bar[XB_TMO])) break; if (sp > XB_SPIN_CAP) { atomicAdd(&bar[XB_TMO], 1u); break; } }
    }
    nloc = mine > 0u ? mine : 1u; nx = cnt > 0u ? cnt : 1u;
}
__device__ __forceinline__ void xcd_barrier(const XcdBarrier& b) {
    asm volatile("s_waitcnt vmcnt(0)" ::: "memory");
    __syncthreads();
    if (threadIdx.x == 0) {
        unsigned* bar = b.bar;
        __builtin_amdgcn_s_waitcnt(0);
        unsigned nloc = b.st[0], nx = b.st[1];
        if (nloc == 0u) { xcd_barrier_complete(bar, b.x, nloc, nx); b.st[0] = nloc; b.st[1] = nx; }
        const unsigned old = xb_add(&bar[XB_XSUB(b.x)], 1u);
        const unsigned gen = old / nloc;
        if (old + 1u == (gen + 1u) * nloc) {
            __builtin_amdgcn_fence(__ATOMIC_RELEASE, "agent");
            asm volatile("s_waitcnt vmcnt(0)" ::: "memory");
            const unsigned og = xb_add(&bar[XB_TOP], 1u);
            const unsigned tg = og / nx;
            if (og + 1u == (tg + 1u) * nx) xb_add(&bar[XB_TOPGEN], 1u);
            else XB_SPIN(xb_ld(&bar[XB_TOPGEN]) == tg, bar);
            __builtin_amdgcn_fence(__ATOMIC_ACQUIRE, "agent");
            xb_add(&bar[XB_XGEN(b.x)], 1u);
            asm volatile("s_waitcnt vmcnt(0)" ::: "memory");
        } else {
            XB_SPIN(xb_ld(&bar[XB_XGEN(b.x)]) == gen, bar);
            __builtin_amdgcn_fence(__ATOMIC_ACQUIRE, "agent");
            asm volatile("s_waitcnt vmcnt(0)" ::: "memory");
        }
    }
    __syncthreads();
}

struct Frame {
    LAS unsigned char* lds;
    unsigned* ctl;
    int tid, lane, wave, vcu, G;
    const float* const* inp; float* out; unsigned char* ws;
};
enum { I_X = 0, I_LN_MIX_E, I_W_IN_E, I_B_FOX, I_W_OUT_E, I_LN_FFN_E, I_W_GATE, I_W_UP, I_W_DOWN, I_LN_MIX_O, I_W_IN_O, I_LB, I_HGRN_G, I_LAM, I_DIFF_G, I_W_OUT_O, I_LN_FFN_O, I_W_ROUTER, I_WE_GATE, I_WE_UP, I_WE_DOWN, I_LN_FINAL };

__device__ __forceinline__ int dim_of_pos(int p) { return (p >> 1) + 32 * (p & 1); }
__device__ __forceinline__ int srccol_in0(int j) {
    if (j < 512) return j;
    if (j < 1024) { const int o = j - 512; return 1544 + (o & ~63) + dim_of_pos(o & 63); }
    if (j < 1536) return 512 + (j - 1024);
    if (j < 2048) return 1024 + (j - 1536);
    if (j < 2176) { const int o = j - 2048; return 2056 + (o & ~63) + dim_of_pos(o & 63); }
    if (j < 2304) return 2184 + (j - 2176);
    if (j < 2560) { const int o = j - 2304; return 2312 + (o & ~63) + dim_of_pos(o & 63); }
    if (j < 2624) { const int o = j - 2560; return 2568 + dim_of_pos(o); }
    if (j < 2632) return 1536 + (j - 2624);
    if (j < 2636) return 2632 + (j - 2632);
    return -1;
}
__device__ __forceinline__ int srccol_in1(int j) {
    if (j < 512) return j;
    if (j < 1024) { const int o = j - 512; return 2048 + (o & ~63) + dim_of_pos(o & 63); }
    if (j < 1536) return 512 + (j - 1024);
    if (j < 2048) return 1024 + (j - 1536);
    if (j < 2560) return 1536 + (j - 2048);
    if (j < 3072) { const int o = j - 2560; return 2560 + (o & ~63) + dim_of_pos(o & 63); }
    return 3072 + (j - 3072);
}
__device__ __forceinline__ void p0_item(const float* W, int Nsrc, int sc, const float* gain, bf16_t* WT, int K, int n0, int k0, LAS float* scr, int lane) {
    const float gk = gain ? gain[k0 + lane] : 1.0f;
    const float* src = W + (size_t)k0 * Nsrc + (sc >= 0 ? sc : 0);
#pragma unroll 16
    for (int kk = 0; kk < 64; ++kk) { const float gkk = __shfl(gk, kk); float v = src[(size_t)kk * Nsrc] * gkk; v = (sc >= 0) ? v : 0.f; scr[kk * 65 + lane] = v; }
    LDS_WAIT(); asm volatile("" ::: "memory");
    const int c = lane & 7;
#pragma unroll
    for (int j = 0; j < 8; ++j) { const int n = (lane >> 3) + 8 * j; const LAS float* s = scr + (8 * c) * 65 + n;
        u32x4 o; o.x = cvt_pk_bf16(s[0 * 65], s[1 * 65]); o.y = cvt_pk_bf16(s[2 * 65], s[3 * 65]); o.z = cvt_pk_bf16(s[4 * 65], s[5 * 65]); o.w = cvt_pk_bf16(s[6 * 65], s[7 * 65]);
        *(u32x4*)(WT + (size_t)(n0 + n) * K + k0 + 8 * c) = o; }
    LDS_WAIT(); asm volatile("" ::: "memory");
}
__device__ __forceinline__ void p0_prologue(Frame& F) {
    LAS float* scr = (LAS float*)(F.lds + F.wave * 16640);
    const int gw = F.vcu * NWAVES + F.wave, NGW = F.G * NWAVES, lane = F.lane;
    unsigned char* ws = F.ws;
    constexpr int I0 = 16 * 44, I1 = 16 * 16, I2 = 16 * 88, I3 = 44 * 16, I4 = 16 * 56, I5 = 16 * 16, I6 = 8 * 16 * 112, I7 = 8 * 56 * 16;
    constexpr int NITEMS = I0 + I1 + I2 + I3 + I4 + I5 + I6 + I7;
    for (int it = gw; it < NITEMS; it += NGW) {
        int r = it;
        if (r < I0) { const int kb = r / 44, nb = r % 44; const int j = nb * 64 + lane; p0_item(F.inp[I_W_IN_E], N0SRC, srccol_in0(j), F.inp[I_LN_MIX_E], (bf16_t*)(ws + WS_WIN0), DM, nb * 64, kb * 64, scr, lane); continue; } r -= I0;
        if (r < I1) { const int kb = r / 16, nb = r % 16; p0_item(F.inp[I_W_OUT_E], DM, nb * 64 + lane, nullptr, (bf16_t*)(ws + WS_WOUT0), DM, nb * 64, kb * 64, scr, lane); continue; } r -= I1;
        if (r < I2) { const int kb = r / 88, nb = r % 88; const int j = nb * 64, pn = j >> 8, rr = j & 255; const float* W = (rr < 128) ? F.inp[I_W_GATE] : F.inp[I_W_UP];
            p0_item(W, FF, pn * 128 + (rr & 127) + lane, F.inp[I_LN_FFN_E], (bf16_t*)(ws + WS_WGU0), DM, j, kb * 64, scr, lane); continue; } r -= I2;
        if (r < I3) { const int kb = r / 16, nb = r % 16; p0_item(F.inp[I_W_DOWN], DM, nb * 64 + lane, nullptr, (bf16_t*)(ws + WS_WDN0), FF, nb * 64, kb * 64, scr, lane); continue; } r -= I3;
        if (r < I4) { const int kb = r / 56, nb = r % 56; const int j = nb * 64 + lane; p0_item(F.inp[I_W_IN_O], N1, srccol_in1(j), F.inp[I_LN_MIX_O], (bf16_t*)(ws + WS_WIN1), DM, nb * 64, kb * 64, scr, lane); continue; } r -= I4;
        if (r < I5) { const int kb = r / 16, nb = r % 16; p0_item(F.inp[I_W_OUT_O], DM, nb * 64 + lane, nullptr, (bf16_t*)(ws + WS_WOUT1), DM, nb * 64, kb * 64, scr, lane); continue; } r -= I5;
        if (r < I6) { const int e = r / (16 * 112), q = r % (16 * 112), kb = q / 112, nb = q % 112; const int j = nb * 64, pn = j >> 8, rr = j & 255;
            const float* W = ((rr < 128) ? F.inp[I_WE_GATE] : F.inp[I_WE_UP]) + (size_t)e * DM * FFE;
            p0_item(W, FFE, pn * 128 + (rr & 127) + lane, F.inp[I_LN_FFN_O], (bf16_t*)(ws + WS_WEGU) + (size_t)e * 7168 * DM, DM, j, kb * 64, scr, lane); continue; } r -= I6;
        { const int e = r / (56 * 16), q = r % (56 * 16), kb = q / 16, nb = q % 16;
            p0_item(F.inp[I_WE_DOWN] + (size_t)e * FFE * DM, DM, nb * 64 + lane, nullptr, (bf16_t*)(ws + WS_WEDN) + (size_t)e * DM * FFE, FFE, nb * 64, kb * 64, scr, lane); }
    }
    { bf16_t* XB = (bf16_t*)(ws + WS_XB); float* SS = (float*)(ws + WS_SS);
      for (int m = gw; m < MTOK; m += NGW) {
        const f32x4* xr = (const f32x4*)(F.inp[I_X] + (size_t)m * DM) + lane; float s = 0.f; f32x4 v[4];
#pragma unroll
        for (int j = 0; j < 4; ++j) { v[j] = xr[64 * j]; s += (v[j][0] * v[j][0] + v[j][1] * v[j][1]) + (v[j][2] * v[j][2] + v[j][3] * v[j][3]); }
        s = wave_sum(s);
        u32x2* o = (u32x2*)(XB + (size_t)m * DM) + lane;
#pragma unroll
        for (int j = 0; j < 4; ++j) { u32x2 w; w.x = cvt_pk_bf16(v[j][0], v[j][1]); w.y = cvt_pk_bf16(v[j][2], v[j][3]); o[64 * j] = w; }
        if (lane < 16) SS[(size_t)m * 16 + lane] = (lane == 0) ? s : 0.f;
      } }
    { float* rope = (float*)(ws + WS_ROPE); const int gt = gw * 64 + lane, NT = NGW * 64;
      for (int i = gt; i < SEQ * 32; i += NT) { const int t = i >> 5, p = i & 31; const float inv = powf(10000.0f, -(float)p * 2.0f / 64.0f); const float ang = (float)t * inv;
          rope[2 * i] = cosf(ang); rope[2 * i + 1] = sinf(ang); }
      float* wrt = (float*)(ws + WS_WRT);
      for (int i = gt; i < 8 * DM; i += NT) { const int e = i >> 10, k = i & 1023; wrt[i] = F.inp[I_W_ROUTER][k * 8 + e] * F.inp[I_LN_FFN_O][k]; } }
}

__device__ __forceinline__ void fox_cumsum_unit(Frame& F, int bh) {
    const float* LOGF = (const float*)(F.ws + WS_LOGF); float* CB = (float*)(F.ws + WS_CB);
    LAS float* wt = (LAS float*)(F.lds);
    const int b = bh >> 3, h = bh & 7, tid = F.tid;
    float v[4]; float run = 0.f;
#pragma unroll
    for (int j = 0; j < 4; ++j) { v[j] = LOGF[((size_t)b * SEQ + 4 * tid + j) * 8 + h]; run += v[j]; v[j] = run; }
    float incl = run;
#pragma unroll
    for (int o = 1; o < 64; o <<= 1) { const float t = __shfl_up(incl, o); if (F.lane >= o) incl += t; }
    if (F.lane == 63) wt[F.wave] = incl;
    __syncthreads();
    float woff = 0.f;
    for (int w = 0; w < F.wave; ++w) woff += wt[w];
    const float base = woff + incl - run;
    f32x4 o = (f32x4){base + v[0], base + v[1], base + v[2], base + v[3]};
    *(f32x4*)(CB + (size_t)bh * SEQ + 4 * tid) = o;
    __syncthreads();
}
__device__ __forceinline__ unsigned sortable(float f) { const unsigned u = __float_as_uint(f + 0.0f); return (u & 0x80000000u) ? ~u : (u | 0x80000000u); }
constexpr int SCP = 2052;
__device__ __forceinline__ void idx_unit(Frame& F, int b, int qt) {
    const bf16_t* QKV = (const bf16_t*)(F.ws + WS_BIG); const float* IW = (const float*)(F.ws + WS_IW);
    u64* MASKT = (u64*)(F.ws + WS_XB);
    LAS float* Sc = (LAS float*)F.lds;
    const int lane = F.lane, fr = lane & 15, fq = lane >> 4, q0 = qt * 16, nkeys = q0 + 16;
    const size_t rowq = (size_t)b * SEQ + q0 + fr;
    bf16x8 qf[4][2];
#pragma unroll
    for (int h = 0; h < 4; ++h)
#pragma unroll
        for (int ks = 0; ks < 2; ++ks) qf[h][ks] = *(const bf16x8*)(QKV + rowq * N0 + C0_IQ + h * 64 + ks * 32 + fq * 8);
    const f32x4 w4 = *(const f32x4*)(IW + rowq * 4);
    for (int kb = F.wave; kb * 16 < nkeys; kb += NWAVES) {
        const size_t rowk = (size_t)b * SEQ + kb * 16 + fr;
        const bf16x8 k0 = *(const bf16x8*)(QKV + rowk * N0 + C0_IK + fq * 8), k1 = *(const bf16x8*)(QKV + rowk * N0 + C0_IK + 32 + fq * 8);
        f32x4 sc = (f32x4){0.f, 0.f, 0.f, 0.f};
#pragma unroll
        for (int h = 0; h < 4; ++h) { f32x4 a = (f32x4){0.f, 0.f, 0.f, 0.f};
            a = __builtin_amdgcn_mfma_f32_16x16x32_bf16(k0, qf[h][0], a, 0, 0, 0); a = __builtin_amdgcn_mfma_f32_16x16x32_bf16(k1, qf[h][1], a, 0, 0, 0);
#pragma unroll
            for (int j = 0; j < 4; ++j) sc[j] += w4[h] * fmaxf(a[j], 0.f); }
        *(LAS f32x4*)(Sc + fr * SCP + kb * 16 + 4 * fq) = sc;
    }
    __syncthreads();
#pragma unroll 1
    for (int rr = 0; rr < 2; ++rr) {
        const int row = F.wave * 2 + rr, t = q0 + row;
        unsigned key[32];
#pragma unroll
        for (int i = 0; i < 32; ++i) { const int s = i * 64 + lane; key[i] = (s <= t) ? sortable(Sc[row * SCP + (s < nkeys ? s : 0)]) : 0u; }
        unsigned theta = 0u; int need = 0;
        const bool all = (t + 1 <= 256);
        if (!all) {
            unsigned prefix = 0u;
#pragma unroll 1
            for (int bit = 31; bit >= 0; --bit) { const unsigned cand = prefix | (1u << bit); int cnt = 0;
#pragma unroll
                for (int i = 0; i < 32; ++i) cnt += __popcll(__ballot(key[i] >= cand));
                if (cnt >= 256) prefix = cand; }
            theta = prefix; int ngt = 0;
#pragma unroll
            for (int i = 0; i < 32; ++i) ngt += __popcll(__ballot(key[i] > theta));
            need = 256 - ngt;
        }
        int running = 0; u64 mine = 0ull;
#pragma unroll
        for (int i = 0; i < 32; ++i) {
            bool sel;
            if (all) sel = (i * 64 + lane <= t);
            else { const u64 eq = __ballot(key[i] == theta);
                   const int rank = running + (int)__builtin_amdgcn_mbcnt_hi((unsigned)(eq >> 32), __builtin_amdgcn_mbcnt_lo((unsigned)eq, 0u));
                   sel = (key[i] > theta) || (key[i] == theta && rank < need); running += __popcll(eq); }
            const u64 w = __ballot(sel);
            if (lane == i) mine = w;
        }
        if (lane < 32) MASKT[((size_t)b * 32 + lane) * SEQ + t] = mine;
    }
    __syncthreads();
}

template <int MODE, bool KOZ = false>
__device__ __forceinline__ void naive_attn_row(const bf16_t* Qrow, const bf16_t* Kp, const bf16_t* Vp, long kvpitch, bf16_t* Orow, int t, const float* cb, const u64* maskb, int lane) {
    float q[64];
#pragma unroll
    for (int c = 0; c < 8; ++c) { const u32x4 w = *(const u32x4*)(Qrow + c * 8);
        q[8 * c + 0] = bf_lo(w.x); q[8 * c + 1] = bf_hi(w.x); q[8 * c + 2] = bf_lo(w.y); q[8 * c + 3] = bf_hi(w.y); q[8 * c + 4] = bf_lo(w.z); q[8 * c + 5] = bf_hi(w.z); q[8 * c + 6] = bf_lo(w.w); q[8 * c + 7] = bf_hi(w.w); }
    float m = -INFINITY, l = 0.f; float o[64];
#pragma unroll
    for (int d = 0; d < 64; ++d) o[d] = 0.f;
    for (int s = lane; s <= t; s += 64) {
        if (MODE == 2) { const u64 w = maskb[(size_t)(s >> 6) * SEQ + t]; if (!((w >> (s & 63)) & 1ull)) continue; }
        const bf16_t* kr = Kp + (size_t)s * kvpitch; float dot = 0.f;
#pragma unroll
        for (int c = 0; c < 8; ++c) { const u32x4 w = *(const u32x4*)(kr + c * 8);
            dot += q[8 * c + 0] * bf_lo(w.x) + q[8 * c + 1] * bf_hi(w.x) + q[8 * c + 2] * bf_lo(w.y) + q[8 * c + 3] * bf_hi(w.y) + q[8 * c + 4] * bf_lo(w.z) + q[8 * c + 5] * bf_hi(w.z) + q[8 * c + 6] * bf_lo(w.w) + q[8 * c + 7] * bf_hi(w.w); }
        if (MODE == 1) dot -= cb[s] * LOG2E;
        const float mn = fmaxf(m, dot), a = exp2f(m - mn), p = exp2f(dot - mn);
        l = l * a + p; m = mn;
        const bf16_t* vr = Vp + (size_t)s * kvpitch;
#pragma unroll
        for (int c = 0; c < 8; ++c) { const u32x4 w = *(const u32x4*)(vr + c * 8);
            o[8 * c + 0] = o[8 * c + 0] * a + p * bf_lo(w.x); o[8 * c + 1] = o[8 * c + 1] * a + p * bf_hi(w.x); o[8 * c + 2] = o[8 * c + 2] * a + p * bf_lo(w.y); o[8 * c + 3] = o[8 * c + 3] * a + p * bf_hi(w.y);
            o[8 * c + 4] = o[8 * c + 4] * a + p * bf_lo(w.z); o[8 * c + 5] = o[8 * c + 5] * a + p * bf_hi(w.z); o[8 * c + 6] = o[8 * c + 6] * a + p * bf_lo(w.w); o[8 * c + 7] = o[8 * c + 7] * a + p * bf_hi(w.w); }
    }
    const float Mx = wave_max(m); const float sc = (m == -INFINITY) ? 0.f : exp2f(m - Mx);
    const float L = wave_sum(l * sc); float res = 0.f;
#pragma unroll
    for (int d = 0; d < 64; ++d) { const float od = wave_sum(o[d] * sc); if (lane == d) res = od; }
    float r = res / L; if (KOZ) r = 0.f;
    const unsigned pk = cvt_pk_bf16(r, r);
    Orow[lane] = (bf16_t)(pk & 0xffffu);
}

__device__ __forceinline__ void hgrn_unit(Frame& F, int u) {
    bf16_t* QKV = (bf16_t*)(F.ws + WS_BIG);
    const int b = u >> 4, h = (u >> 1) & 7, vh = u & 1, tid = F.tid, lane = F.lane, vloc = lane & 31, ks = lane >> 5;
    LAS float* Qs = (LAS float*)F.lds;
    LAS float* Fs = Qs + 4096;
    LAS float* Vs = Fs + 4096;
    LAS float* Os = Vs + 2048;
    const int k0 = F.wave * 8 + ks * 4;
    float st[4] = {0.f, 0.f, 0.f, 0.f};
    const int sk = (tid & 7) * 8, stt = tid >> 3;
    float lbv[8];
#pragma unroll
    for (int j = 0; j < 8; ++j) { const int ch = h * 64 + sk + j; lbv[j] = sigmoidf_(F.inp[I_LB][512 + ch] - F.inp[I_LB][ch]); }
    for (int c = 0; c < SEQ / 64; ++c) {
        const size_t row0 = (size_t)b * SEQ + c * 64;
        { const bf16_t* rp = QKV + (row0 + stt) * N1;
          const u32x4 wq = *(const u32x4*)(rp + C1_HQ + h * 64 + sk), wf = *(const u32x4*)(rp + C1_HF + h * 64 + sk);
          const unsigned aq[4] = {wq.x, wq.y, wq.z, wq.w}, af[4] = {wf.x, wf.y, wf.z, wf.w};
          float qv[8], fv[8];
#pragma unroll
          for (int j = 0; j < 4; ++j) { qv[2 * j] = siluf_(bf_lo(aq[j])); qv[2 * j + 1] = siluf_(bf_hi(aq[j]));
              fv[2 * j] = lbv[2 * j] + (1.f - lbv[2 * j]) * sigmoidf_(bf_lo(af[j])); fv[2 * j + 1] = lbv[2 * j + 1] + (1.f - lbv[2 * j + 1]) * sigmoidf_(bf_hi(af[j])); }
          *(LAS f32x4*)(Qs + stt * 64 + sk) = (f32x4){qv[0], qv[1], qv[2], qv[3]}; *(LAS f32x4*)(Qs + stt * 64 + sk + 4) = (f32x4){qv[4], qv[5], qv[6], qv[7]};
          *(LAS f32x4*)(Fs + stt * 64 + sk) = (f32x4){fv[0], fv[1], fv[2], fv[3]}; *(LAS f32x4*)(Fs + stt * 64 + sk + 4) = (f32x4){fv[4], fv[5], fv[6], fv[7]};
          if (tid < 256) { const int vt = tid >> 2, vc = (tid & 3) * 8; const u32x4 wv = *(const u32x4*)(QKV + (row0 + vt) * N1 + C1_HI + h * 64 + vh * 32 + vc);
              *(LAS f32x4*)(Vs + vt * 32 + vc) = (f32x4){bf_lo(wv.x), bf_hi(wv.x), bf_lo(wv.y), bf_hi(wv.y)}; *(LAS f32x4*)(Vs + vt * 32 + vc + 4) = (f32x4){bf_lo(wv.z), bf_hi(wv.z), bf_lo(wv.w), bf_hi(wv.w)}; } }
        __syncthreads();
#pragma unroll 4
        for (int tt = 0; tt < 64; ++tt) {
            const f32x4 f4 = *(const LAS f32x4*)(Fs + tt * 64 + k0), q4 = *(const LAS f32x4*)(Qs + tt * 64 + k0); const float v = Vs[tt * 32 + vloc];
            float o = 0.f;
#pragma unroll
            for (int j = 0; j < 4; ++j) { st[j] = f4[j] * (st[j] - v) + v; o += st[j] * q4[j]; }
            o += __shfl_xor(o, 32);
            if (ks == 0) Os[(F.wave * 64 + tt) * 32 + vloc] = o;
        }
        __syncthreads();
        { const int ot = tid >> 3, ov = (tid & 7) * 4; f32x4 s = (f32x4){0.f, 0.f, 0.f, 0.f};
#pragma unroll
          for (int w = 0; w < 8; ++w) s += *(const LAS f32x4*)(Os + (w * 64 + ot) * 32 + ov);
          u32x2 pk; pk.x = cvt_pk_bf16(s[0], s[1]); pk.y = cvt_pk_bf16(s[2], s[3]);
          *(u32x2*)(QKV + (row0 + ot) * N1 + C1_HI + h * 64 + vh * 32 + ov) = pk; }
        __syncthreads();
    }
}

__device__ __forceinline__ void combine_rows(Frame& F) {
    bf16_t* QKV = (bf16_t*)(F.ws + WS_BIG); const bf16_t* DO = (const bf16_t*)(F.ws + WS_XB);
    const int gw = F.vcu * NWAVES + F.wave, NGW = F.G * NWAVES, lane = F.lane;
    const float* lv = F.inp[I_LAM];
    const float d01 = wave_sum(lv[lane] * lv[64 + lane]), d23 = wave_sum(lv[128 + lane] * lv[192 + lane]);
    const float lam_init = 0.8f - 0.6f * expf(-0.3f);
    const float lam = expf(d01) - expf(d23) + lam_init;
    float gh[8], gd[8];
#pragma unroll
    for (int j = 0; j < 8; ++j) { gh[j] = F.inp[I_HGRN_G][(lane & 7) * 8 + j]; gd[j] = F.inp[I_DIFF_G][(lane & 15) * 8 + j] * (1.0f - lam_init); }
    for (int m = gw; m < MTOK; m += NGW) {
        bf16_t* rp = QKV + (size_t)m * N1;
        { const u32x4 wo = *(const u32x4*)(rp + C1_HI + lane * 8), wg = *(const u32x4*)(rp + C1_HG + lane * 8);
          float o[8] = {bf_lo(wo.x), bf_hi(wo.x), bf_lo(wo.y), bf_hi(wo.y), bf_lo(wo.z), bf_hi(wo.z), bf_lo(wo.w), bf_hi(wo.w)};
          float g[8] = {bf_lo(wg.x), bf_hi(wg.x), bf_lo(wg.y), bf_hi(wg.y), bf_lo(wg.z), bf_hi(wg.z), bf_lo(wg.w), bf_hi(wg.w)};
          float ss = 0.f;
#pragma unroll
          for (int j = 0; j < 8; ++j) ss += o[j] * o[j];
          ss += __shfl_xor(ss, 1); ss += __shfl_xor(ss, 2); ss += __shfl_xor(ss, 4);
          const float rs = rsqrtf(ss * (1.0f / 64.0f) + EPS); float r[8];
#pragma unroll
          for (int j = 0; j < 8; ++j) r[j] = (KO & 8) ? 0.f : o[j] * rs * gh[j] * siluf_(g[j]);
          *(u32x4*)(rp + C1_HQ + lane * 8) = (u32x4){cvt_pk_bf16(r[0], r[1]), cvt_pk_bf16(r[2], r[3]), cvt_pk_bf16(r[4], r[5]), cvt_pk_bf16(r[6], r[7])}; }
        { const int hd = lane >> 4, dd = (lane & 15) * 8; const bf16_t* dp = DO + (size_t)m * DM + hd * 256 + dd;
          const u32x4 w1 = *(const u32x4*)dp, w2 = *(const u32x4*)(dp + 128);
          float a[8] = {bf_lo(w1.x), bf_hi(w1.x), bf_lo(w1.y), bf_hi(w1.y), bf_lo(w1.z), bf_hi(w1.z), bf_lo(w1.w), bf_hi(w1.w)};
          float c[8] = {bf_lo(w2.x), bf_hi(w2.x), bf_lo(w2.y), bf_hi(w2.y), bf_lo(w2.z), bf_hi(w2.z), bf_lo(w2.w), bf_hi(w2.w)};
          float ss = 0.f; float d[8];
#pragma unroll
          for (int j = 0; j < 8; ++j) { d[j] = a[j] - lam * c[j]; ss += d[j] * d[j]; }
          ss += __shfl_xor(ss, 1); ss += __shfl_xor(ss, 2); ss += __shfl_xor(ss, 4); ss += __shfl_xor(ss, 8);
          const float rs = rsqrtf(ss * (1.0f / 128.0f) + EPS); float r[8];
#pragma unroll
          for (int j = 0; j < 8; ++j) r[j] = (KO & 16) ? 0.f : d[j] * rs * gd[j];
          *(u32x4*)(rp + C1_Q + hd * 128 + dd) = (u32x4){cvt_pk_bf16(r[0], r[1]), cvt_pk_bf16(r[2], r[3]), cvt_pk_bf16(r[4], r[5]), cvt_pk_bf16(r[6], r[7])}; }
    }
}

__device__ __forceinline__ void router_rows(Frame& F) {
    const bf16_t* XB = (const bf16_t*)(F.ws + WS_XB); const float* SS = (const float*)(F.ws + WS_SS); const float* WRT = (const float*)(F.ws + WS_WRT);
    float* GATE = (float*)(F.ws + WS_GATE); int* LIST = (int*)(F.ws + WS_LIST); unsigned* cnt = F.ctl + CW_CNT;
    LAS float* Ws = (LAS float*)F.lds;
    for (int i = F.tid; i < 8 * DM; i += NTHR) Ws[i] = WRT[i];
    __syncthreads();
    const int gw = F.vcu * NWAVES + F.wave, NGW = F.G * NWAVES, lane = F.lane;
    for (int m = gw; m < MTOK; m += NGW) {
        const u32x4 w0 = *(const u32x4*)(XB + (size_t)m * DM + lane * 8), w1 = *(const u32x4*)(XB + (size_t)m * DM + 512 + lane * 8);
        const float x[16] = {bf_lo(w0.x), bf_hi(w0.x), bf_lo(w0.y), bf_hi(w0.y), bf_lo(w0.z), bf_hi(w0.z), bf_lo(w0.w), bf_hi(w0.w), bf_lo(w1.x), bf_hi(w1.x), bf_lo(w1.y), bf_hi(w1.y), bf_lo(w1.z), bf_hi(w1.z), bf_lo(w1.w), bf_hi(w1.w)};
        float ssum = (lane < 16) ? SS[(size_t)m * 16 + lane] : 0.f; ssum = wave_sum(ssum);
        const float rs = rsqrtf(ssum * (1.0f / DM) + EPS);
        float lg[8];
#pragma unroll
        for (int e = 0; e < 8; ++e) { const LAS float* wp = Ws + e * DM + lane * 8; float s = 0.f;
            const f32x4 a0 = *(const LAS f32x4*)wp, a1 = *(const LAS f32x4*)(wp + 4), b0 = *(const LAS f32x4*)(wp + 512), b1 = *(const LAS f32x4*)(wp + 516);
            s += x[0] * a0[0] + x[1] * a0[1] + x[2] * a0[2] + x[3] * a0[3] + x[4] * a1[0] + x[5] * a1[1] + x[6] * a1[2] + x[7] * a1[3];
            s += x[8] * b0[0] + x[9] * b0[1] + x[10] * b0[2] + x[11] * b0[3] + x[12] * b1[0] + x[13] * b1[1] + x[14] * b1[2] + x[15] * b1[3];
            lg[e] = wave_sum(s) * rs; }
        int i1 = 0; float l1 = lg[0];
#pragma unroll
        for (int e = 1; e < 8; ++e) if (lg[e] > l1) { l1 = lg[e]; i1 = e; }
        int i2 = -1; float l2 = -INFINITY;
#pragma unroll
        for (int e = 0; e < 8; ++e) if (e != i1 && lg[e] > l2) { l2 = lg[e]; i2 = e; }
        const float g1 = 1.0f / (1.0f + __expf(l2 - l1)), g2 = 1.0f - g1;
        if (lane == 0) {
            const unsigned s1 = __hip_atomic_fetch_add(cnt + i1, 1u, RLX_AGENT); LIST[(size_t)i1 * MTOK + s1] = m; GATE[m] = g1;
            const unsigned s2 = __hip_atomic_fetch_add(cnt + 8 + i2, 1u, RLX_AGENT); LIST[(size_t)(8 + i2) * MTOK + s2] = m; GATE[MTOK + m] = g2;
        }
    }
}

__device__ __forceinline__ void final_norm(Frame& F) {
    const int gw = F.vcu * NWAVES + F.wave, NGW = F.G * NWAVES, lane = F.lane;
    f32x4 g[4];
#pragma unroll
    for (int j = 0; j < 4; ++j) g[j] = *((const f32x4*)F.inp[I_LN_FINAL] + lane + 64 * j);
    for (int m = gw; m < MTOK; m += NGW) {
        f32x4* xr = (f32x4*)(F.out + (size_t)m * DM) + lane; f32x4 v[4]; float s = 0.f;
#pragma unroll
        for (int j = 0; j < 4; ++j) { v[j] = xr[64 * j]; s += (v[j][0] * v[j][0] + v[j][1] * v[j][1]) + (v[j][2] * v[j][2] + v[j][3] * v[j][3]); }
        const float rs = rsqrtf(wave_sum(s) * (1.0f / DM) + EPS);
#pragma unroll
        for (int j = 0; j < 4; ++j) xr[64 * j] = v[j] * rs * g[j];
    }
}

constexpr int NPH = 17;
struct Args { const float* in[22]; float* out; unsigned char* ws; int ph_lo, ph_hi, li, pad; };
__global__ void __launch_bounds__(NTHR, 2) trunk_fwd(Args args) {
    extern __shared__ __attribute__((aligned(16))) unsigned char lds[];
    Frame F;
    F.lds = (LAS unsigned char*)lds;
    F.tid = threadIdx.x; F.lane = F.tid & 63; F.wave = __builtin_amdgcn_readfirstlane(F.tid >> 6);
    F.G = gridDim.x; { const int bx = blockIdx.x; F.vcu = (F.G % 8 == 0) ? (bx % 8) * (F.G / 8) + bx / 8 : bx; }
    F.ws = args.ws; F.out = args.out; F.ctl = (unsigned*)(args.ws + WS_CTL);
    F.inp = args.in;
    volatile LAS unsigned* MISC = (volatile LAS unsigned*)(F.lds + MISC_OFF);
    for (int u = F.tid; u < (LDS_BYTES - LDSCTL_OFF) / 4; u += NTHR) ((LAS unsigned*)(F.lds + LDSCTL_OFF))[u] = 0u;
    __syncthreads();
    XcdBarrier bar; bar.bar = F.ctl + CW_BAR; bar.x = 0; bar.st = nullptr;
    if (!MK_PER_PHASE) bar = xcd_barrier_post(F.ctl + CW_BAR, MISC + 8);
#define GRID_BAR() do { if (MK_PER_PHASE) { if (F.tid == 0) __hip_atomic_store(F.ctl + CW_TMO, 0xBADBA0u, RLX_AGENT); } else { xcd_barrier(bar); } } while (0)
    const int lo = args.ph_lo, hi = args.ph_hi;
#ifndef PH_MASK
#define PH_MASK 0x1ffff
#endif
#define IN(k) ((((PH_MASK) >> (k)) & 1) && lo <= (k) && (k) < hi)
#define BOTH(k) (IN(k) && IN((k) + 1))
    unsigned char* ws = args.ws;
    bf16_t* XB = (bf16_t*)(ws + WS_XB); float* SS = (float*)(ws + WS_SS); bf16_t* BIG = (bf16_t*)(ws + WS_BIG);
    const int c = (int)blockIdx.x, G = F.G;

    if (IN(0)) { p0_prologue(F); if (BOTH(0)) GRID_BAR(); }
    if (IN(1)) {
        pg8::Gemm g{XB, (const bf16_t*)(ws + WS_WIN0), DM, DM, 0, nullptr}; pg8::StaticOrder S; S.init(MTOK, N0, G, c);
        pg8::EpiIn E{BIG, N0, SS, (const float*)(ws + WS_ROPE), (float*)(ws + WS_LOGF), (float*)(ws + WS_IW), F.inp[I_B_FOX], 0};
        pg8::gemm_phase<pg8::EpiIn, pg8::StaticOrder, false, true>(F.lds, g, S, E);
        if (BOTH(1)) GRID_BAR();
    }
    if (IN(2)) {
        for (int u = c; u < 128; u += G) fox_cumsum_unit(F, u);
        for (int i = 0; ; ++i) { const int L = i * G + c; if (L >= 2048) break; const int b = L & 15, j = L >> 4; const int qt = (j & 1) ? 127 - (j >> 1) : (j >> 1); idx_unit(F, b, qt); }
        if (BOTH(2)) GRID_BAR();
    }
    if (IN(3)) {
#if FAST_ATTN
        static_assert(attn_body::LDS_BYTES <= RING_BYTES, "attention LDS");
        if (c < 256) {
            const int hc = c >> 1, b = hc >> 3, h = hc & 7;
            attn_body::bf16* base = (attn_body::bf16*)(BIG + (size_t)b * SEQ * N0);
            const float* cbp = (const float*)(ws + WS_CB) + (size_t)(b * 8 + h) * SEQ; const u64* mkp = (const u64*)(ws + WS_XB) + (size_t)b * 32 * SEQ;
#define FOX_U(QBI) attn_body::attn_unit<8, 1, N0, N0, N0, QBI>(base + C0_FQ + h * 64, base + C0_FK + h * 64, base + C0_FV + h * 64, base + C0_FQ + h * 64, (char*)lds, cbp, nullptr)
#define DSA_U(QBI) attn_body::attn_unit<8, 2, N0, N0, N0, QBI>(base + C0_DQ + h * 64, base + C0_DK + (h >> 2) * 64, base + C0_DV + (h >> 2) * 64, base + C0_DQ + h * 64, (char*)lds, nullptr, mkp)
            if (c & 1) { FOX_U(1); FOX_U(6); FOX_U(3); FOX_U(4); DSA_U(1); DSA_U(6); DSA_U(3); DSA_U(4); }
            else       { FOX_U(0); FOX_U(7); FOX_U(2); FOX_U(5); DSA_U(0); DSA_U(7); DSA_U(2); DSA_U(5); }
#undef FOX_U
#undef DSA_U
        }
#else
        const int gw = F.vcu * NWAVES + F.wave, NGW = G * NWAVES;
        for (int id = gw; id < 256 * SEQ; id += NGW) {
            const int combo = id & 255, t = id >> 8; const int typ = combo >> 7, b = (combo >> 3) & 15, h = combo & 7;
            bf16_t* rowp = BIG + ((size_t)b * SEQ + t) * N0; const bf16_t* b0 = BIG + (size_t)b * SEQ * N0;
            if (typ == 0) naive_attn_row<1, (KO & 1) != 0>(rowp + C0_FQ + h * 64, b0 + C0_FK + h * 64, b0 + C0_FV + h * 64, N0, rowp + C0_FQ + h * 64, t, (const float*)(ws + WS_CB) + (size_t)(b * 8 + h) * SEQ, nullptr, F.lane);
            else naive_attn_row<2, (KO & 2) != 0>(rowp + C0_DQ + h * 64, b0 + C0_DK + (h >> 2) * 64, b0 + C0_DV + (h >> 2) * 64, N0, rowp + C0_DQ + h * 64, t, nullptr, (const u64*)(ws + WS_XB) + (size_t)b * 32 * SEQ, F.lane);
        }
#endif
        if (BOTH(3)) GRID_BAR();
    }
    if (IN(4)) {
        pg8::Gemm g{BIG, (const bf16_t*)(ws + WS_WOUT0), N0, DM, 0, nullptr}; pg8::StaticOrder S; S.init(MTOK, DM, G, c);
        pg8::EpiRes E{F.inp[I_X], F.out, XB, SS};
        pg8::gemm_phase<pg8::EpiRes, pg8::StaticOrder, false, true>(F.lds, g, S, E);
        if (BOTH(4)) GRID_BAR();
    }
    if (IN(5) && !(KO & 4)) {
        pg8::Gemm g{XB, (const bf16_t*)(ws + WS_WGU0), DM, DM, 0, nullptr}; pg8::StaticOrder S; S.init(MTOK, 2 * FF, G, c);
        pg8::EpiGU<false> E{BIG, FF, SS, nullptr};
        pg8::gemm_phase<pg8::EpiGU<false>, pg8::StaticOrder, false, true>(F.lds, g, S, E);
        if (BOTH(5)) GRID_BAR();
    }
    if (IN(6) && !(KO & 4)) {
        pg8::Gemm g{BIG, (const bf16_t*)(ws + WS_WDN0), FF, FF, 0, nullptr}; pg8::StaticOrder S; S.init(MTOK, DM, G, c);
        pg8::EpiRes E{F.out, F.out, XB, SS};
        pg8::gemm_phase<pg8::EpiRes, pg8::StaticOrder, false, true>(F.lds, g, S, E);
        if (BOTH(6)) GRID_BAR();
    }
    if (IN(7)) {
        pg8::Gemm g{XB, (const bf16_t*)(ws + WS_WIN1), DM, DM, 0, nullptr}; pg8::StaticOrder S; S.init(MTOK, N1, G, c);
        pg8::EpiIn E{BIG, N1, SS, (const float*)(ws + WS_ROPE), nullptr, nullptr, nullptr, 1};
        pg8::gemm_phase<pg8::EpiIn, pg8::StaticOrder, false, true>(F.lds, g, S, E);
        if (BOTH(7)) GRID_BAR();
    }
    if (IN(8)) {
        for (int u = c; u < 256; u += G) hgrn_unit(F, u);
#if FAST_ATTN
        if (c < 256) {
            const int b = c >> 4, hd = (c >> 2) & 3, mp = (c >> 1) & 1, jv = c & 1;
            attn_body::bf16* base = (attn_body::bf16*)(BIG + (size_t)b * SEQ * N1);
            attn_body::bf16* obase = (attn_body::bf16*)(XB + (size_t)b * SEQ * DM) + (hd * 2 + mp) * 128 + jv * 64;
#define DIFF_U(QBI) attn_body::attn_unit<8, 0, N1, N1, DM, QBI>(base + C1_Q + (hd * 2 + mp) * 64, base + C1_K + (hd * 2 + mp) * 64, base + C1_V + hd * 128 + jv * 64, obase, (char*)lds, nullptr, nullptr)
            DIFF_U(7); DIFF_U(0); DIFF_U(6); DIFF_U(1); DIFF_U(5); DIFF_U(2); DIFF_U(4); DIFF_U(3);
#undef DIFF_U
        }
#else
        const int gw = F.vcu * NWAVES + F.wave, NGW = G * NWAVES;
        bf16_t* DO = XB;
        for (int id = gw; id < 256 * SEQ; id += NGW) {
            const int combo = id & 255, t = id >> 8; const int b = combo >> 4, hd = (combo >> 2) & 3, mp = (combo >> 1) & 1, jv = combo & 1;
            const bf16_t* rowp = BIG + ((size_t)b * SEQ + t) * N1; const bf16_t* b0 = BIG + (size_t)b * SEQ * N1;
            naive_attn_row<0>(rowp + C1_Q + (hd * 2 + mp) * 64, b0 + C1_K + (hd * 2 + mp) * 64, b0 + C1_V + hd * 128 + jv * 64, N1,
                              DO + ((size_t)b * SEQ + t) * DM + (hd * 2 + mp) * 128 + jv * 64, t, nullptr, nullptr, F.lane);
        }
#endif
        if (BOTH(8)) GRID_BAR();
    }
    if (IN(9)) { combine_rows(F); if (BOTH(9)) GRID_BAR(); }
    if (IN(10)) {
        pg8::Gemm g{BIG, (const bf16_t*)(ws + WS_WOUT1), N1, DM, 0, nullptr}; pg8::StaticOrder S; S.init(MTOK, DM, G, c);
        pg8::EpiRes E{F.out, F.out, XB, SS};
        pg8::gemm_phase<pg8::EpiRes, pg8::StaticOrder, false, true>(F.lds, g, S, E);
        if (BOTH(10)) GRID_BAR();
    }
    if (IN(11)) { router_rows(F); if (BOTH(11)) GRID_BAR(); }
#define MOE_PHASES(k) { \
        const int* LIST = (const int*)(ws + WS_LIST) + (size_t)(k) * 8 * MTOK; \
        if (IN(12 + 2 * (k)) && !(KO & (32 << (k)))) { \
            pg8::Gemm g{XB, (const bf16_t*)(ws + WS_WEGU), DM, DM, (size_t)7168 * DM, LIST}; pg8::MoeOrder S; S.init(F.ctl + CW_CNT + 8 * (k), 28, G, c); \
            pg8::EpiGU<true> E{BIG, FFE, SS, LIST}; \
            pg8::gemm_phase<pg8::EpiGU<true>, pg8::MoeOrder, true, true>(F.lds, g, S, E); \
            if (BOTH(12 + 2 * (k))) GRID_BAR(); \
        } \
        if (IN(13 + 2 * (k)) && !(KO & (32 << (k)))) { \
            pg8::Gemm g{BIG, (const bf16_t*)(ws + WS_WEDN), FFE, FFE, (size_t)DM * FFE, nullptr}; pg8::MoeOrder S; S.init(F.ctl + CW_CNT + 8 * (k), 4, G, c); \
            pg8::EpiMoeDown E{F.out, LIST, (const float*)(ws + WS_GATE) + (size_t)(k) * MTOK}; \
            pg8::gemm_phase<pg8::EpiMoeDown, pg8::MoeOrder, false, true>(F.lds, g, S, E); \
            if (BOTH(13 + 2 * (k))) GRID_BAR(); \
        } }
    MOE_PHASES(0)
    MOE_PHASES(1)
#undef MOE_PHASES
    if (IN(16)) { final_norm(F); }
#undef IN
#undef BOTH
}


#ifndef DBG
#define DBG 0
#endif
#if DBG
constexpr int CW_CHK = 512;
constexpr size_t WS_DBG = WS_END;
__device__ __forceinline__ void chk_max(unsigned* ctl, int id, float e) { if (!(e >= 0.f)) e = 1e30f; atomicMax(ctl + CW_CHK + id, __float_as_uint(e)); }
__device__ __forceinline__ float relerr(float got, float exp_, float scale = 1.0f) { return fabsf(got - exp_) / (fabsf(exp_) + 0.5f * scale); }
__device__ __forceinline__ int dbg_row(int i) { const int rows[8] = {0, 255, 256, 1000, 2047, 2048 + 77, 16 * 2048 - 1, 20000}; return rows[i & 7]; }
__device__ float block_sum(float v, float* red) {
    v = wave_sum(v); __syncthreads(); if ((threadIdx.x & 63) == 0) red[threadIdx.x >> 6] = v; __syncthreads();
    float s = 0.f; for (int w = 0; w < 8; ++w) s += red[w]; __syncthreads(); return s;
}
__global__ void __launch_bounds__(512) dbg_check(Args args, int which) {
    __shared__ float hv[3584]; __shared__ float raw[2880]; __shared__ float red[8];
    const float* const* in = args.in; unsigned char* ws = args.ws; unsigned* ctl = (unsigned*)(ws + WS_CTL);
    const int tid = threadIdx.x; const int r = dbg_row(blockIdx.x), t = r & (SEQ - 1);
    const bf16_t* BIG = (const bf16_t*)(ws + WS_BIG); const bf16_t* XB = (const bf16_t*)(ws + WS_XB); const float* SS = (const float*)(ws + WS_SS);
    float* SCR = (float*)(ws + WS_DBG) + (size_t)blockIdx.x * 1024;
    float emax = 0.f;
    if (which == 1) {
        float ssq = 0.f; for (int k = tid; k < DM; k += 512) { const float x = in[I_X][(size_t)r * DM + k]; ssq += x * x; }
        const float rs = rsqrtf(block_sum(ssq, red) / DM + EPS);
        for (int k = tid; k < DM; k += 512) hv[k] = in[I_X][(size_t)r * DM + k] * rs * in[I_LN_MIX_E][k];
        __syncthreads();
        for (int n = tid; n < N0SRC; n += 512) { float a = 0.f; for (int k = 0; k < DM; ++k) a += hv[k] * in[I_W_IN_E][(size_t)k * N0SRC + n]; raw[n] = a; }
        __syncthreads();
        const bf16_t* q = BIG + (size_t)r * N0;
        float e1 = 0.f, e2 = 0.f, e3 = 0.f;
        for (int i = tid; i < 512; i += 512) { e1 = fmaxf(e1, relerr(bf1(q[C0_FQ + i]), raw[i] * C2, C2)); e2 = fmaxf(e2, relerr(bf1(q[C0_FK + i]), raw[512 + i])); e3 = fmaxf(e3, relerr(bf1(q[C0_FV + i]), raw[1024 + i])); }
        chk_max(ctl, 21, wave_max(e1)); chk_max(ctl, 22, wave_max(e2)); chk_max(ctl, 23, wave_max(e3));
        float e4 = 0.f; for (int i = tid; i < 128; i += 512) e4 = fmaxf(e4, relerr(bf1(q[C0_DV + i]), raw[2184 + i]));
        chk_max(ctl, 24, wave_max(e4));
        const int sb[4] = {1544, 2056, 2312, 2568}, nh[4] = {8, 2, 4, 1}, db[4] = {C0_DQ, C0_DK, C0_IQ, C0_IK}; const float scl[4] = {C2, 1.f, 0.125f, 1.f};
        for (int sg = 0; sg < 4; ++sg) { float e = 0.f; for (int i = tid; i < nh[sg] * 32; i += 512) { const int hh = i >> 5, p = i & 31;
            const float inv = powf(10000.0f, -(float)p * 2.0f / 64.0f), ang = (float)t * inv, cs = cosf(ang), sn = sinf(ang);
            const float x1 = raw[sb[sg] + hh * 64 + p], x2 = raw[sb[sg] + hh * 64 + 32 + p];
            e = fmaxf(e, relerr(bf1(q[db[sg] + hh * 64 + 2 * p]), (x1 * cs - x2 * sn) * scl[sg], scl[sg])); e = fmaxf(e, relerr(bf1(q[db[sg] + hh * 64 + 2 * p + 1]), (x2 * cs + x1 * sn) * scl[sg], scl[sg])); }
            chk_max(ctl, 25 + sg, wave_max(e)); }
        float e9 = 0.f, e10 = 0.f;
        if (tid < 8) { const float x = raw[1536 + tid] + in[I_B_FOX][tid]; const float lf = fminf(x, 0.f) - log1pf(expf(-fabsf(x))); e9 = relerr(((const float*)(ws + WS_LOGF))[(size_t)r * 8 + tid], lf); }
        if (tid < 4) e10 = relerr(((const float*)(ws + WS_IW))[(size_t)r * 4 + tid], raw[2632 + tid] * 0.5f);
        float ea = 0.f, eb = 0.f, ec = 0.f;
        if (tid < 8) { ea = relerr(bf1(q[C0_FF + tid]), raw[1536 + tid]); const float x = raw[1536 + tid]; const float lf = fminf(x, 0.f) - log1pf(expf(-fabsf(x))); eb = relerr(((const float*)(ws + WS_LOGF))[(size_t)r * 8 + tid], lf); ec = e9; }
        chk_max(ctl, 1, wave_max(ea)); chk_max(ctl, 2, wave_max(eb)); chk_max(ctl, 3, wave_max(ec)); chk_max(ctl, 4, wave_max(e10));
    } else if (which == 2) {
        const float* LOGF = (const float*)(ws + WS_LOGF); const float* CB = (const float*)(ws + WS_CB); const u64* MASKT = (const u64*)(ws + WS_XB);
        const int gid = blockIdx.x * 512 + tid;
        if (gid < 128) { const int b = gid >> 3, h = gid & 7; float c = 0.f; for (int s2 = 0; s2 < SEQ; ++s2) { c += LOGF[((size_t)b * SEQ + s2) * 8 + h]; emax = fmaxf(emax, fabsf(CB[(size_t)gid * SEQ + s2] - c) / (fabsf(c) * 1e-3f + 0.01f)); } }
        chk_max(ctl, 2, wave_max(emax));
        float e3 = 0.f;
        for (int rr = gid; rr < MTOK; rr += 8 * 512) { const int b = rr >> 11, tt = rr & 2047; int pc = 0; bool bad = false;
            for (int i = 0; i < 32; ++i) { const u64 w = MASKT[((size_t)b * 32 + i) * SEQ + tt]; pc += __popcll(w);
                const int lo = i * 64; if (lo > tt) { if (w) bad = true; } else if (tt - lo < 63) { if (w >> (tt - lo + 1)) bad = true; } }
            const int want = (tt + 1 < 256) ? tt + 1 : 256; if (pc != want || bad) e3 = 1.f; }
        chk_max(ctl, 3, wave_max(e3));
    } else if (which == 4) {
        for (int k = tid; k < DM; k += 512) hv[k] = bf1(BIG[(size_t)r * N0 + k]);
        __syncthreads();
        float ssq = 0.f;
        for (int n = tid; n < DM; n += 512) { float a = in[I_X][(size_t)r * DM + n]; for (int k = 0; k < DM; ++k) a += hv[k] * in[I_W_OUT_E][(size_t)k * DM + n];
            emax = fmaxf(emax, relerr(args.out[(size_t)r * DM + n], a)); emax = fmaxf(emax, relerr(bf1(XB[(size_t)r * DM + n]), a)); ssq += a * a; }
        ssq = block_sum(ssq, red); float s16 = 0.f; for (int i = 0; i < 16; ++i) s16 += SS[(size_t)r * 16 + i];
        emax = fmaxf(emax, fabsf(s16 - ssq) / ssq * 10.f);
        chk_max(ctl, 4, wave_max(emax));
    } else if (which == 5) {
        float ssq = 0.f; for (int k = tid; k < DM; k += 512) { const float x = args.out[(size_t)r * DM + k]; ssq += x * x; }
        const float rs = rsqrtf(block_sum(ssq, red) / DM + EPS);
        for (int k = tid; k < DM; k += 512) hv[k] = args.out[(size_t)r * DM + k] * rs * in[I_LN_FFN_E][k];
        __syncthreads();
        for (int n = tid; n < FF; n += 512) { float g = 0.f, u = 0.f; for (int k = 0; k < DM; ++k) { g += hv[k] * in[I_W_GATE][(size_t)k * FF + n]; u += hv[k] * in[I_W_UP][(size_t)k * FF + n]; }
            const float h = g / (1.f + expf(-g)) * u; emax = fmaxf(emax, relerr(bf1(BIG[(size_t)r * FF + n]), h)); }
        __syncthreads();
        for (int k = tid; k < FF; k += 512) hv[k] = bf1(BIG[(size_t)r * FF + k]);
        __syncthreads();
        for (int n = tid; n < DM; n += 512) { float a = args.out[(size_t)r * DM + n]; for (int k = 0; k < FF; ++k) a += hv[k] * in[I_W_DOWN][(size_t)k * DM + n]; SCR[n] = a; }
        chk_max(ctl, 5, wave_max(emax));
    } else if (which == 6) {
        for (int n = tid; n < DM; n += 512) emax = fmaxf(emax, relerr(args.out[(size_t)r * DM + n], SCR[n]));
        chk_max(ctl, 6, wave_max(emax));
    }
}
__global__ void __launch_bounds__(512) dbg_encode(Args args, int nchk, int total) {
    const unsigned* ctl = (const unsigned*)(args.ws + WS_CTL);
    int idx = 0, mag = 0;
    for (int i = 1; i <= nchk; ++i) { const float e = __uint_as_float(ctl[CW_CHK + i]); if (e > 0.06f) { idx = i; mag = 0; float th = 1.0f; while (mag < 9 && e < th) { th *= 0.5f; ++mag; } break; } }
    const float s = sqrtf((float)(10 * idx + mag));
    for (int i = blockIdx.x * 512 + threadIdx.x; i < total; i += gridDim.x * 512) args.out[i] = s;
}
#endif
extern "C" void kernel_launch(void* const* d_in, const int* in_sizes, int n_in, void* d_out, int out_size, void* d_ws, size_t ws_size, hipStream_t stream) {
    static int grid = 0;
    if (grid == 0) {
        if (n_in != 22 || in_sizes[0] != MTOK * DM || out_size != MTOK * DM || ws_size < WS_END) { fprintf(stderr, "kernel_launch: unexpected shapes / workspace (%zu < %zu)\n", ws_size, (size_t)WS_END); grid = -1; return; }
        int dev = 0, cus = 0, per_cu = 0;
        if (hipGetDevice(&dev) != hipSuccess || hipDeviceGetAttribute(&cus, hipDeviceAttributeMultiprocessorCount, dev) != hipSuccess) { grid = -1; return; }
        if (hipFuncSetAttribute((const void*)trunk_fwd, hipFuncAttributeMaxDynamicSharedMemorySize, LDS_BYTES) != hipSuccess) { grid = -1; return; }
        if (hipOccupancyMaxActiveBlocksPerMultiprocessor(&per_cu, (const void*)trunk_fwd, NTHR, LDS_BYTES) != hipSuccess || per_cu < 1) { fprintf(stderr, "kernel_launch: occupancy query says %d\n", per_cu); }
        (void)hipGetLastError();
        grid = cus;
    }
    if (grid < 0) return;
    if (hipMemsetAsync((char*)d_ws + WS_CTL, 0, CTL_ZERO_BYTES, stream) != hipSuccess) return;
    Args a{};
    for (int i = 0; i < 22; ++i) a.in[i] = (const float*)d_in[i];
    a.out = (float*)d_out; a.ws = (unsigned char*)d_ws; a.pad = 0;
#if MK_PER_PHASE
    for (int p = 0; p < NPH; ++p) { a.ph_lo = p; a.ph_hi = p + 1; a.li = p; hipLaunchKernelGGL(trunk_fwd, dim3(grid), dim3(NTHR), LDS_BYTES, stream, a);
#if DBG
        if (p == 1 || p == 2 || p == 4 || p == 5 || p == 6) hipLaunchKernelGGL(dbg_check, dim3(8), dim3(512), 0, stream, a, p);
        if (p == DBG_LAST) { hipLaunchKernelGGL(dbg_encode, dim3(1024), dim3(512), 0, stream, a, 9, MTOK * DM); break; }
#endif
    }
#else
    a.ph_lo = 0; a.ph_hi = NPH; a.li = 0;
    hipLaunchKernelGGL(trunk_fwd, dim3(grid), dim3(NTHR), LDS_BYTES, stream, a);
#endif
}
```

```cpp
#include <hip/hip_runtime.h>
#include <hip/hip_bf16.h>
#include <cstdio>
#include <cstdint>

#ifndef MK_PER_PHASE
#define MK_PER_PHASE 0
#endif
#ifndef KO
#define KO 0
#endif
#define DBG 0
#define DBG_LAST 1
#ifndef PROBE_PH
#define PROBE_PH -1
#endif
#ifndef HG_SKIP
#define HG_SKIP 0
#define AT_SKIP 0
#endif
#ifndef HGRN_MFMA
#define HGRN_MFMA 1
#endif
#ifndef FFN_GU8
#define FFN_GU8 0
#endif
#ifndef FFN_DN8
#define FFN_DN8 1
#endif
#ifndef FAST_ATTN
#define FAST_ATTN 1
#endif

#define LAS __attribute__((address_space(3)))
#define GAS __attribute__((address_space(1)))
typedef unsigned short bf16_t;
typedef short bf16x8 __attribute__((ext_vector_type(8)));
typedef float f32x4 __attribute__((ext_vector_type(4)));
typedef float f32x2 __attribute__((ext_vector_type(2)));
typedef unsigned u32x4 __attribute__((ext_vector_type(4)));
typedef unsigned u32x2 __attribute__((ext_vector_type(2)));
typedef unsigned long long u64;

constexpr int NB = 16, SEQ = 2048, DM = 1024, MTOK = NB * SEQ;
constexpr int N0 = 2816;
constexpr int N0SRC = 2636, N1 = 3584, FF = 2816, FFE = 3584, NEXP = 8;
constexpr float EPS = 1e-6f;
constexpr float LOG2E = 1.4426950408889634f;
constexpr float C2 = 0.125f * LOG2E;
constexpr int C0_FQ = 0, C0_DQ = 512, C0_FK = 1024, C0_FV = 1536, C0_DK = 2048, C0_DV = 2176, C0_IQ = 2304, C0_IK = 2560, C0_FF = 2624, C0_IW = 2632;
constexpr int C1_HQ = 0, C1_Q = 512, C1_HF = 1024, C1_HI = 1536, C1_HG = 2048, C1_K = 2560, C1_V = 3072;

constexpr size_t MiB = 1u << 20;
constexpr size_t WS_FLAG = 64 * 1024;
constexpr size_t WS_CTL = 0, CTL_ZERO_BYTES = 64 * 1024 + 32768;
constexpr size_t WS_ROPE = 1 * MiB;
constexpr size_t WS_IW   = WS_ROPE + 512 * 1024;
constexpr size_t WS_LOGF = 2 * MiB;
constexpr size_t WS_CB   = 3 * MiB;
constexpr size_t WS_SS   = 4 * MiB;
constexpr size_t WS_WRT  = 6 * MiB;
constexpr size_t WS_FQK  = 6 * MiB + 64 * 1024;
constexpr size_t WS_GATE = 6 * MiB + 256 * 1024;
constexpr size_t WS_LIST = 7 * MiB;
constexpr size_t WS_WIN0 = 10 * MiB;
constexpr size_t WS_WOUT0 = 16 * MiB;
constexpr size_t WS_WGU0 = 18 * MiB;
constexpr size_t WS_WDN0 = 29 * MiB;
constexpr size_t WS_WIN1 = 35 * MiB;
constexpr size_t WS_WOUT1 = 42 * MiB;
constexpr size_t WS_WEGU = 44 * MiB;
constexpr size_t WS_WEDN = 100 * MiB;
constexpr size_t WS_XB8 = 128 * MiB;
constexpr size_t WS_Y0 = 16 * MiB;
constexpr size_t WS_DY = 128 * MiB;
constexpr size_t WS_MASK = 160 * MiB;
constexpr float SW8 = 64.0f, SX8 = 8.0f, SH8 = 4.0f;
constexpr size_t WS_XB = 212 * MiB;
constexpr size_t WS_BIG = 276 * MiB;
constexpr size_t WS_END = 514 * MiB;
constexpr int MAXPANEL = 136;
static_assert(WS_BIG + (size_t)MAXPANEL * 256 * FFE * 2 <= WS_END && WS_BIG + (size_t)MTOK * N1 * 2 <= WS_END, "ws map");
constexpr int CW_TMO = 0, CW_CODE = 1;
constexpr int CW_CNT = 64;
constexpr int CW_BAR = 4096;

constexpr int RING_BYTES = 151552;
constexpr int LDSCTL_OFF = RING_BYTES, MISC_OFF = LDSCTL_OFF + 320;
constexpr int LDS_BYTES = 155648;
constexpr int NWAVES = 8, NTHR = 512;

#define RLX_AGENT __ATOMIC_RELAXED, __HIP_MEMORY_SCOPE_AGENT
#define LDS_WAIT() asm volatile("s_waitcnt lgkmcnt(0)" ::: "memory")
__device__ __forceinline__ unsigned cvt_pk_bf16(float lo, float hi) { unsigned r; asm volatile("v_cvt_pk_bf16_f32 %0, %1, %2" : "=v"(r) : "v"(lo), "v"(hi)); return r; }
typedef __bf16 bf16x2_v __attribute__((ext_vector_type(2)));
__device__ __forceinline__ unsigned cvt_pk_bf16_v(float lo, float hi) { f32x2 v = {lo, hi}; bf16x2_v b = __builtin_convertvector(v, bf16x2_v); return __builtin_bit_cast(unsigned, b); }
__device__ __forceinline__ float bf_lo(unsigned u) { return __uint_as_float(u << 16); }
__device__ __forceinline__ float bf_hi(unsigned u) { return __uint_as_float(u & 0xffff0000u); }
__device__ __forceinline__ float bf1(bf16_t u) { return __uint_as_float(((unsigned)u) << 16); }
#define DPP_F(v, ctrl) __uint_as_float((unsigned)__builtin_amdgcn_update_dpp(0, (int)__float_as_uint(v), ctrl, 0xF, 0xF, true))
__device__ __forceinline__ float wave_sum(float v) {
    v += DPP_F(v, 0xB1); v += DPP_F(v, 0x4E); v += DPP_F(v, 0x141); v += DPP_F(v, 0x140);
    const int b = (int)__float_as_uint(v);
    return (__uint_as_float((unsigned)__builtin_amdgcn_readlane(b, 0)) + __uint_as_float((unsigned)__builtin_amdgcn_readlane(b, 16))) + (__uint_as_float((unsigned)__builtin_amdgcn_readlane(b, 32)) + __uint_as_float((unsigned)__builtin_amdgcn_readlane(b, 48)));
}
__device__ __forceinline__ float wave_max(float v) {
    v = fmaxf(v, DPP_F(v, 0xB1)); v = fmaxf(v, DPP_F(v, 0x4E)); v = fmaxf(v, DPP_F(v, 0x141)); v = fmaxf(v, DPP_F(v, 0x140));
    const int b = (int)__float_as_uint(v);
    return fmaxf(fmaxf(__uint_as_float((unsigned)__builtin_amdgcn_readlane(b, 0)), __uint_as_float((unsigned)__builtin_amdgcn_readlane(b, 16))), fmaxf(__uint_as_float((unsigned)__builtin_amdgcn_readlane(b, 32)), __uint_as_float((unsigned)__builtin_amdgcn_readlane(b, 48))));
}
__device__ __forceinline__ float sigmoidf_(float x) { return 1.0f / (1.0f + __expf(-x)); }
__device__ __forceinline__ float siluf_(float x) { return x / (1.0f + __expf(-x)); }

namespace pg8 {
constexpr int BM = 256, BK = 64, HALF = 128, HTB = HALF * BK * 2, STAGE_BYTES = 8 * HTB, NXCD = 8, WGM = 8;
__host__ __device__ __forceinline__ int lds_byte(int r, int c) { const int st = (r >> 4) * 2 + (c >> 5), rr = r & 15, cc = c & 31, ob = rr * 64 + cc * 2; return st * 1024 + (ob ^ (((ob >> 9) & 1) << 5)); }
__host__ __device__ __forceinline__ void stage_rc(int b, int& R, int& C) { const int st = b / 1024, sb = b % 1024, swz = sb ^ (((sb >> 9) & 1) << 5); R = (st >> 1) * 16 + swz / 64; C = (st & 1) * 32 + (swz % 64) / 2; }
__host__ __device__ __forceinline__ int perm32(int rho) { const int n = rho >> 4, i = rho & 15; return 8 * (i >> 2) + 4 * n + (i & 3); }

typedef int v4i_t __attribute__((ext_vector_type(4)));
typedef int v8i_t __attribute__((ext_vector_type(8)));
struct Unit { int pm, pn, e, nvalid, lbase, kc; };
struct Gemm { const void* A; const void* Bt; int lda; int K; size_t bstride_e; const int* list; };

__device__ __forceinline__ void swz_order(int L, int nM, int nN, int& pm, int& pn) {
    const int nwg = nM * nN; int wgid = L;
    { const int q = nwg / NXCD, r = nwg % NXCD, xcd = wgid % NXCD, off = wgid / NXCD; wgid = (xcd < r ? xcd * (q + 1) : r * (q + 1) + (xcd - r) * q) + off; }
    const int nig = WGM * nN, gid = wgid / nig, fm = gid * WGM, gsz = (nM - fm) < WGM ? (nM - fm) : WGM;
    pm = fm + ((wgid % nig) % gsz); pn = (wgid % nig) / gsz;
}
struct StaticOrder {
    int nM, nN, nwg, G, c;
    __device__ __forceinline__ void init(int M, int N, int G_, int c_) { nM = M / BM; nN = N / BM; nwg = nM * nN; G = G_; c = c_; }
    __device__ __forceinline__ bool next(int i, Unit& u) const {
        const long L = (long)i * G + c; if (L >= nwg) return false;
        swz_order((int)L, nM, nN, u.pm, u.pn); u.e = 0; u.nvalid = BM; u.lbase = 0; u.kc = 0; return true;
    }
};
struct MoeOrder {
    int nN, NP0, NPt, G, c; int a0, a1, a2, a3, a4, a5, a6, a7, b0, b1, b2, b3, b4, b5, b6, b7;
    int mode, Lmain, Pmain;
    __device__ __forceinline__ static int npan(int x0, int x1, int x2, int x3, int x4, int x5, int x6, int x7) {
        int n = ((x0 + 255) >> 8) + ((x1 + 255) >> 8) + ((x2 + 255) >> 8) + ((x3 + 255) >> 8) + ((x4 + 255) >> 8) + ((x5 + 255) >> 8) + ((x6 + 255) >> 8) + ((x7 + 255) >> 8); return n > MAXPANEL ? MAXPANEL : n; }
    __device__ __forceinline__ void init(const unsigned* cntp, int nN_, int G_, int c_) {
        nN = nN_; G = G_; c = c_;
        a0 = (int)cntp[0]; a1 = (int)cntp[1]; a2 = (int)cntp[2]; a3 = (int)cntp[3]; a4 = (int)cntp[4]; a5 = (int)cntp[5]; a6 = (int)cntp[6]; a7 = (int)cntp[7];
        b0 = (int)cntp[8]; b1 = (int)cntp[9]; b2 = (int)cntp[10]; b3 = (int)cntp[11]; b4 = (int)cntp[12]; b5 = (int)cntp[13]; b6 = (int)cntp[14]; b7 = (int)cntp[15];
        NP0 = npan(a0, a1, a2, a3, a4, a5, a6, a7); NPt = NP0 + npan(b0, b1, b2, b3, b4, b5, b6, b7);
        mode = 0; Lmain = (NPt * nN / G) * G; if (Lmain % nN) Lmain = 0; Pmain = Lmain / nN;
    }
    __device__ __forceinline__ bool next(int i, Unit& u) const {
        const long L = (long)i * G + c + (mode == 2 ? Lmain : 0); if (L >= (mode == 1 ? (long)Lmain : (long)NPt * nN)) return false;
        int pg, pn;
        if (mode == 0) swz_order((int)L, NPt, nN, pg, pn); else if (mode == 1) swz_order((int)L, Pmain, nN, pg, pn); else { pg = Pmain + ((int)L - Lmain) / nN; pn = ((int)L - Lmain) % nN; }
        panel(pg, u); u.pn = pn; return true;
    }
    __device__ __forceinline__ void panel(int pg, Unit& u) const {
        const int pn = 0;
        const int kc = pg >= NP0 ? 1 : 0, pm = pg - (kc ? NP0 : 0);
        const int c0 = kc ? b0 : a0, c1 = kc ? b1 : a1, c2 = kc ? b2 : a2, c3 = kc ? b3 : a3, c4 = kc ? b4 : a4, c5 = kc ? b5 : a5, c6 = kc ? b6 : a6, c7 = kc ? b7 : a7;
        int e = 0, ps = 0, ce = c0;
#define MOE_STEP(CN, CNEXT, EI) { const int np = ((CN) + 255) >> 8; if (e == (EI) - 1 && pm >= ps + np) { ps += np; e = (EI); ce = (CNEXT); } }
        MOE_STEP(c0, c1, 1) MOE_STEP(c1, c2, 2) MOE_STEP(c2, c3, 3) MOE_STEP(c3, c4, 4) MOE_STEP(c4, c5, 5) MOE_STEP(c5, c6, 6) MOE_STEP(c6, c7, 7)
#undef MOE_STEP
        const int local = pm - ps; int nv = ce - local * 256; nv = nv > 256 ? 256 : nv; nv = nv < 1 ? 1 : nv;
        u.pm = kc * MAXPANEL + pm; u.pn = pn; u.e = e; u.nvalid = nv; u.lbase = (kc * 8 + e) * MTOK + local * 256; u.kc = kc;
    }
};

__device__ __forceinline__ float row_rstd(const float* SS, int row, int fq) {
    const f32x4* pp = (const f32x4*)(SS + (size_t)row * 16); const f32x4 p0 = pp[0], p1 = pp[1], p2 = pp[2], p3 = pp[3]; (void)fq;
    const float s = ((p0[0] + p0[1]) + (p0[2] + p0[3])) + ((p1[0] + p1[1]) + (p1[2] + p1[3])) + ((p2[0] + p2[1]) + (p2[2] + p2[3])) + ((p3[0] + p3[1]) + (p3[2] + p3[3]));
    return rsqrtf(s * (1.0f / DM) + EPS);
}

struct EpiIn {
    static constexpr bool PERM = true;
    bf16_t* O; int ldc; const float* SS; const float* rope; float* LOGF; float* IW; const float* bfox; int layer;
    __device__ __forceinline__ int kind_of(int g64) const {
        if (layer == 0) { if (g64 < 8) return 1; if (g64 < 16) return 3; if (g64 < 32) return 0; if (g64 < 34) return 2; if (g64 < 36) return 0; if (g64 < 40) return 4; if (g64 == 40) return 2; if (g64 == 41) return 5; return 0; }
        if (g64 < 8) return 6; if (g64 >= 8 && g64 < 16) return 3; if (g64 >= 40 && g64 < 48) return 2; return 0;
    }
    __device__ __forceinline__ void operator()(const f32x4 (&acc)[2][2][4][2], const Unit& u, int wr, int wc, int fr, int fq) const {
        const int row0 = u.pm * BM + wr * 64 + fr;
        int kind[2]; int colb[2];
#pragma unroll
        for (int bj = 0; bj < 2; ++bj) { colb[bj] = u.pn * BM + bj * HALF + wc * 32; kind[bj] = kind_of(colb[bj] >> 6); }
        const bool anyrope = (kind[0] >= 2 && kind[0] <= 4) || (kind[1] >= 2 && kind[1] <= 4);
        const int i0 = (((wc & 1) * 32) + 8 * fq) >> 1;
#pragma unroll
        for (int ai = 0; ai < 2; ++ai)
#pragma unroll
            for (int m = 0; m < 4; ++m) {
                const int row = row0 + ai * HALF + m * 16;
                const float rs = row_rstd(SS, row, fq);
                f32x4 cs0 = (f32x4){1.f, 0.f, 1.f, 0.f}, cs1 = cs0;
                if (anyrope) { const float* rp = rope + ((size_t)(row & (SEQ - 1)) * 32 + i0) * 2; cs0 = *(const f32x4*)rp; cs1 = *(const f32x4*)(rp + 4); }
#pragma unroll
                for (int bj = 0; bj < 2; ++bj) {
                    f32x4 v0 = acc[ai][bj][m][0] * rs, v1 = acc[ai][bj][m][1] * rs;
                    const int kd = kind[bj];
                    if (kd >= 2 && kd <= 4) {
                        f32x4 a, b;
                        a[0] = v0[0] * cs0[0] - v0[1] * cs0[1]; a[1] = v0[1] * cs0[0] + v0[0] * cs0[1];
                        a[2] = v0[2] * cs0[2] - v0[3] * cs0[3]; a[3] = v0[3] * cs0[2] + v0[2] * cs0[3];
                        b[0] = v1[0] * cs1[0] - v1[1] * cs1[1]; b[1] = v1[1] * cs1[0] + v1[0] * cs1[1];
                        b[2] = v1[2] * cs1[2] - v1[3] * cs1[3]; b[3] = v1[3] * cs1[2] + v1[2] * cs1[3];
                        v0 = a; v1 = b;
                    }
                    const float sc = (kd == 1 || kd == 3) ? C2 : (kd == 4 ? 0.125f : 1.0f);
                    if (kd == 5 && (wc & 1) == 0) {
                        if (fq == 0) { f32x4 l0, l1;
#pragma unroll
                            for (int j = 0; j < 4; ++j) { const float x0 = v0[j] + bfox[j], x1 = v1[j] + bfox[4 + j];
                                l0[j] = fminf(x0, 0.f) - log1pf(__expf(-fabsf(x0))); l1[j] = fminf(x1, 0.f) - log1pf(__expf(-fabsf(x1))); }
                            *(f32x4*)(LOGF + (size_t)row * 8) = l0; *(f32x4*)(LOGF + (size_t)row * 8 + 4) = l1; }
                        if (fq == 1) { *(f32x4*)(IW + (size_t)row * 4) = v0 * 0.5f; }
                    }
                    v0 = v0 * sc; v1 = v1 * sc;
                    if (kd == 6) {
#pragma unroll
                        for (int j = 0; j < 4; ++j) { v0[j] = v0[j] * __builtin_amdgcn_rcpf(1.0f + __builtin_amdgcn_exp2f(-LOG2E * v0[j])); v1[j] = v1[j] * __builtin_amdgcn_rcpf(1.0f + __builtin_amdgcn_exp2f(-LOG2E * v1[j])); } }
                    u32x4 w; w.x = cvt_pk_bf16(v0[0], v0[1]); w.y = cvt_pk_bf16(v0[2], v0[3]); w.z = cvt_pk_bf16(v1[0], v1[1]); w.w = cvt_pk_bf16(v1[2], v1[3]);
                    *(u32x4*)(O + (size_t)row * ldc + colb[bj] + 8 * fq) = w;
                }
            }
    }
};
template <bool BASE16> struct EpiRes {
    static constexpr bool PERM = false;
    const float* base; float* out; bf16_t* xb; float* SS; int omask; unsigned char* xb8; float ascale;
    __device__ __forceinline__ void operator()(const f32x4 (&acc)[2][2][4][2], const Unit& u, int wr, int wc, int fr, int fq) const {
        const int col0 = u.pn * BM + wc * 32 + 4 * fq;
#pragma unroll
        for (int ai = 0; ai < 2; ++ai) {
            f32x4 pre[4][2][2];
#pragma unroll
            for (int m = 0; m < 4; ++m)
#pragma unroll
                for (int bj = 0; bj < 2; ++bj)
#pragma unroll
                    for (int n = 0; n < 2; ++n) { const size_t off = (size_t)(u.pm * BM + ai * HALF + wr * 64 + m * 16 + fr) * DM + col0 + bj * HALF + n * 16;
                        if (BASE16) { const u32x2 w = *(const u32x2*)((const bf16_t*)base + off); pre[m][bj][n] = (f32x4){bf_lo(w.x), bf_hi(w.x), bf_lo(w.y), bf_hi(w.y)}; } else pre[m][bj][n] = *(const f32x4*)(base + off); }
#pragma unroll
            for (int m = 0; m < 4; ++m) {
                const int row = u.pm * BM + ai * HALF + wr * 64 + m * 16 + fr; float ssq = 0.f;
#pragma unroll
                for (int bj = 0; bj < 2; ++bj)
#pragma unroll
                    for (int n = 0; n < 2; ++n) {
                        const size_t offo = (size_t)(row & omask) * DM + col0 + bj * HALF + n * 16;
                        const f32x4 o = pre[m][bj][n] + acc[ai][bj][m][n] * ascale;
                        if (out) *(f32x4*)(out + offo) = o; ssq += (o[0] * o[0] + o[1] * o[1]) + (o[2] * o[2] + o[3] * o[3]);
                        u32x2 w; w.x = cvt_pk_bf16(o[0], o[1]); w.y = cvt_pk_bf16(o[2], o[3]); *(u32x2*)(xb + offo) = w;
                        if (xb8) { int p = __builtin_amdgcn_cvt_pk_fp8_f32(o[0] * SX8, o[1] * SX8, 0, false); p = __builtin_amdgcn_cvt_pk_fp8_f32(o[2] * SX8, o[3] * SX8, p, true); *(int*)(xb8 + offo) = p; }
                    }
                ssq += __shfl_xor(ssq, 16); ssq += __shfl_xor(ssq, 32);
                if (fq == 0) SS[(size_t)(row & omask) * 16 + u.pn * 4 + wc] = ssq;
            }
        }
    }
};
template <bool MOE, bool H8 = MOE, bool IN8 = MOE> struct EpiGU {
    static constexpr bool PERM = true;
    bf16_t* H; int ldh; const float* SS; const int* list;
    __device__ __forceinline__ void operator()(const f32x4 (&acc)[2][2][4][2], const Unit& u, int wr, int wc, int fr, int fq) const {
        const int hcol = u.pn * HALF + wc * 32 + 8 * fq;
#pragma unroll
        for (int ai = 0; ai < 2; ++ai)
#pragma unroll
            for (int m = 0; m < 4; ++m) {
                const int rl = ai * HALF + wr * 64 + m * 16 + fr;
                const float rs = MOE ? 1.0f / (SX8 * SW8) : row_rstd(SS, u.pm * BM + rl, fq) * (IN8 ? 1.0f / (SX8 * SW8) : 1.0f);
                unsigned w[4];
                const float c1 = -LOG2E * rs, c2 = rs * rs * (H8 ? SH8 : 1.0f);
#pragma unroll
                for (int n = 0; n < 2; ++n) { float h[4];
#pragma unroll
                    for (int jp = 0; jp < 2; ++jp) {
                        const f32x2 g2 = (f32x2){acc[ai][0][m][n][2 * jp], acc[ai][0][m][n][2 * jp + 1]}, u2 = (f32x2){acc[ai][1][m][n][2 * jp], acc[ai][1][m][n][2 * jp + 1]};
                        const f32x2 a = g2 * c1; f32x2 t = (f32x2){__builtin_amdgcn_exp2f(a[0]), __builtin_amdgcn_exp2f(a[1])}; t = t + 1.0f;
                        const f32x2 r = (f32x2){__builtin_amdgcn_rcpf(t[0]), __builtin_amdgcn_rcpf(t[1])};
                        const f32x2 h2 = ((g2 * u2) * c2) * r; h[2 * jp] = h2[0]; h[2 * jp + 1] = h2[1]; }
                    if (H8) { int p = __builtin_amdgcn_cvt_pk_fp8_f32(h[0], h[1], 0, false); p = __builtin_amdgcn_cvt_pk_fp8_f32(h[2], h[3], p, true); w[n] = (unsigned)p; }
                    else { w[2 * n] = cvt_pk_bf16(h[0], h[1]); w[2 * n + 1] = cvt_pk_bf16(h[2], h[3]); } }
                if (H8) *(u32x2*)((unsigned char*)H + (size_t)(u.pm * BM + rl) * ldh + hcol) = (u32x2){w[0], w[1]};
                else *(u32x4*)(H + (size_t)(u.pm * BM + rl) * ldh + hcol) = (u32x4){w[0], w[1], w[2], w[3]};
            }
    }
};
struct EpiMoeDown {
    static constexpr bool PERM = false;
    bf16_t* y0; const int* list; const float* gate; int tmask; bf16_t* y1;
    __device__ __forceinline__ void operator()(const f32x4 (&acc)[2][2][4][2], const Unit& u, int wr, int wc, int fr, int fq) const {
        const int col0 = u.pn * BM + wc * 32 + 4 * fq;
#pragma unroll
        for (int ai = 0; ai < 2; ++ai) {
            int tk[4]; float gg[4];
#pragma unroll
            for (int m = 0; m < 4; ++m) { const int rl = ai * HALF + wr * 64 + m * 16 + fr; const int rc = rl < u.nvalid ? rl : u.nvalid - 1; tk[m] = list[u.lbase + rc]; }
#pragma unroll
            for (int m = 0; m < 4; ++m) gg[m] = gate[u.kc * MTOK + tk[m]] * (1.0f / (SH8 * SW8));
            bf16_t* yb = u.kc ? y1 : y0;
#pragma unroll
            for (int m = 0; m < 4; ++m) { const int rl = ai * HALF + wr * 64 + m * 16 + fr; if (rl < u.nvalid) {
#pragma unroll
                for (int bj = 0; bj < 2; ++bj)
#pragma unroll
                    for (int n = 0; n < 2; ++n) { const f32x4 v = acc[ai][bj][m][n] * gg[m]; u32x2 w; w.x = cvt_pk_bf16(v[0], v[1]); w.y = cvt_pk_bf16(v[2], v[3]);
                        *(u32x2*)(yb + (size_t)(tk[m] & tmask) * DM + col0 + bj * HALF + n * 16) = w; } } }
        }
    }
};

template <bool GATHER> __device__ __forceinline__ void a_offsets(const Gemm& g, const Unit& u, const int (&R)[2], const int (&C)[2], unsigned (&ao)[2][2]) {
#pragma unroll
    for (int h = 0; h < 2; ++h)
#pragma unroll
        for (int i = 0; i < 2; ++i) { const int rl = h * HALF + R[i]; size_t row;
            if (GATHER) { const int rc = rl < u.nvalid ? rl : u.nvalid - 1; row = (size_t)g.list[u.lbase + rc]; } else row = (size_t)u.pm * BM + rl;
            ao[h][i] = (unsigned)(row * (size_t)g.lda + C[i] * 2); }
}

template <class Epi, class Sched, bool GATHER, bool ALIGN_EPI, bool FP8 = false>
__device__ __forceinline__ void gemm_phase(LAS unsigned char* lds, const Gemm g, const Sched& S, const Epi& E) {
    const int tid = threadIdx.x, wid = __builtin_amdgcn_readfirstlane(tid >> 6), lane = tid & 63, wr = wid >> 2, wc = wid & 3, fr = lane & 15, fq = lane >> 4;
    const int K = g.K, nt = K / (BK * 2);
    int RR[2], CC[2]; unsigned voffB[2];
#pragma unroll
    for (int i = 0; i < 2; ++i) { int R, C; stage_rc(tid * 16 + i * 8192, R, C); RR[i] = R; CC[i] = C; const int Rb = Epi::PERM ? ((R & ~31) + perm32(R & 31)) : R; voffB[i] = (unsigned)(Rb * K + C * 2); }
    const size_t kstep = (size_t)(BK * 2);
    const size_t hstepB = (size_t)HALF * K;
    const size_t tstepB = 2 * hstepB;
    const unsigned ldsw = (unsigned)wid * 1024u;
    const int aoff = lds_byte(wr * 64 + fr, fq * 8), boff = lds_byte(wc * 32 + fr, fq * 8);
#define PG8_SA(b, h) (((b) * 2 + (h)) * HTB)
#define PG8_SB(b, h) ((4 + (b) * 2 + (h)) * HTB)
#define PG8_STAGE_B(bufoff, gbase) do { _Pragma("unroll") for (int _i = 0; _i < 2; ++_i) \
        __builtin_amdgcn_global_load_lds((const unsigned*)((const char*)(gbase) + voffB[_i]), (LAS unsigned*)(lds + (bufoff) + ldsw + _i * 8192), 16, 0, 0); } while (0)
#define PG8_STAGE_A(bufoff, kb, AO) do { _Pragma("unroll") for (int _i = 0; _i < 2; ++_i) \
        __builtin_amdgcn_global_load_lds((const unsigned*)(Ab + (kb) + (AO)[_i]), (LAS unsigned*)(lds + (bufoff) + ldsw + _i * 8192), 16, 0, 0); } while (0)
#define PG8_LDA(dst, b, h) do { _Pragma("unroll") for (int m = 0; m < 4; ++m) { const bf16x8 r0_ = *(const LAS bf16x8*)(lds + PG8_SA(b, h) + aoff + m * 2048), r1_ = *(const LAS bf16x8*)(lds + PG8_SA(b, h) + aoff + m * 2048 + 1024); \
        if constexpr (FP8) dst##8[m] = PG8_CAT8(r0_, r1_); else { dst[m][0] = r0_; dst[m][1] = r1_; } } } while (0)
#define PG8_LDB(dst, b, h) do { _Pragma("unroll") for (int n = 0; n < 2; ++n) { const bf16x8 r0_ = *(const LAS bf16x8*)(lds + PG8_SB(b, h) + boff + n * 2048), r1_ = *(const LAS bf16x8*)(lds + PG8_SB(b, h) + boff + n * 2048 + 1024); \
        if constexpr (FP8) dst##8[n] = PG8_CAT8(r0_, r1_); else { dst[n][0] = r0_; dst[n][1] = r1_; } } } while (0)
#define PG8_CAT8(x0, x1) __builtin_shufflevector(__builtin_bit_cast(v4i_t, x0), __builtin_bit_cast(v4i_t, x1), 0, 1, 2, 3, 4, 5, 6, 7)
#define PG8_MMA(ai, bj, At, Bt) do { __builtin_amdgcn_s_setprio(1); _Pragma("unroll") for (int m = 0; m < 4; ++m) _Pragma("unroll") for (int n = 0; n < 2; ++n) { \
        if constexpr (FP8) asm volatile("v_mfma_f32_16x16x128_f8f6f4 %0, %1, %2, %0" : "+v"(acc[ai][bj][m][n]) : "v"(Bt##8[n]), "v"(At##8[m])); \
        else { _Pragma("unroll") for (int k = 0; k < 2; ++k) acc[ai][bj][m][n] = __builtin_amdgcn_mfma_f32_16x16x32_bf16(Bt[n][k], At[m][k], acc[ai][bj][m][n], 0, 0, 0); } } __builtin_amdgcn_s_setprio(0); } while (0)
#define PG8_WAIT_V(n) asm volatile("s_waitcnt vmcnt(" #n ")" ::: "memory")
#define PG8_WAIT_L(n) asm volatile("s_waitcnt lgkmcnt(" #n ")" ::: "memory")
#define PG8_BAR __builtin_amdgcn_s_barrier()
#define PG8_SCHED __builtin_amdgcn_sched_barrier(0)
    Unit cur, nxt; int ui = 0;
    if (!S.next(0, cur)) return;
    f32x4 acc[2][2][4][2];
#pragma unroll
    for (int a = 0; a < 2; ++a)
#pragma unroll
        for (int b = 0; b < 2; ++b)
#pragma unroll
            for (int m = 0; m < 4; ++m)
#pragma unroll
                for (int n = 0; n < 2; ++n) acc[a][b][m][n] = (f32x4){0.f, 0.f, 0.f, 0.f};
    bf16x8 At[4][2], B0[2][2], B1[2][2];
    v8i_t At8[4], B08[2], B18[2];
    unsigned cao[2][2], nao[2][2];
    a_offsets<GATHER>(g, cur, RR, CC, cao);
    const char* Ab = (const char*)g.A;
    const char* cB = (const char*)g.Bt + (size_t)cur.e * g.bstride_e + (size_t)cur.pn * tstepB;
    PG8_STAGE_B(PG8_SB(0, 0), cB); PG8_STAGE_B(PG8_SB(0, 1), cB + hstepB); PG8_STAGE_A(PG8_SA(0, 0), 0, cao[0]); PG8_STAGE_A(PG8_SA(0, 1), 0, cao[1]);
    if (wr == 1) PG8_BAR;
    PG8_WAIT_V(2); PG8_BAR;
    PG8_STAGE_B(PG8_SB(1, 0), cB + kstep); PG8_STAGE_A(PG8_SA(1, 0), kstep, cao[0]); PG8_STAGE_B(PG8_SB(1, 1), cB + hstepB + kstep);
    PG8_WAIT_V(6); PG8_BAR;
    for (;;) {
        const bool has_next = S.next(ui + 1, nxt);
        if (has_next) a_offsets<GATHER>(g, nxt, RR, CC, nao);
        else {
#pragma unroll
            for (int h = 0; h < 2; ++h)
#pragma unroll
                for (int i = 0; i < 2; ++i) nao[h][i] = cao[h][i]; }
        const char* nB = has_next ? (const char*)g.Bt + (size_t)nxt.e * g.bstride_e + (size_t)nxt.pn * tstepB : cB;
        for (int t = 0; t < nt; t += 2) {
            const bool last = (t == nt - 2);
            const size_t ka1 = (size_t)(t + 1) * kstep;
            const size_t ka2 = last ? 0 : (size_t)(t + 2) * kstep; const char* b2 = last ? nB : cB + (size_t)(t + 2) * kstep;
            const size_t ka3 = ka2 + kstep; const char* b3 = b2 + kstep;
            unsigned ao2[2][2];
#pragma unroll
            for (int h = 0; h < 2; ++h)
#pragma unroll
                for (int i = 0; i < 2; ++i) ao2[h][i] = last ? nao[h][i] : cao[h][i];
            PG8_LDB(B0, 0, 0); PG8_LDB(B1, 0, 1); PG8_SCHED; PG8_LDA(At, 0, 0); PG8_STAGE_A(PG8_SA(1, 1), ka1, cao[1]);
            PG8_WAIT_V(8); PG8_WAIT_L(0); PG8_BAR; PG8_MMA(0, 0, At, B0); PG8_MMA(0, 1, At, B1); PG8_BAR; PG8_SCHED;
            PG8_LDA(At, 0, 1); PG8_STAGE_B(PG8_SB(0, 0), b2); PG8_STAGE_B(PG8_SB(0, 1), b2 + hstepB); PG8_STAGE_A(PG8_SA(0, 0), ka2, ao2[0]);
            PG8_WAIT_V(8); PG8_WAIT_L(0); PG8_BAR; PG8_MMA(1, 0, At, B0); PG8_MMA(1, 1, At, B1); PG8_BAR; PG8_SCHED;
            PG8_LDB(B0, 1, 0); PG8_LDB(B1, 1, 1); PG8_SCHED; PG8_LDA(At, 1, 0); PG8_STAGE_A(PG8_SA(0, 1), ka2, ao2[1]);
            PG8_WAIT_V(8); PG8_WAIT_L(0); PG8_BAR; PG8_MMA(0, 0, At, B0); PG8_MMA(0, 1, At, B1); PG8_BAR; PG8_SCHED;
            PG8_LDA(At, 1, 1); PG8_STAGE_B(PG8_SB(1, 0), b3); PG8_STAGE_B(PG8_SB(1, 1), b3 + hstepB); PG8_STAGE_A(PG8_SA(1, 0), ka3, ao2[0]);
            PG8_WAIT_V(8); PG8_WAIT_L(0); PG8_BAR; PG8_MMA(1, 0, At, B0); PG8_MMA(1, 1, At, B1); PG8_BAR; PG8_SCHED;
        }
        if constexpr (ALIGN_EPI) { if (wr == 0) PG8_BAR; }
        if constexpr (FP8) asm volatile("s_nop 15\n\ts_nop 15\n\ts_nop 15" ::: "memory");
        if constexpr (FP8) {
#pragma unroll
            for (int a = 0; a < 2; ++a)
#pragma unroll
                for (int b = 0; b < 2; ++b)
#pragma unroll
                    for (int m = 0; m < 4; ++m)
#pragma unroll
                        for (int n = 0; n < 2; ++n) asm volatile("" : "+v"(acc[a][b][m][n])); }
        E(acc, cur, wr, wc, fr, fq);
        if (!has_next) break;
#pragma unroll
        for (int a = 0; a < 2; ++a)
#pragma unroll
            for (int b = 0; b < 2; ++b)
#pragma unroll
                for (int m = 0; m < 4; ++m)
#pragma unroll
                    for (int n = 0; n < 2; ++n) acc[a][b][m][n] = (f32x4){0.f, 0.f, 0.f, 0.f};
        cur = nxt; cB = nB; ++ui;
#pragma unroll
        for (int h = 0; h < 2; ++h)
#pragma unroll
            for (int i = 0; i < 2; ++i) cao[h][i] = nao[h][i];
        if constexpr (ALIGN_EPI) { if (wr == 1) PG8_BAR; }
    }
    PG8_WAIT_V(0);
    if constexpr (!ALIGN_EPI) { if (wr == 0) PG8_BAR; }
    PG8_BAR;
#undef PG8_SA
#undef PG8_SB
#undef PG8_STAGE_A
#undef PG8_STAGE_B
#undef PG8_LDA
#undef PG8_LDB
#undef PG8_MMA
#undef PG8_CAT8
#undef PG8_WAIT_V
#undef PG8_WAIT_L
#undef PG8_BAR
#undef PG8_SCHED
}
}

namespace attn_body {
typedef float f32x4_t __attribute__((ext_vector_type(4)));

using bf16=__hip_bfloat16;
using bf16x8=__attribute__((ext_vector_type(8)))short;
using s16x4=__attribute__((ext_vector_type(4)))short;
using f32x16=__attribute__((ext_vector_type(16)))float;
using u32x4=__attribute__((ext_vector_type(4)))unsigned;
__device__ __forceinline__ u32x4 kbw_(unsigned long long w){ return (u32x4){(unsigned)w,(unsigned)(w>>32),0u,0u}; }
constexpr int D=64;
constexpr int NW=8,QBLK=32,QB=QBLK*NW,KVBLK=64;
__device__ __forceinline__ int crow(int r,int hi){return (r&3)+8*(r>>2)+4*hi;}
#define SBAR() __builtin_amdgcn_sched_barrier(0)
__device__ __forceinline__ void cmask(f32x16&p0,f32x16&p1,int jb,int qrel,int hi){
  const float NEG=-INFINITY; int kb=64*jb+4*hi;
  #pragma unroll
  for(int r=0;r<16;++r){int kv=kb+(r&3)+8*(r>>2); if(kv>qrel)p0[r]=NEG; if(kv+32>qrel)p1[r]=NEG;}
}

constexpr int NSLOT=3, SLOTB=8192;
constexpr int LDS_K=0, LDS_V=NSLOT*SLOTB, LDS_WS=2*NSLOT*SLOTB, LDS_OST=LDS_WS+NW*64*4, LDS_X=LDS_OST+NW*4096, LDS_BYTES=LDS_X+65536, LDS_BYTES_DV2=LDS_V+2*NSLOT*SLOTB+NW*64*4+NW*8192;
constexpr float C2A=0.125f*1.4426950408889634f;
__device__ __forceinline__ void glds16(const void*gsrc,unsigned lds_dst){unsigned keep;
  asm volatile("s_mov_b32 %0, m0\n\ts_mov_b32 m0, %2\n\ts_nop 0\n\tglobal_load_lds_dwordx4 %1, off\n\ts_mov_b32 m0, %0":"=&s"(keep):"v"(gsrc),"s"(lds_dst):"memory");}
__device__ __forceinline__ float max3f(float a,float b,float c){float r;asm("v_max3_f32 %0, %1, %2, %3":"=v"(r):"v"(a),"v"(b),"v"(c));return r;}
__device__ __forceinline__ float max2f(float a,float b){float r;asm("v_max_f32_e32 %0, %1, %2":"=v"(r):"v"(a),"v"(b));return r;}
__device__ __forceinline__ float fadd_s(float a,float b){float r;asm("v_add_f32_e32 %0, %1, %2":"=v"(r):"v"(a),"v"(b));return r;}
__device__ __forceinline__ float fsub_s(float a,float b){float r;asm("v_sub_f32_e32 %0, %1, %2":"=v"(r):"v"(a),"v"(b));return r;}
typedef float f32x2_t __attribute__((ext_vector_type(2))); typedef __bf16 bf16x2_t __attribute__((ext_vector_type(2)));
__device__ __forceinline__ unsigned cvtpk_s(float lo,float hi){f32x2_t v={lo,hi};bf16x2_t b=__builtin_convertvector(v,bf16x2_t);return __builtin_bit_cast(unsigned,b);}
#define WAIT_BAR(N) asm volatile("s_waitcnt vmcnt(" #N ") lgkmcnt(0)\n\ts_barrier":::"memory")

__device__ __forceinline__ void qkt(f32x16&p0,f32x16&p1,const char*Kslot,const bf16x8*qr,const f32x16&negm,int r32,int hi){
  const char*kb=Kslot+hi*1024+r32*16;
  #pragma unroll
  for(int d0=0;d0<4;++d0){
    const bf16x8 b0=*reinterpret_cast<const bf16x8*>(kb+d0*2048);
    const bf16x8 b1=*reinterpret_cast<const bf16x8*>(kb+d0*2048+512);
    if(d0==0){p0=__builtin_amdgcn_mfma_f32_32x32x16_bf16(b0,qr[0],negm,0,0,0);p1=__builtin_amdgcn_mfma_f32_32x32x16_bf16(b1,qr[0],negm,0,0,0);}
    else{p0=__builtin_amdgcn_mfma_f32_32x32x16_bf16(b0,qr[d0],p0,0,0,0);p1=__builtin_amdgcn_mfma_f32_32x32x16_bf16(b1,qr[d0],p1,0,0,0);}}
}
typedef __attribute__((address_space(3))) const char* lds_cptr;
typedef short v4i16_t __attribute__((ext_vector_type(4)));
__device__ __forceinline__ void kload8(bf16x8*kf,lds_cptr kp){
  kf[0]=*(const __attribute__((address_space(3))) bf16x8*)(kp);      kf[1]=*(const __attribute__((address_space(3))) bf16x8*)(kp+512);
  kf[2]=*(const __attribute__((address_space(3))) bf16x8*)(kp+2048); kf[3]=*(const __attribute__((address_space(3))) bf16x8*)(kp+2560);
  kf[4]=*(const __attribute__((address_space(3))) bf16x8*)(kp+4096); kf[5]=*(const __attribute__((address_space(3))) bf16x8*)(kp+4608);
  kf[6]=*(const __attribute__((address_space(3))) bf16x8*)(kp+6144); kf[7]=*(const __attribute__((address_space(3))) bf16x8*)(kp+6656);
}
__device__ __forceinline__ void kload2(bf16x8*kf,lds_cptr kp,int j){ kf[2*j]=*(const __attribute__((address_space(3))) bf16x8*)(kp+j*2048); kf[2*j+1]=*(const __attribute__((address_space(3))) bf16x8*)(kp+j*2048+512); }
__device__ __forceinline__ s16x4 vtr(lds_cptr p){ return __builtin_bit_cast(s16x4,__builtin_amdgcn_ds_read_tr16_b64_v4i16((__attribute__((address_space(3))) v4i16_t*)p)); }
__device__ __forceinline__ float rowmax(const f32x16&p0,const f32x16&p1){
  float a=max3f(p0[0],p0[1],p1[0]),b=max3f(p0[2],p0[3],p1[1]);a=max3f(a,p1[2],p1[3]);
  #pragma unroll
  for(int r=4;r<16;r+=4){a=max3f(a,p0[r],p0[r+1]);b=max3f(b,p0[r+2],p0[r+3]);a=max3f(a,p1[r],p1[r+1]);b=max3f(b,p1[r+2],p1[r+3]);}
  const float m=max2f(a,b);
  auto rr=__builtin_amdgcn_permlane32_swap(__float_as_uint(m),__float_as_uint(m),false,false);
  return max2f(__uint_as_float(rr[0]),__uint_as_float(rr[1]));
}
__device__ __forceinline__ void pv(f32x16*o,int vb,bf16x8 pa0,bf16x8 pa1,bf16x8 pa2,bf16x8 pa3){
  #pragma unroll
  for(int d0=0;d0<2;++d0){s16x4 lo[4],hi[4];
    #pragma unroll
    for(int ks=0;ks<4;++ks){
      asm volatile("ds_read_b64_tr_b16 %0,%1 offset:%c2":"=&v"(lo[ks]):"v"(vb),"i"(d0*4096+ks*1024):"memory");
      asm volatile("ds_read_b64_tr_b16 %0,%1 offset:%c2":"=&v"(hi[ks]):"v"(vb),"i"(d0*4096+ks*1024+512):"memory");}
    asm volatile("s_waitcnt lgkmcnt(0)":::"memory");SBAR();
    #define PK(k) (bf16x8){lo[k][0],lo[k][1],lo[k][2],lo[k][3],hi[k][0],hi[k][1],hi[k][2],hi[k][3]}
    o[d0]=__builtin_amdgcn_mfma_f32_32x32x16_bf16(pa0,PK(0),o[d0],0,0,0);
    o[d0]=__builtin_amdgcn_mfma_f32_32x32x16_bf16(pa1,PK(1),o[d0],0,0,0);
    o[d0]=__builtin_amdgcn_mfma_f32_32x32x16_bf16(pa2,PK(2),o[d0],0,0,0);
    o[d0]=__builtin_amdgcn_mfma_f32_32x32x16_bf16(pa3,PK(3),o[d0],0,0,0);
    #undef PK
  }
}

#ifndef ATTN_STORE16
#define ATTN_STORE16(p,v) (*(u32x4*)(p)=(v))
#endif
template<int THRL,int MODE,int qp,int kvp,int op,int QBI,bool PRE=false,bool PFN=false,bool DV2=false> __device__ __forceinline__ void attn_unit(const bf16*Qb,const bf16*__restrict__ Kb,const bf16*__restrict__ Vb,bf16*Ob,char*shm,const float*cb,const unsigned long long*maskb,const bf16*Kn=nullptr,const bf16*Vn=nullptr){
  constexpr int q0=QBI*QB;
  constexpr int VSL=DV2?2:1;
  constexpr int L_WS=LDS_V+NSLOT*SLOTB*VSL, L_OST=L_WS+NW*64*4, L_X=L_OST+NW*4096*VSL;
  static_assert(!DV2||MODE==0,"DV2 is for the plain causal mode");
  #define WB(NA,NB) do{ if(DV2){WAIT_BAR(NB);}else{WAIT_BAR(NA);} }while(0)
  int tid_=threadIdx.x; asm volatile("":"+v"(tid_));
  const int tid=tid_,lane=tid&63,r32=lane&31,hi=lane>>5; const int wid=__builtin_amdgcn_readfirstlane(tid>>6);
  const bf16*Qw=Qb+(long)(q0+wid*QBLK)*qp;
  const bf16*Kh=Kb,*Vh=Vb;
  const unsigned lds0=(unsigned)(uintptr_t)shm;
  float*wsf=(float*)(shm+L_WS)+wid*64;
  const lds_cptr shm3=(lds_cptr)shm;
  const bf16*ksrc=Kh+(long)lane*kvp+wid*8;
  const bf16*vsrc=Vh+(long)(16*(wid&3)+(lane>>2))*kvp+(wid>>2)*32+(lane&3)*8;
  const unsigned kdst=lds0+LDS_K+wid*1024, vdst=lds0+LDS_V+wid*1024;
  #define DMA_K(t,slot) glds16(ksrc+(long)(t)*KVBLK*kvp,(unsigned)__builtin_amdgcn_readfirstlane(kdst+(slot)))
  #define DMA_V(t,slot) do{ glds16(vsrc+(long)(t)*KVBLK*kvp,(unsigned)__builtin_amdgcn_readfirstlane(vdst+VSL*(slot))); if(DV2){glds16(vsrc+(long)(t)*KVBLK*kvp+64,(unsigned)__builtin_amdgcn_readfirstlane(vdst+VSL*(slot)+SLOTB));} }while(0)
  const int vb0=(int)(lds0+LDS_V)+((lane>>4)&1)*32+(lane&3)*8+(4*hi+((lane&15)>>2))*64;
  const char*Kbase=shm+LDS_K; bf16x8 kf[8];
  const lds_cptr kp0=shm3+LDS_K+hi*1024+r32*16; const lds_cptr vp0=shm3+LDS_V+((lane>>4)&1)*32+(lane&3)*8+(4*hi+((lane&15)>>2))*64;
  const int NT=(q0+QB)/KVBLK;
  typedef __attribute__((address_space(3))) unsigned long long* lds_u64p;
  const lds_u64p xq=(lds_u64p)(shm3+L_X);
  if(MODE==1){ const int s0=4*tid; if(s0<q0+QB){ const f32x4_t c=*reinterpret_cast<const f32x4_t*>(cb+s0);
      _Pragma("unroll") for(int j=0;j<4;++j){ const float x=-c[j]*1.4426950408889634f; const unsigned p1=cvtpk_s(x,0.f)&0xffffu; const float r1=x-__uint_as_float(p1<<16);
        const unsigned p2=cvtpk_s(r1,0.f)&0xffffu; const float r2=r1-__uint_as_float(p2<<16); const unsigned p3=cvtpk_s(r2,0.f)&0xffffu;
        *(__attribute__((address_space(3))) u32x4*)(shm3+L_X+(s0+j)*16)=(u32x4){p1|(p2<<16),p3|0x3f800000u,0x00003f80u,0u}; } } }
  if(MODE==2){ const int npc=((q0+QB)/KVBLK)*128; for(int i=tid;i<npc;i+=NW*64){ const int tile=i>>7,pc=i&127;
      const u32x4 v=*reinterpret_cast<const u32x4*>(maskb+(long)tile*2048+q0+2*pc); *(__attribute__((address_space(3))) u32x4*)(shm3+L_X+(tile*256+2*pc)*8)=v; } }
  const unsigned himask=hi?0u:~0u;
  bf16x8 qone=__builtin_bit_cast(bf16x8,(u32x4){0x3f803f80u,0x00003f80u,0u,0u});
  if(MODE==1){ const float x=cb[q0+wid*QBLK+r32]*1.4426950408889634f; const unsigned p1=cvtpk_s(x,0.f)&0xffffu; const float r1=x-__uint_as_float(p1<<16);
    const unsigned p2=cvtpk_s(r1,0.f)&0xffffu; const float r2=r1-__uint_as_float(p2<<16); const unsigned p3=cvtpk_s(r2,0.f)&0xffffu;
    qone=__builtin_bit_cast(bf16x8,(u32x4){0x3f803f80u,0x00003f80u|(p1<<16),p2|(p3<<16),0u}); }
  #define KBF(t,half) __builtin_bit_cast(bf16x8,(*(const __attribute__((address_space(3))) u32x4*)(shm3+L_X+((t)*64+(half)*32+r32)*16))&(u32x4){himask,himask,himask,himask})
  #define BIAS(P0,P1,t) do{ if(MODE==1){ P0=__builtin_amdgcn_mfma_f32_32x32x16_bf16(KBF(t,0),qone,P0,0,0,0); P1=__builtin_amdgcn_mfma_f32_32x32x16_bf16(KBF(t,1),qone,P1,0,0,0); } }while(0)
  unsigned mlo=0u,mhi=0u;
  #define MLOAD(t) do{ if(MODE==2){ const unsigned long long mw_=xq[(t)*256+wid*QBLK+r32]>>(4*hi); mlo=(unsigned)mw_; mhi=(unsigned)(mw_>>32); } }while(0)
  #define MBIT(r) (((r)&3)+8*((r)>>2))
  #define EXM(v,r,W) ((MODE==2)?__uint_as_float(__float_as_uint(__builtin_amdgcn_exp2f(v))&(unsigned)__builtin_amdgcn_sbfe((int)(W),MBIT(r),1)):__builtin_amdgcn_exp2f(v))
  if(!PRE){DMA_K(0,0);DMA_V(0,0);DMA_K(1,SLOTB);}
  bf16x8 qr[4];
  #pragma unroll
  for(int d0=0;d0<4;++d0)qr[d0]=*reinterpret_cast<const bf16x8*>(&Qw[(long)r32*qp+d0*16+hi*8]);
  float mhat=0.f,l_reg=0.f;f32x16 o[DV2?4:2];o[0]=f32x16{};o[1]=f32x16{};if(DV2){o[DV2?2:0]=f32x16{};o[DV2?3:1]=f32x16{};}f32x16 negm=f32x16{};asm volatile("":"+v"(negm));
  const int qrel=wid*QBLK+r32;
  #define CMASK(P0,P1,t) do{ if(MODE!=2){int jb_=(t)-(NT-4); if(jb_>=0)cmask(P0,P1,jb_,qrel,hi);} }while(0)
  bool resc=false;
  #define START(P0,P1) do{ const float rm=rowmax(P0,P1); resc=false; \
    { const float dl=rm; mhat=fadd_s(mhat,dl); \
      _Pragma("unroll") for(int r=0;r<16;++r){P0[r]=fsub_s(P0[r],dl);P1[r]=fsub_s(P1[r],dl);} \
      _Pragma("unroll") for(int r=0;r<16;++r)negm[r]=-mhat; asm volatile("":"+v"(negm)); } \
    _Pragma("unroll") for(int r=0;r<16;++r)P0[r]=EXM(P0[r],r,mlo); }while(0)
  #define RESC() do{ if(resc){ asm volatile("s_waitcnt lgkmcnt(0)":::"memory"); \
      _Pragma("unroll") for(int d_=0;d_<(DV2?4:2);++d_) _Pragma("unroll") for(int r=0;r<16;++r)o[d_][r]*=wsf[crow(r,hi)]; } }while(0)
  f32x16 pA0,pA1,pB0,pB1;
  int sl_prev=0,sl_cur=0,sl_next=SLOTB;
  #define ROT() do{sl_prev=sl_cur;sl_cur=sl_next;sl_next=(sl_next==(NSLOT-1)*SLOTB)?0:sl_next+SLOTB;}while(0)
  if(!PRE){DMA_K(2,2*SLOTB);}
  WB(3,4);
  qkt(pA0,pA1,Kbase,qr,negm,r32,hi);BIAS(pA0,pA1,0);asm volatile("s_nop 15\n\ts_nop 7":"+v"(pA0),"+v"(pA1));CMASK(pA0,pA1,0);MLOAD(0);
  START(pA0,pA1);
  _Pragma("unroll") for(int r=0;r<16;++r)pA1[r]=EXM(pA1[r],r,mhi);
  WAIT_BAR(0);
  DMA_K(3,0);DMA_V(1,SLOTB);
  ROT();
  kload8(kf,kp0+sl_cur);
  WB(2,3);
  s16x4 vlo[8],vhi[8]; u32x4 pw0,pw1,pw2,pw3;
  #define PKW(P,B) cvtpk_s(P[B],P[B+1])
  #define PAF(k) __builtin_bit_cast(bf16x8,pw##k)
  #define VFR(i) (bf16x8){vlo[i][0],vlo[i][1],vlo[i][2],vlo[i][3],vhi[i][0],vhi[i][1],vhi[i][2],vhi[i][3]}
  #define PIN(x) asm volatile("":"+v"(x))
  #define MX3(a,b,c) __builtin_fmaxf(__builtin_fmaxf((a),(b)),(c))
  #define GAPA(MF,A0,A1,A2,A3,W0,W1,PW) do{ MF; sacc+=A0; sacc+=A1; sacc+=A2; sacc+=A3; PIN(sacc); W0; W1; PIN(PW); SBAR(); }while(0)
  #define EX(v) __builtin_amdgcn_exp2f(v)
  #define GAPB(MF,X,B,W) do{ MF; X[B]=EXM(X[B],B,W); X[B+1]=EXM(X[B+1],B+1,W); X[B+2]=EXM(X[B+2],B+2,W); X[B+3]=EXM(X[B+3],B+3,W); PIN(X); SBAR(); }while(0)
  #define VRD(i) do{ vlo[i]=vtr(vp_+(((i)>>2)*4096+((i)&3)*1024)); vhi[i]=vtr(vp_+(((i)>>2)*4096+((i)&3)*1024+512)); }while(0)
  #define VRD2(i) do{ vlo[i]=vtr(vp_+(8192+((i)>>2)*4096+((i)&3)*1024)); vhi[i]=vtr(vp_+(8192+((i)>>2)*4096+((i)&3)*1024+512)); }while(0)
  #define KRD(G,j) do{ if(G){ kload2(kf,kp0+sl_next,j); SBAR(); } }while(0)
  #define STEP(C0,C1,P0,P1,t,GK,GV,GL) do{ SBAR(); \
    const lds_cptr vp_=vp0+VSL*sl_prev; \
    VRD(0); SBAR(); float sacc=(P0[0]+P0[1]); \
    GAPA(C0=__builtin_amdgcn_mfma_f32_32x32x16_bf16(kf[0],qr[0],negm,0,0,0), P0[2],P0[3],P0[4],P0[5],     pw0[0]=PKW(P0,0), pw0[1]=PKW(P0,2), pw0); \
    VRD(4); SBAR(); GAPA(C1=__builtin_amdgcn_mfma_f32_32x32x16_bf16(kf[1],qr[0],negm,0,0,0), P0[6],P0[7],P0[8],P0[9],     pw0[2]=PKW(P0,4), pw0[3]=PKW(P0,6), pw0); \
    VRD(1); SBAR(); GAPA(C0=__builtin_amdgcn_mfma_f32_32x32x16_bf16(kf[2],qr[1],C0,0,0,0),   P0[10],P0[11],P0[12],P0[13], pw1[0]=PKW(P0,8), pw1[1]=PKW(P0,10), pw1); \
    VRD(5); SBAR(); GAPA(C1=__builtin_amdgcn_mfma_f32_32x32x16_bf16(kf[3],qr[1],C1,0,0,0),   P0[14],P0[15],P1[0],P1[1],   pw1[2]=PKW(P0,12),pw1[3]=PKW(P0,14), pw1); \
    VRD(2); SBAR(); GAPA(C0=__builtin_amdgcn_mfma_f32_32x32x16_bf16(kf[4],qr[2],C0,0,0,0),   P1[2],P1[3],P1[4],P1[5],     pw2[0]=PKW(P1,0), pw2[1]=PKW(P1,2), pw2); \
    VRD(6); SBAR(); GAPA(C1=__builtin_amdgcn_mfma_f32_32x32x16_bf16(kf[5],qr[2],C1,0,0,0),   P1[6],P1[7],P1[8],P1[9],     pw2[2]=PKW(P1,4), pw2[3]=PKW(P1,6), pw2); \
    VRD(3); SBAR(); GAPA(C0=__builtin_amdgcn_mfma_f32_32x32x16_bf16(kf[6],qr[3],C0,0,0,0),   P1[10],P1[11],P1[12],P1[13], pw3[0]=PKW(P1,8), pw3[1]=PKW(P1,10), pw3); \
    VRD(7); SBAR(); GAPA(C1=__builtin_amdgcn_mfma_f32_32x32x16_bf16(kf[7],qr[3],C1,0,0,0),   P1[14],P1[15],0.f,0.f,       pw3[2]=PKW(P1,12),pw3[3]=PKW(P1,14), pw3); \
    l_reg+=sacc; BIAS(C0,C1,t); MLOAD(t); \
    if(GK){DMA_K((t)+3,sl_cur);} if(GV){DMA_V((t)+1,sl_next);} \
    CMASK(C0,C1,t); \
    { float a=MX3(C0[0],C0[1],C1[0]),b=MX3(C0[2],C0[3],C1[1]); a=MX3(a,C1[2],C1[3]); \
      _Pragma("unroll") for(int r=4;r<16;r+=4){a=MX3(a,C0[r],C0[r+1]);b=MX3(b,C0[r+2],C0[r+3]);a=MX3(a,C1[r],C1[r+1]);b=MX3(b,C1[r+2],C1[r+3]);} \
      float rm=__builtin_fmaxf(a,b); { auto rr=__builtin_amdgcn_permlane32_swap(__float_as_uint(rm),__float_as_uint(rm),false,false); rm=__builtin_fmaxf(__uint_as_float(rr[0]),__uint_as_float(rr[1])); } \
      resc=false; \
      if(__builtin_expect(__any(rm>(float)THRL),0)){ const float dl=__builtin_fmaxf(rm,0.f); mhat+=dl; \
        _Pragma("unroll") for(int r=0;r<16;++r){C0[r]-=dl;C1[r]-=dl;} \
        _Pragma("unroll") for(int r=0;r<16;++r)negm[r]=-mhat; asm volatile("":"+v"(negm)); \
        const float f=__builtin_amdgcn_exp2f(-dl); l_reg*=f; if(hi==0)wsf[r32]=f; resc=true; } } \
    SBAR(); \
    GAPB(o[0]=__builtin_amdgcn_mfma_f32_32x32x16_bf16(PAF(0),VFR(0),o[0],0,0,0), C0,0,mlo); \
    GAPB(o[1]=__builtin_amdgcn_mfma_f32_32x32x16_bf16(PAF(0),VFR(4),o[1],0,0,0), C0,4,mlo); \
    KRD(GL,0); GAPB(o[0]=__builtin_amdgcn_mfma_f32_32x32x16_bf16(PAF(1),VFR(1),o[0],0,0,0), C0,8,mlo); \
    KRD(GL,1); GAPB(o[1]=__builtin_amdgcn_mfma_f32_32x32x16_bf16(PAF(1),VFR(5),o[1],0,0,0), C0,12,mlo); \
    KRD(GL,2); GAPB(o[0]=__builtin_amdgcn_mfma_f32_32x32x16_bf16(PAF(2),VFR(2),o[0],0,0,0), C1,0,mhi); \
    KRD(GL,3); GAPB(o[1]=__builtin_amdgcn_mfma_f32_32x32x16_bf16(PAF(2),VFR(6),o[1],0,0,0), C1,4,mhi); \
    GAPB(o[0]=__builtin_amdgcn_mfma_f32_32x32x16_bf16(PAF(3),VFR(3),o[0],0,0,0), C1,8,mhi); \
    GAPB(o[1]=__builtin_amdgcn_mfma_f32_32x32x16_bf16(PAF(3),VFR(7),o[1],0,0,0), C1,12,mhi); \
    if(DV2){ VRD2(0);VRD2(4);VRD2(1);VRD2(5);VRD2(2);VRD2(6);VRD2(3);VRD2(7); SBAR(); \
      o[DV2?2:0]=__builtin_amdgcn_mfma_f32_32x32x16_bf16(PAF(0),VFR(0),o[DV2?2:0],0,0,0); o[DV2?3:1]=__builtin_amdgcn_mfma_f32_32x32x16_bf16(PAF(0),VFR(4),o[DV2?3:1],0,0,0); \
      o[DV2?2:0]=__builtin_amdgcn_mfma_f32_32x32x16_bf16(PAF(1),VFR(1),o[DV2?2:0],0,0,0); o[DV2?3:1]=__builtin_amdgcn_mfma_f32_32x32x16_bf16(PAF(1),VFR(5),o[DV2?3:1],0,0,0); \
      o[DV2?2:0]=__builtin_amdgcn_mfma_f32_32x32x16_bf16(PAF(2),VFR(2),o[DV2?2:0],0,0,0); o[DV2?3:1]=__builtin_amdgcn_mfma_f32_32x32x16_bf16(PAF(2),VFR(6),o[DV2?3:1],0,0,0); \
      o[DV2?2:0]=__builtin_amdgcn_mfma_f32_32x32x16_bf16(PAF(3),VFR(3),o[DV2?2:0],0,0,0); o[DV2?3:1]=__builtin_amdgcn_mfma_f32_32x32x16_bf16(PAF(3),VFR(7),o[DV2?3:1],0,0,0); SBAR(); } \
    }while(0)
  int t=1;
  #undef CMASK
  #define CMASK(P0,P1,t) do{}while(0)
  for(;t+5<NT;t+=2){
    STEP(pB0,pB1,pA0,pA1,t,true,true,true);     WB(2,3); RESC(); ROT();
    STEP(pA0,pA1,pB0,pB1,t+1,true,true,true);   WB(2,3); RESC(); ROT();
  }
  #undef CMASK
  #define CMASK(P0,P1,t) do{ if(MODE!=2){int jb_=(t)-(NT-4); if(jb_>=0)cmask(P0,P1,jb_,qrel,hi);} }while(0)
  #define ENDW(tt) do{ if((tt)+3<NT){WB(2,3);} else if((tt)+2<NT){WB(1,2);} else {WAIT_BAR(0);} }while(0)
  for(;t+1<NT;t+=2){
    STEP(pB0,pB1,pA0,pA1,t,(t+3<NT),(t+1<NT),(t+1<NT));       ENDW(t);   RESC(); ROT();
    STEP(pA0,pA1,pB0,pB1,t+1,(t+4<NT),(t+2<NT),(t+2<NT));     ENDW(t+1); RESC(); ROT();
  }
  STEP(pB0,pB1,pA0,pA1,NT-1,false,false,false); RESC();
  { float sacc=pB0[0]+pB0[1]; _Pragma("unroll") for(int r=2;r<16;++r)sacc+=pB0[r]; _Pragma("unroll") for(int r=0;r<16;++r)sacc+=pB1[r]; l_reg+=sacc;
    pw0=(u32x4){PKW(pB0,0),PKW(pB0,2),PKW(pB0,4),PKW(pB0,6)};pw1=(u32x4){PKW(pB0,8),PKW(pB0,10),PKW(pB0,12),PKW(pB0,14)};pw2=(u32x4){PKW(pB1,0),PKW(pB1,2),PKW(pB1,4),PKW(pB1,6)};pw3=(u32x4){PKW(pB1,8),PKW(pB1,10),PKW(pB1,12),PKW(pB1,14)};
    SBAR(); pv(o,vb0+VSL*sl_cur,PAF(0),PAF(1),PAF(2),PAF(3)); if(DV2){ SBAR(); pv(o+(DV2?2:0),vb0+VSL*sl_cur+SLOTB,PAF(0),PAF(1),PAF(2),PAF(3)); } }
  #undef PKW
  #undef PAF
  #undef VFR
  #undef PIN
  #undef MX3
  #undef GAPA
  #undef GAPB
  #undef EX
  #undef VRD
  #undef KRD
  #undef STEP
  #undef ENDW
  if(PFN){ asm volatile("s_waitcnt lgkmcnt(0)\n\ts_barrier":::"memory");
    const bf16*nks=Kn+(long)lane*kvp+wid*8; const bf16*nvs=Vn+(long)(16*(wid&3)+(lane>>2))*kvp+(wid>>2)*32+(lane&3)*8;
    glds16(nks,(unsigned)__builtin_amdgcn_readfirstlane(kdst)); glds16(nvs,(unsigned)__builtin_amdgcn_readfirstlane(vdst)); if(DV2){glds16(nvs+64,(unsigned)__builtin_amdgcn_readfirstlane(vdst+SLOTB));} glds16(nks+(long)KVBLK*kvp,(unsigned)__builtin_amdgcn_readfirstlane(kdst+SLOTB)); glds16(nks+(long)2*KVBLK*kvp,(unsigned)__builtin_amdgcn_readfirstlane(kdst+2*SLOTB)); }
  {auto rr=__builtin_amdgcn_permlane32_swap(__float_as_uint(l_reg),__float_as_uint(l_reg),false,false);l_reg=__uint_as_float(rr[0])+__uint_as_float(rr[1]);}
  if(hi==0)wsf[32+r32]=l_reg;asm volatile("s_waitcnt lgkmcnt(0)":::"memory");
  float rli[16];
  #pragma unroll
  for(int r=0;r<16;++r)rli[r]=__builtin_amdgcn_rcpf(wsf[32+crow(r,hi)]);
  bf16*Ow=Ob+(long)(q0+wid*QBLK)*op;
  { constexpr int OW=DV2?128:64; bf16*stg=(bf16*)(shm+L_OST)+wid*2048*VSL;
    #pragma unroll
    for(int r=0;r<16;++r){const int orow=crow(r,hi);
      #pragma unroll
      for(int d0=0;d0<(DV2?4:2);++d0)stg[orow*OW+d0*32+r32]=__float2bfloat16(o[d0][r]*rli[r]);}
    asm volatile("s_waitcnt lgkmcnt(0)":::"memory");
    #pragma unroll
    for(int i=0;i<4*VSL;++i){const int row=DV2?i*4+(lane>>4):i*8+(lane>>3),ch=DV2?(lane&15):(lane&7); const u32x4 v=*(const u32x4*)(stg+row*OW+ch*8); ATTN_STORE16(Ow+(long)row*op+ch*8,v);} }
  if(!PFN){ asm volatile("s_waitcnt lgkmcnt(0)\n\ts_barrier":::"memory"); }
  #undef KBF
  #undef BIAS
  #undef MLOAD
  #undef MBIT
  #undef EXM
  #undef DMA_K
  #undef DMA_V
  #undef WB
  #undef VRD2
  #undef CMASK
  #undef START
  #undef RESC
  #undef ROT
}
#undef SBAR
#undef WAIT_BAR
}

#define XB_TMO      128
#define XB_XCNT(j)  (256  + 64 * (j))
#define XB_XSUB(j)  (1280 + 64 * (j))
#define XB_XGEN(j)  (2304 + 64 * (j))
#define XB_TOP      3328
#define XB_TOPGEN   3392
#define XCD_BAR_WORDS 3456
#define XB_SPIN_CAP (1u << 18)
__device__ __forceinline__ unsigned xb_ld(unsigned* p)              { return __hip_atomic_load(p, __ATOMIC_RELAXED, __HIP_MEMORY_SCOPE_AGENT); }
__device__ __forceinline__ unsigned xb_add(unsigned* p, unsigned v) { return __hip_atomic_fetch_add(p, v, __ATOMIC_RELAXED, __HIP_MEMORY_SCOPE_AGENT); }
__device__ __forceinline__ unsigned xb_xcc_id() { return (unsigned)__builtin_amdgcn_s_getreg((3 << 11) | 20) & 0xFu; }
#define XB_SPIN(cond, bar) do { unsigned _sp = 0; while (cond) { __builtin_amdgcn_s_sleep(1); \
    if ((++_sp & 255u) == 0u) { if (xb_ld(&(bar)[XB_TMO])) break; if (_sp > XB_SPIN_CAP) { atomicAdd(&(bar)[XB_TMO], 1u); break; } } } } while (0)
struct XcdBarrier { unsigned* bar; unsigned x; volatile LAS unsigned* st; };
__device__ __forceinline__ XcdBarrier xcd_barrier_post(unsigned* bar, volatile LAS unsigned* st) {
    XcdBarrier b; b.bar = bar; b.x = xb_xcc_id(); b.st = st;
    if (threadIdx.x == 0) (void)xb_add(&bar[XB_XCNT(b.x)], 1u);
    return b;
}
__device__ __forceinline__ void xcd_barrier_complete(unsigned* bar, unsigned x, unsigned& nloc, unsigned& nx) {
    const unsigned G = gridDim.x * gridDim.y * gridDim.z;
    unsigned sum, cnt, mine, sp = 0u;
    for (;;) {
        sum = 0u; cnt = 0u; mine = 0u;
#pragma unroll
        for (unsigned j = 0; j < 16; ++j) { const unsigned c = xb_ld(&bar[XB_XCNT(j)]); sum += c; cnt += (c > 0u) ? 1u : 0u; mine = (j == x) ? c : mine; }
        if (sum == G) break;
        __builtin_amdgcn_s_sleep(1);
        if ((++sp & 255u) == 0u) { if (xb_ld(&bar[XB_TMO])) break; if (sp > XB_SPIN_CAP) { atomicAdd(&bar[XB_TMO], 1u); break; } }
    }
    nloc = mine > 0u ? mine : 1u; nx = cnt > 0u ? cnt : 1u;
}
__device__ __forceinline__ void xcd_barrier(const XcdBarrier& b) {
    asm volatile("s_waitcnt vmcnt(0)" ::: "memory");
    __syncthreads();
    if (threadIdx.x == 0) {
        unsigned* bar = b.bar;
        __builtin_amdgcn_s_waitcnt(0);
        unsigned nloc = b.st[0], nx = b.st[1];
        if (nloc == 0u) { xcd_barrier_complete(bar, b.x, nloc, nx); b.st[0] = nloc; b.st[1] = nx; }
        const unsigned old = xb_add(&bar[XB_XSUB(b.x)], 1u);
        const unsigned gen = old / nloc;
        if (old + 1u == (gen + 1u) * nloc) {
            __builtin_amdgcn_fence(__ATOMIC_RELEASE, "agent");
            asm volatile("s_waitcnt vmcnt(0)" ::: "memory");
            const unsigned og = xb_add(&bar[XB_TOP], 1u);
            const unsigned tg = og / nx;
            if (og + 1u == (tg + 1u) * nx) xb_add(&bar[XB_TOPGEN], 1u);
            else XB_SPIN(xb_ld(&bar[XB_TOPGEN]) == tg, bar);
            __builtin_amdgcn_fence(__ATOMIC_ACQUIRE, "agent");
            xb_add(&bar[XB_XGEN(b.x)], 1u);
            asm volatile("s_waitcnt vmcnt(0)" ::: "memory");
        } else {
            XB_SPIN(xb_ld(&bar[XB_XGEN(b.x)]) == gen, bar);
            __builtin_amdgcn_fence(__ATOMIC_ACQUIRE, "agent");
            asm volatile("s_waitcnt vmcnt(0)" ::: "memory");
        }
    }
    __syncthreads();
}

struct Frame {
    LAS unsigned char* lds;
    unsigned* ctl;
    int tid, lane, wave, vcu, G;
    const float* const* inp; float* out; unsigned char* ws;
};
enum { I_X = 0, I_LN_MIX_E, I_W_IN_E, I_B_FOX, I_W_OUT_E, I_LN_FFN_E, I_W_GATE, I_W_UP, I_W_DOWN, I_LN_MIX_O, I_W_IN_O, I_LB, I_HGRN_G, I_LAM, I_DIFF_G, I_W_OUT_O, I_LN_FFN_O, I_W_ROUTER, I_WE_GATE, I_WE_UP, I_WE_DOWN, I_LN_FINAL };

__device__ __forceinline__ int dim_of_pos(int p) { return (p >> 1) + 32 * (p & 1); }
__device__ __forceinline__ int srccol_in0(int j) {
    if (j < 512) return j;
    if (j < 1024) { const int o = j - 512; return 1544 + (o & ~63) + dim_of_pos(o & 63); }
    if (j < 1536) return 512 + (j - 1024);
    if (j < 2048) return 1024 + (j - 1536);
    if (j < 2176) { const int o = j - 2048; return 2056 + (o & ~63) + dim_of_pos(o & 63); }
    if (j < 2304) return 2184 + (j - 2176);
    if (j < 2560) { const int o = j - 2304; return 2312 + (o & ~63) + dim_of_pos(o & 63); }
    if (j < 2624) { const int o = j - 2560; return 2568 + dim_of_pos(o); }
    if (j < 2632) return 1536 + (j - 2624);
    if (j < 2636) return 2632 + (j - 2632);
    return -1;
}
__device__ __forceinline__ int srccol_in1(int j) {
    if (j < 512) return j;
    if (j < 1024) { const int o = j - 512; return 2048 + (o & ~63) + dim_of_pos(o & 63); }
    if (j < 1536) return 512 + (j - 1024);
    if (j < 2048) return 1024 + (j - 1536);
    if (j < 2560) return 1536 + (j - 2048);
    if (j < 3072) { const int o = j - 2560; return 2560 + (o & ~63) + dim_of_pos(o & 63); }
    return 3072 + (j - 3072);
}
__device__ __forceinline__ void p0_item(const float* W, int Nsrc, int sc, const float* gain, bf16_t* WT, int K, int n0, int k0, LAS float* scr, int lane) {
    const float gk = gain ? gain[k0 + lane] : 1.0f;
    const float* src = W + (size_t)k0 * Nsrc + (sc >= 0 ? sc : 0);
#pragma unroll 16
    for (int kk = 0; kk < 64; ++kk) { const float gkk = __shfl(gk, kk); float v = src[(size_t)kk * Nsrc] * gkk; v = (sc >= 0) ? v : 0.f; scr[kk * 65 + lane] = v; }
    LDS_WAIT(); asm volatile("" ::: "memory");
    const int c = lane & 7;
#pragma unroll
    for (int j = 0; j < 8; ++j) { const int n = (lane >> 3) + 8 * j; const LAS float* s = scr + (8 * c) * 65 + n;
        u32x4 o; o.x = cvt_pk_bf16(s[0 * 65], s[1 * 65]); o.y = cvt_pk_bf16(s[2 * 65], s[3 * 65]); o.z = cvt_pk_bf16(s[4 * 65], s[5 * 65]); o.w = cvt_pk_bf16(s[6 * 65], s[7 * 65]);
        *(u32x4*)(WT + (size_t)(n0 + n) * K + k0 + 8 * c) = o; }
    LDS_WAIT(); asm volatile("" ::: "memory");
}
__device__ __forceinline__ void p0_item8(const float* W, int Nsrc, int sc, const float* gain, unsigned char* WT, int K, int n0, int k0, LAS float* scr, int lane) {
    const float gk = (gain ? gain[k0 + lane] : 1.0f) * SW8;
    const float* src = W + (size_t)k0 * Nsrc + sc;
#pragma unroll 16
    for (int kk = 0; kk < 64; ++kk) { const float gkk = __shfl(gk, kk); scr[kk * 65 + lane] = src[(size_t)kk * Nsrc] * gkk; }
    LDS_WAIT(); asm volatile("" ::: "memory");
    const int c = lane & 7;
#pragma unroll
    for (int j = 0; j < 8; ++j) { const int n = (lane >> 3) + 8 * j; const LAS float* s = scr + (8 * c) * 65 + n;
        int p0 = __builtin_amdgcn_cvt_pk_fp8_f32(s[0 * 65], s[1 * 65], 0, false); p0 = __builtin_amdgcn_cvt_pk_fp8_f32(s[2 * 65], s[3 * 65], p0, true);
        int p1 = __builtin_amdgcn_cvt_pk_fp8_f32(s[4 * 65], s[5 * 65], 0, false); p1 = __builtin_amdgcn_cvt_pk_fp8_f32(s[6 * 65], s[7 * 65], p1, true);
        *(u32x2*)(WT + (size_t)(n0 + n) * K + k0 + 8 * c) = (u32x2){(unsigned)p0, (unsigned)p1}; }
    LDS_WAIT(); asm volatile("" ::: "memory");
}
__device__ __forceinline__ void p0_prologue(Frame& F) {
    LAS float* scr = (LAS float*)(F.lds + F.wave * 16640);
    const int gw = F.vcu * NWAVES + F.wave, NGW = F.G * NWAVES, lane = F.lane;
    unsigned char* ws = F.ws;
    constexpr int I0 = 16 * 44, I1 = 16 * 16, I2 = 16 * 88, I3 = 44 * 16, I4 = 16 * 56, I5 = 16 * 16, I6 = 8 * 16 * 112, I7 = 8 * 56 * 16;
    constexpr int NITEMS = I0 + I1 + I2 + I3 + I4 + I5 + I6 + I7;
    for (int it = gw; it < NITEMS; it += NGW) {
        int r = it;
        if (r < I0) { const int kb = r / 44, nb = r % 44; const int j = nb * 64 + lane; p0_item(F.inp[I_W_IN_E], N0SRC, srccol_in0(j), F.inp[I_LN_MIX_E], (bf16_t*)(ws + WS_WIN0), DM, nb * 64, kb * 64, scr, lane); continue; } r -= I0;
        if (r < I1) { const int kb = r / 16, nb = r % 16; p0_item(F.inp[I_W_OUT_E], DM, nb * 64 + lane, nullptr, (bf16_t*)(ws + WS_WOUT0), DM, nb * 64, kb * 64, scr, lane); continue; } r -= I1;
        if (r < I2) { const int kb = r / 88, nb = r % 88; const int j = nb * 64, pn = j >> 8, rr = j & 255; const float* W = (rr < 128) ? F.inp[I_W_GATE] : F.inp[I_W_UP];
            if (FFN_GU8) p0_item8(W, FF, pn * 128 + (rr & 127) + lane, F.inp[I_LN_FFN_E], (unsigned char*)(ws + WS_WGU0), DM, j, kb * 64, scr, lane); else
            p0_item(W, FF, pn * 128 + (rr & 127) + lane, F.inp[I_LN_FFN_E], (bf16_t*)(ws + WS_WGU0), DM, j, kb * 64, scr, lane); continue; } r -= I2;
        if (r < I3) { const int kb = r / 16, nb = r % 16; if (FFN_DN8) p0_item8(F.inp[I_W_DOWN], DM, nb * 64 + lane, nullptr, (unsigned char*)(ws + WS_WDN0), FF, nb * 64, kb * 64, scr, lane); else p0_item(F.inp[I_W_DOWN], DM, nb * 64 + lane, nullptr, (bf16_t*)(ws + WS_WDN0), FF, nb * 64, kb * 64, scr, lane); continue; } r -= I3;
        if (r < I4) { const int kb = r / 56, nb = r % 56; const int j = nb * 64 + lane; p0_item(F.inp[I_W_IN_O], N1, srccol_in1(j), F.inp[I_LN_MIX_O], (bf16_t*)(ws + WS_WIN1), DM, nb * 64, kb * 64, scr, lane); continue; } r -= I4;
        if (r < I5) { const int kb = r / 16, nb = r % 16; p0_item(F.inp[I_W_OUT_O], DM, nb * 64 + lane, nullptr, (bf16_t*)(ws + WS_WOUT1), DM, nb * 64, kb * 64, scr, lane); continue; } r -= I5;
        if (r < I6) { const int e = r / (16 * 112), q = r % (16 * 112), kb = q / 112, nb = q % 112; const int j = nb * 64, pn = j >> 8, rr = j & 255;
            const float* W = ((rr < 128) ? F.inp[I_WE_GATE] : F.inp[I_WE_UP]) + (size_t)e * DM * FFE;
            p0_item8(W, FFE, pn * 128 + (rr & 127) + lane, F.inp[I_LN_FFN_O], (unsigned char*)(ws + WS_WEGU) + (size_t)e * 7168 * DM, DM, j, kb * 64, scr, lane); continue; } r -= I6;
        { const int e = r / (56 * 16), q = r % (56 * 16), kb = q / 16, nb = q % 16;
            p0_item8(F.inp[I_WE_DOWN] + (size_t)e * FFE * DM, DM, nb * 64 + lane, nullptr, (unsigned char*)(ws + WS_WEDN) + (size_t)e * DM * FFE, FFE, nb * 64, kb * 64, scr, lane); }
    }
    { bf16_t* XB = (bf16_t*)(ws + WS_XB); float* SS = (float*)(ws + WS_SS);
      for (int m = gw; m < MTOK; m += NGW) {
        const f32x4* xr = (const f32x4*)(F.inp[I_X] + (size_t)m * DM) + lane; float s = 0.f; f32x4 v[4];
#pragma unroll
        for (int j = 0; j < 4; ++j) { v[j] = xr[64 * j]; s += (v[j][0] * v[j][0] + v[j][1] * v[j][1]) + (v[j][2] * v[j][2] + v[j][3] * v[j][3]); }
        s = wave_sum(s);
        u32x2* o = (u32x2*)(XB + (size_t)m * DM) + lane;
#pragma unroll
        for (int j = 0; j < 4; ++j) { u32x2 w; w.x = cvt_pk_bf16(v[j][0], v[j][1]); w.y = cvt_pk_bf16(v[j][2], v[j][3]); o[64 * j] = w; }
        if (lane < 16) SS[(size_t)m * 16 + lane] = (lane == 0) ? s : 0.f;
      } }
    { float* rope = (float*)(ws + WS_ROPE); const int gt = gw * 64 + lane, NT = NGW * 64;
      for (int i = gt; i < SEQ * 32; i += NT) { const int t = i >> 5, p = i & 31; const float inv = powf(10000.0f, -(float)p * 2.0f / 64.0f); const float ang = (float)t * inv;
          rope[2 * i] = cosf(ang); rope[2 * i + 1] = sinf(ang); }
      float* wrt = (float*)(ws + WS_WRT);
      for (int i = gt; i < 8 * DM; i += NT) { const int e = i >> 10, k = i & 1023; wrt[i] = F.inp[I_W_ROUTER][k * 8 + e] * F.inp[I_LN_FFN_O][k]; } }
}

__device__ __forceinline__ void fox_cumsum_unit(Frame& F, int bh) {
    const float* LOGF = (const float*)(F.ws + WS_LOGF); float* CB = (float*)(F.ws + WS_CB);
    LAS float* wt = (LAS float*)(F.lds);
    const int b = bh >> 3, h = bh & 7, tid = F.tid;
    float v[4]; float run = 0.f;
#pragma unroll
    for (int j = 0; j < 4; ++j) { v[j] = LOGF[((size_t)b * SEQ + 4 * tid + j) * 8 + h]; run += v[j]; v[j] = run; }
    float incl = run;
#pragma unroll
    for (int o = 1; o < 64; o <<= 1) { const float t = __shfl_up(incl, o); if (F.lane >= o) incl += t; }
    if (F.lane == 63) wt[F.wave] = incl;
    __syncthreads();
    float woff = 0.f;
    for (int w = 0; w < F.wave; ++w) woff += wt[w];
    const float base = woff + incl - run;
    f32x4 o = (f32x4){base + v[0], base + v[1], base + v[2], base + v[3]};
    *(f32x4*)(CB + (size_t)bh * SEQ + 4 * tid) = o;
    __syncthreads();
    { const bf16_t* QKV = (const bf16_t*)(F.ws + WS_BIG); float qm = 0.f, km = 0.f;
#pragma unroll 1
      for (int j = 0; j < 4; ++j) { const bf16_t* rp = QKV + ((size_t)b * SEQ + 4 * tid + j) * N0; float qs = 0.f, ks = 0.f;
#pragma unroll
          for (int cch = 0; cch < 8; ++cch) { const u32x4 wq = *(const u32x4*)(rp + C0_FQ + h * 64 + 8 * cch), wk = *(const u32x4*)(rp + C0_FK + h * 64 + 8 * cch);
              const unsigned qa[4] = {wq.x, wq.y, wq.z, wq.w}, ka[4] = {wk.x, wk.y, wk.z, wk.w};
#pragma unroll
              for (int e = 0; e < 4; ++e) { qs += bf_lo(qa[e]) * bf_lo(qa[e]) + bf_hi(qa[e]) * bf_hi(qa[e]); ks += bf_lo(ka[e]) * bf_lo(ka[e]) + bf_hi(ka[e]) * bf_hi(ka[e]); } }
          qm = fmaxf(qm, qs); km = fmaxf(km, ks); }
      qm = wave_max(qm); km = wave_max(km);
      if (F.lane == 0) { wt[16 + F.wave] = qm; wt[32 + F.wave] = km; }
      __syncthreads();
      if (tid == 0) { float a = 0.f, bb = 0.f; for (int w = 0; w < 8; ++w) { a = fmaxf(a, wt[16 + w]); bb = fmaxf(bb, wt[32 + w]); }
          ((float*)(F.ws + WS_FQK))[bh] = 2.0f * sqrtf(a) * sqrtf(bb) * 1.001f; }
      __syncthreads(); }
}
constexpr int SCP = 2052;
template <int NT>
__device__ __forceinline__ void select_row(const LAS float* Srow, int t, int nkeys, int lane, u64* mout) {
    int mlo = 0, mhi = 0;
    if (t + 1 <= 256) {
        const int r = t - lane * 64; const u64 w = (r >= 63) ? ~0ull : (r < 0 ? 0ull : ((2ull << r) - 1ull));
        mlo = (int)(unsigned)w; mhi = (int)(unsigned)(w >> 32);
    } else {
        float sc[NT];
#pragma unroll
        for (int i = 0; i < NT; ++i) { const int s_ = i * 64 + lane; sc[i] = Srow[s_ < nkeys ? s_ : nkeys - 1]; }
#pragma unroll
        for (int i = 0; i < NT; ++i) asm volatile("" : "+v"(sc[i]));
#pragma unroll
        for (int i = 0; i < NT; ++i) sc[i] = (i * 64 + lane <= t) ? sc[i] + 0.0f : -INFINITY;
#define CNT_OP(OPC, TH, OUT) do { int c_ = 0; const float th_ = (TH); _Pragma("unroll") for (int i_ = 0; i_ < NT; i_ += 4) { u64 t0_, t1_, t2_, t3_; \
            asm volatile("v_cmp_" OPC "_f32 %1, %5, %9\n\tv_cmp_" OPC "_f32 %2, %6, %9\n\tv_cmp_" OPC "_f32 %3, %7, %9\n\tv_cmp_" OPC "_f32 %4, %8, %9\n\t" \
                         "v_addc_co_u32 %0, vcc, 0, %0, %1\n\tv_addc_co_u32 %0, vcc, 0, %0, %2\n\tv_addc_co_u32 %0, vcc, 0, %0, %3\n\tv_addc_co_u32 %0, vcc, 0, %0, %4" \
                         : "+v"(c_), "=&s"(t0_), "=&s"(t1_), "=&s"(t2_), "=&s"(t3_) : "v"(sc[i_]), "v"(sc[i_ + 1]), "v"(sc[i_ + 2]), "v"(sc[i_ + 3]), "v"(th_) : "vcc"); } \
            c_ += __builtin_amdgcn_update_dpp(0, c_, 0xB1, 0xF, 0xF, true); c_ += __builtin_amdgcn_update_dpp(0, c_, 0x4E, 0xF, 0xF, true); \
            c_ += __builtin_amdgcn_update_dpp(0, c_, 0x141, 0xF, 0xF, true); c_ += __builtin_amdgcn_update_dpp(0, c_, 0x140, 0xF, 0xF, true); \
            OUT = (__builtin_amdgcn_readlane(c_, 0) + __builtin_amdgcn_readlane(c_, 16)) + (__builtin_amdgcn_readlane(c_, 32) + __builtin_amdgcn_readlane(c_, 48)); } while (0)
        float theta = 0.f; int need = 0; bool exact = false;
        int np, nz; CNT_OP("gt", 0.0f, np); CNT_OP("ge", 0.0f, nz);
        if (np < 256 && nz >= 256) { theta = 0.f; need = 256 - np; }
        else {
            float lo, hi; int clo, chi2; bool hi_moved;
            if (np >= 256) { lo = 0.f; clo = nz; float mx = -INFINITY;
#pragma unroll
                for (int i = 0; i < NT; ++i) mx = fmaxf(mx, sc[i]);
                hi = wave_max(mx); chi2 = 1; hi_moved = false; }
            else { hi = 0.f; chi2 = nz; hi_moved = true; clo = t + 1; float mn = INFINITY;
#pragma unroll
                for (int i = 0; i < NT; ++i) mn = fminf(mn, (sc[i] == -INFINITY) ? INFINITY : sc[i]);
                lo = -wave_max(-mn); }
#pragma unroll 1
            for (int it = 0; it < 300; ++it) {
                float mid = 0.5f * (lo + hi);
                if (!(it & 1)) { const float lc = __log2f((float)clo);
                    const float fr = fminf(fmaxf((lc - 8.0028f) * __builtin_amdgcn_rcpf(lc - __log2f(fmaxf((float)chi2, 0.5f))), 0.03f), 0.97f);
                    const float mi = lo + (hi - lo) * fr; if (mi > lo && mi < hi) mid = mi; }
                if (!(mid > lo && mid < hi)) break;
                int cm; CNT_OP("ge", mid, cm);
                if (cm == 256) { theta = mid; exact = true; break; }
                if (cm > 256) { lo = mid; clo = cm; } else { hi = mid; chi2 = cm; hi_moved = true; } }
            if (!exact) {
                theta = lo; int ngt = chi2;
                if (!hi_moved) { CNT_OP("ge", hi, ngt); if (ngt >= 256) { theta = hi; CNT_OP("gt", hi, ngt); } }
                need = 256 - ngt; }
        }
#undef CNT_OP
        if (exact) {
#pragma unroll
            for (int i = 0; i < NT; ++i) { const u64 w = __ballot(sc[i] >= theta);
                mlo = (lane == i) ? (int)(unsigned)w : mlo; mhi = (lane == i) ? (int)(unsigned)(w >> 32) : mhi; }
        } else {
            int running = 0;
#pragma unroll
            for (int i = 0; i < NT; ++i) { const u64 eq = __ballot(sc[i] == theta), gt = __ballot(sc[i] > theta);
                const int rank = (int)__builtin_amdgcn_mbcnt_hi((unsigned)(eq >> 32), __builtin_amdgcn_mbcnt_lo((unsigned)eq, (unsigned)running));
                const u64 lt = __ballot(rank < need); const u64 w = gt | (eq & lt); running += __popcll(eq);
                mlo = (lane == i) ? (int)(unsigned)w : mlo; mhi = (lane == i) ? (int)(unsigned)(w >> 32) : mhi; }
        }
    }
    if (lane < 32) mout[(size_t)lane * SEQ] = ((u64)(unsigned)mhi << 32) | (u64)(unsigned)mlo;
}
constexpr int IDX_STG = 16 * SCP * 4;
constexpr int IDX_QP = 528, IDX_KP = 144;
static_assert(IDX_STG + NWAVES * 16 * IDX_KP <= RING_BYTES && 16 * IDX_QP <= NWAVES * 16 * IDX_KP, "indexer staging");
struct IdxPre { bf16x8 qraw; f32x4 w4; bf16x8 kr[8][2]; };
__device__ __forceinline__ void idx_decode(int L, int& b, int& qt) { b = L & 15; const int j = L >> 4; qt = (j & 1) ? 127 - (j >> 1) : (j >> 1); }
__device__ __forceinline__ void idx_load_k(const Frame& F, int b, int nkb, int kb0, bf16x8 (&kr)[8][2]) {
    const bf16_t* QKV = (const bf16_t*)(F.ws + WS_BIG); const int l = F.lane;
#pragma unroll
    for (int u = 0; u < 8; ++u) { const int kb = kb0 + u * NWAVES; const size_t row0 = (size_t)b * SEQ + (kb < nkb ? kb : nkb - 1) * 16 + (l >> 3);
#pragma unroll
        for (int hf = 0; hf < 2; ++hf) kr[u][hf] = *(const bf16x8*)(QKV + (row0 + hf * 8) * N0 + C0_IK + (l & 7) * 8); }
}
__device__ __forceinline__ void idx_load(const Frame& F, int b, int qt, IdxPre& P) {
    const bf16_t* QKV = (const bf16_t*)(F.ws + WS_BIG); const float* IW = (const float*)(F.ws + WS_IW);
    const int l = F.lane; const size_t row0 = (size_t)b * SEQ + qt * 16;
    P.qraw = *(const bf16x8*)(QKV + (row0 + 2 * F.wave + (l >> 5)) * N0 + C0_IQ + (l & 31) * 8);
    P.w4 = *(const f32x4*)(IW + (row0 + (l & 15)) * 4);
    idx_load_k(F, b, qt + 1, F.wave, P.kr);
}
__device__ __forceinline__ void idx_score(const bf16x8 (&qf)[4][2], const f32x4 w4, const bf16x8 (&kr)[8][2], int kb0, int nkb, LAS unsigned char* wst, LAS float* Sc, int lane) {
    const int fr = lane & 15, fq = lane >> 4;
#pragma unroll
    for (int u = 0; u < 8; ++u) { const int kb = kb0 + u * NWAVES;
        if (kb < nkb) {
            *(LAS bf16x8*)(wst + (lane >> 3) * IDX_KP + (lane & 7) * 16) = kr[u][0]; *(LAS bf16x8*)(wst + (8 + (lane >> 3)) * IDX_KP + (lane & 7) * 16) = kr[u][1];
            const bf16x8 k0 = *(const LAS bf16x8*)(wst + fr * IDX_KP + fq * 16), k1 = *(const LAS bf16x8*)(wst + fr * IDX_KP + 64 + fq * 16);
            f32x4 sc = (f32x4){0.f, 0.f, 0.f, 0.f};
#pragma unroll
            for (int h = 0; h < 4; ++h) { f32x4 a = (f32x4){0.f, 0.f, 0.f, 0.f};
                a = __builtin_amdgcn_mfma_f32_16x16x32_bf16(k0, qf[h][0], a, 0, 0, 0); a = __builtin_amdgcn_mfma_f32_16x16x32_bf16(k1, qf[h][1], a, 0, 0, 0);
#pragma unroll
                for (int j = 0; j < 4; ++j) sc[j] += w4[h] * fmaxf(a[j], 0.f); }
            *(LAS f32x4*)(Sc + fr * SCP + kb * 16 + 4 * fq) = sc; } }
}
__device__ __forceinline__ void idx_units(Frame& F, int c, int G) {
    u64* MASKT = (u64*)(F.ws + WS_MASK);
    LAS float* Sc = (LAS float*)F.lds; LAS unsigned char* stg = F.lds + IDX_STG; LAS unsigned char* wst = stg + F.wave * 16 * IDX_KP;
    const int lane = F.lane, fr = lane & 15, fq = lane >> 4;
    int L = c; if (L >= 2048) return;
    int b, qt; idx_decode(L, b, qt);
    IdxPre P; idx_load(F, b, qt, P);
#pragma unroll 1
    for (;;) {
        const int nkb = qt + 1, nkeys = nkb * 16, q0 = qt * 16;
        *(LAS bf16x8*)(stg + (2 * F.wave + (lane >> 5)) * IDX_QP + (lane & 31) * 16) = P.qraw;
        __syncthreads();
        bf16x8 qf[4][2];
#pragma unroll
        for (int h = 0; h < 4; ++h)
#pragma unroll
            for (int ks = 0; ks < 2; ++ks) qf[h][ks] = *(const LAS bf16x8*)(stg + fr * IDX_QP + h * 128 + ks * 64 + fq * 16);
        __syncthreads();
        idx_score(qf, P.w4, P.kr, F.wave, nkb, wst, Sc, lane);
        if (nkb > 8 * NWAVES) { bf16x8 kr[8][2]; idx_load_k(F, b, nkb, F.wave + 8 * NWAVES, kr);
            idx_score(qf, P.w4, kr, F.wave + 8 * NWAVES, nkb, wst, Sc, lane); }
        __syncthreads();
        const int Ln = L + G; const bool more = Ln < 2048; int bn = b, qn = qt;
        if (more) { idx_decode(Ln, bn, qn); idx_load(F, bn, qn, P); }
        const int nt8 = (nkeys + 511) >> 9;
#pragma unroll 1
        for (int rr = 0; rr < 2; ++rr) {
            const int row = F.wave * 2 + rr, t = q0 + row;
            const LAS float* Srow = Sc + row * SCP; u64* mout = MASKT + (size_t)b * 32 * SEQ + t;
            if (nt8 == 1) select_row<8>(Srow, t, nkeys, lane, mout); else if (nt8 == 2) select_row<16>(Srow, t, nkeys, lane, mout);
            else if (nt8 == 3) select_row<24>(Srow, t, nkeys, lane, mout); else select_row<32>(Srow, t, nkeys, lane, mout);
        }
        __syncthreads();
        if (!more) break;
        L = Ln; b = bn; qt = qn;
    }
}

template <int MODE, bool KOZ = false>
__device__ __forceinline__ void naive_attn_row(const bf16_t* Qrow, const bf16_t* Kp, const bf16_t* Vp, long kvpitch, bf16_t* Orow, int t, const float* cb, const u64* maskb, int lane) {
    float q[64];
#pragma unroll
    for (int c = 0; c < 8; ++c) { const u32x4 w = *(const u32x4*)(Qrow + c * 8);
        q[8 * c + 0] = bf_lo(w.x); q[8 * c + 1] = bf_hi(w.x); q[8 * c + 2] = bf_lo(w.y); q[8 * c + 3] = bf_hi(w.y); q[8 * c + 4] = bf_lo(w.z); q[8 * c + 5] = bf_hi(w.z); q[8 * c + 6] = bf_lo(w.w); q[8 * c + 7] = bf_hi(w.w); }
    float m = -INFINITY, l = 0.f; float o[64];
#pragma unroll
    for (int d = 0; d < 64; ++d) o[d] = 0.f;
    for (int s = lane; s <= t; s += 64) {
        if (MODE == 2) { const u64 w = maskb[(size_t)(s >> 6) * SEQ + t]; if (!((w >> (s & 63)) & 1ull)) continue; }
        const bf16_t* kr = Kp + (size_t)s * kvpitch; float dot = 0.f;
#pragma unroll
        for (int c = 0; c < 8; ++c) { const u32x4 w = *(const u32x4*)(kr + c * 8);
            dot += q[8 * c + 0] * bf_lo(w.x) + q[8 * c + 1] * bf_hi(w.x) + q[8 * c + 2] * bf_lo(w.y) + q[8 * c + 3] * bf_hi(w.y) + q[8 * c + 4] * bf_lo(w.z) + q[8 * c + 5] * bf_hi(w.z) + q[8 * c + 6] * bf_lo(w.w) + q[8 * c + 7] * bf_hi(w.w); }
        if (MODE == 1) dot -= cb[s] * LOG2E;
        const float mn = fmaxf(m, dot), a = exp2f(m - mn), p = exp2f(dot - mn);
        l = l * a + p; m = mn;
        const bf16_t* vr = Vp + (size_t)s * kvpitch;
#pragma unroll
        for (int c = 0; c < 8; ++c) { const u32x4 w = *(const u32x4*)(vr + c * 8);
            o[8 * c + 0] = o[8 * c + 0] * a + p * bf_lo(w.x); o[8 * c + 1] = o[8 * c + 1] * a + p * bf_hi(w.x); o[8 * c + 2] = o[8 * c + 2] * a + p * bf_lo(w.y); o[8 * c + 3] = o[8 * c + 3] * a + p * bf_hi(w.y);
            o[8 * c + 4] = o[8 * c + 4] * a + p * bf_lo(w.z); o[8 * c + 5] = o[8 * c + 5] * a + p * bf_hi(w.z); o[8 * c + 6] = o[8 * c + 6] * a + p * bf_lo(w.w); o[8 * c + 7] = o[8 * c + 7] * a + p * bf_hi(w.w); }
    }
    const float Mx = wave_max(m); const float sc = (m == -INFINITY) ? 0.f : exp2f(m - Mx);
    const float L = wave_sum(l * sc); float res = 0.f;
#pragma unroll
    for (int d = 0; d < 64; ++d) { const float od = wave_sum(o[d] * sc); if (lane == d) res = od; }
    float r = res / L; if (KOZ) r = 0.f;
    const unsigned pk = cvt_pk_bf16(r, r);
    Orow[lane] = (bf16_t)(pk & 0xffffu);
}

constexpr int HG_P = 72;
constexpr int HG_QT = 0, HG_KH = HG_QT + 64 * HG_P * 2, HG_KB = HG_KH + 64 * HG_P * 2, HG_QI = HG_KB + 64 * HG_P * 2, HG_QD = HG_QI + 64 * HG_P * 2,
              HG_KST = HG_QD + 96 * HG_P * 2, HG_VT = HG_KST + 64 * HG_P * 2  , HG_ST = HG_VT + 64 * HG_P * 2  , HG_QRAW = HG_ST + 64 * HG_P * 2,
              HG_FRAW = HG_QRAW + 64 * 64 * 2, HG_TB = HG_FRAW + 64 * 64 * 2  , HG_SC = HG_TB + 4 * 64 * 4  , HG_END = HG_SC + 15 * 64 * 4;
static_assert(HG_END <= RING_BYTES, "hgrn LDS");
__device__ __forceinline__ bf16x8 hg_frag(const LAS unsigned char* base, int row, int col) { return *(const LAS bf16x8*)(base + (row * HG_P + col) * 2); }
__device__ __forceinline__ bf16x8 hg_scale(bf16x8 fr, const LAS float* sp) {
    const u32x4 w = __builtin_bit_cast(u32x4, fr); const f32x4 s0 = *(const LAS f32x4*)sp, s1 = *(const LAS f32x4*)(sp + 4);
    return __builtin_bit_cast(bf16x8, (u32x4){cvt_pk_bf16_v(bf_lo(w.x) * s0[0], bf_hi(w.x) * s0[1]), cvt_pk_bf16_v(bf_lo(w.y) * s0[2], bf_hi(w.y) * s0[3]), cvt_pk_bf16_v(bf_lo(w.z) * s1[0], bf_hi(w.z) * s1[1]), cvt_pk_bf16_v(bf_lo(w.w) * s1[2], bf_hi(w.w) * s1[3])});
}
__device__ __forceinline__ void hgrn_mfma_unit(Frame& F, int u, bool dupo) {
    bf16_t* QKV = (bf16_t*)(F.ws + WS_BIG);
    const int b = u >> 4, h = (u >> 1) & 7, vh = u & 1, tid = F.tid, lane = F.lane, w = F.wave, cl = lane & 15, g = lane >> 4;
    LAS unsigned char* L = F.lds;
    LAS bf16_t* Qt = (LAS bf16_t*)(L + HG_QT); LAS bf16_t* Kh = (LAS bf16_t*)(L + HG_KH); LAS bf16_t* Kb = (LAS bf16_t*)(L + HG_KB); LAS bf16_t* Qi = (LAS bf16_t*)(L + HG_QI);
    LAS bf16_t* QD = (LAS bf16_t*)(L + HG_QD); LAS bf16_t* KsT = (LAS bf16_t*)(L + HG_KST); LAS bf16_t* STb = (LAS bf16_t*)(L + HG_ST);
    LAS bf16_t* Qraw = (LAS bf16_t*)(L + HG_QRAW); LAS bf16_t* Fraw = (LAS bf16_t*)(L + HG_FRAW); LAS float* Tb = (LAS float*)(L + HG_TB); LAS float* Sc = (LAS float*)(L + HG_SC);
    const int kprep = 8 * w + (lane & 7);
    const float lbk = sigmoidf_(F.inp[I_LB][512 + h * 64 + kprep] - F.inp[I_LB][h * 64 + kprep]);
    const int rt = tid >> 3, rk = (tid & 7) * 8;
    const int vs = (tid - 256) >> 2, vq = ((tid - 256) & 3) * 8;
    f32x4 st = (f32x4){0.f, 0.f, 0.f, 0.f};
    for (int i = tid; i < 2 * 32 * HG_P; i += NTHR) STb[i] = 0;
    const size_t rbase = (size_t)b * SEQ;
    u32x4 rq, rf, rv = (u32x4){0u, 0u, 0u, 0u};
    { const bf16_t* rp = QKV + (rbase + rt) * N1; rq = *(const u32x4*)(rp + C1_HQ + h * 64 + rk); rf = *(const u32x4*)(rp + C1_HF + h * 64 + rk);
      if (tid >= 256) rv = *(const u32x4*)(QKV + (rbase + vs) * N1 + C1_HI + h * 64 + vh * 32 + vq); }
    for (int c = 0; c < SEQ / 64; ++c) {
        const size_t row0 = rbase + (size_t)c * 64;
        LAS bf16_t* VT = (LAS bf16_t*)(L + HG_VT + (c & 1) * 32 * HG_P * 2);
        *(LAS u32x4*)(Qraw + rt * 64 + rk) = rq; *(LAS u32x4*)(Fraw + rt * 64 + rk) = rf;
        if (tid >= 256) { const unsigned vv[4] = {rv.x, rv.y, rv.z, rv.w};
#pragma unroll
            for (int e = 0; e < 4; ++e) { VT[(vq + 2 * e) * HG_P + vs] = (bf16_t)(vv[e] & 0xffffu); VT[(vq + 2 * e + 1) * HG_P + vs] = (bf16_t)(vv[e] >> 16); } }
        __syncthreads();
        if (c + 1 < SEQ / 64) { const bf16_t* rp = QKV + (row0 + 64 + rt) * N1; rq = *(const u32x4*)(rp + C1_HQ + h * 64 + rk); rf = *(const u32x4*)(rp + C1_HF + h * 64 + rk);
            if (tid >= 256) rv = *(const u32x4*)(QKV + (row0 + 64 + vs) * N1 + C1_HI + h * 64 + vh * 32 + vq); }
        {
            const int k = 8 * w + (lane & 7), sb_ = (lane >> 3) & 3, hf = lane >> 5, tb = 16 * sb_ + 8 * hf;
            float beta[8], kkv[8], qt[8], fr[8]; float bsum = 0.f;
#pragma unroll
            for (int j = 0; j < 8; ++j) { fr[j] = bf1(Fraw[(tb + j) * 64 + k]); qt[j] = bf1(Qraw[(tb + j) * 64 + k]); }
#pragma unroll
            for (int j = 0; j < 8; ++j) { const float sg = __builtin_amdgcn_rcpf(1.f + __builtin_amdgcn_exp2f(-LOG2E * fr[j]));
                const float f = lbk + (1.f - lbk) * sg; bsum += __builtin_amdgcn_logf(f); kkv[j] = 1.f - f; beta[j] = bsum;
                }
            const float oth = __shfl_xor(bsum, 32); const float off = hf ? oth : 0.f, T = bsum + oth;
            const int lb0 = lane & ~24;
            const float T0 = __shfl(T, lb0), T1 = __shfl(T, lb0 | 8), T2 = __shfl(T, lb0 | 16), T3 = __shfl(T, lb0 | 24);
            const float B1 = T0, B2 = B1 + T1, B3 = B2 + T2, B4 = B3 + T3;
            const float Bi = sb_ == 0 ? 0.f : (sb_ == 1 ? B1 : (sb_ == 2 ? B2 : B3)), Bn = sb_ == 0 ? B1 : (sb_ == 1 ? B2 : (sb_ == 2 ? B3 : B4));
            const float eBi = __builtin_amdgcn_exp2f(Bi), Gi = __builtin_amdgcn_exp2f(B4 - Bn), D0 = __builtin_amdgcn_exp2f(Bi - B1), D1 = __builtin_amdgcn_exp2f(Bi - B2), D2 = __builtin_amdgcn_exp2f(Bi - B3);
            if (hf == 0) { Sc[sb_ * 64 + k] = eBi; if (sb_ == 0) Sc[4 * 64 + k] = __builtin_amdgcn_exp2f(B4);
                const int cb9 = 9 + sb_ * (sb_ - 1) / 2; if (sb_ > 0) Sc[cb9 * 64 + k] = D0; if (sb_ > 1) Sc[(cb9 + 1) * 64 + k] = D1; if (sb_ > 2) Sc[(cb9 + 2) * 64 + k] = D2; }
            const float eT = __builtin_amdgcn_exp2f(fmaxf(T, -115.f));
            unsigned ksw[4];
#pragma unroll
            for (int j = 0; j < 8; ++j) { const int t = tb + j;
                const float e = __builtin_amdgcn_exp2f(fmaxf(beta[j] + off, -115.f)), ie = __builtin_amdgcn_rcpf(e), q2 = qt[j] * e, kb = kkv[j] * fminf(eT * ie, 1.0f);
                Qt[t * HG_P + k] = (bf16_t)(cvt_pk_bf16_v(q2, 0.f) & 0xffffu);
                Kh[t * HG_P + k] = (bf16_t)(cvt_pk_bf16_v(kkv[j] * ie, 0.f) & 0xffffu);
                Kb[t * HG_P + k] = (bf16_t)(cvt_pk_bf16_v(kb, 0.f) & 0xffffu);
                const unsigned kp = cvt_pk_bf16_v(kb * Gi, 0.f) & 0xffffu; if (j & 1) ksw[j >> 1] |= kp << 16; else ksw[j >> 1] = kp; }
            *(LAS u32x4*)(KsT + k * HG_P + tb) = (u32x4){ksw[0], ksw[1], ksw[2], ksw[3]};
        }
        __syncthreads();
        {
            const int bi = w >> 1, vt = w & 1;
            f32x4 p[4];
#pragma unroll
            for (int j = 0; j < 4; ++j) { p[j] = (f32x4){0.f, 0.f, 0.f, 0.f};
                if (j <= bi) { const bool dg = (j == bi); const LAS unsigned char* fb = L + (dg ? HG_KH : HG_KB); const int ci = bi * (bi - 1) / 2 + j;
#pragma unroll
                    for (int hh = 0; hh < 2; ++hh) { bf16x8 qf = hg_frag(L + HG_QT, 16 * bi + cl, 32 * hh + 8 * g); if (!dg) qf = hg_scale(qf, Sc + (9 + ci) * 64 + 32 * hh + 8 * g);
                        p[j] = __builtin_amdgcn_mfma_f32_16x16x32_bf16(hg_frag(fb, 16 * j + cl, 32 * hh + 8 * g), qf, p[j], 0, 0, 0); }
                    if (dg) {
#pragma unroll
                        for (int r = 0; r < 4; ++r) if (4 * g + r > cl) p[j][r] = 0.f; } } }
            const bf16x8 f01 = __builtin_bit_cast(bf16x8, (u32x4){cvt_pk_bf16_v(p[0][0], p[0][1]), cvt_pk_bf16_v(p[0][2], p[0][3]), cvt_pk_bf16_v(p[1][0], p[1][1]), cvt_pk_bf16_v(p[1][2], p[1][3])});
            const bf16x8 f23 = __builtin_bit_cast(bf16x8, (u32x4){cvt_pk_bf16_v(p[2][0], p[2][1]), cvt_pk_bf16_v(p[2][2], p[2][3]), cvt_pk_bf16_v(p[3][0], p[3][1]), cvt_pk_bf16_v(p[3][2], p[3][3])});
            const LAS bf16_t* vrow = VT + (16 * vt + cl) * HG_P;
            const u32x2 va = *(const LAS u32x2*)(vrow + 4 * g), vb = *(const LAS u32x2*)(vrow + 16 + 4 * g), vc = *(const LAS u32x2*)(vrow + 32 + 4 * g), vd = *(const LAS u32x2*)(vrow + 48 + 4 * g);
            f32x4 o = (f32x4){0.f, 0.f, 0.f, 0.f};
            o = __builtin_amdgcn_mfma_f32_16x16x32_bf16(__builtin_bit_cast(bf16x8, (u32x4){va.x, va.y, vb.x, vb.y}), f01, o, 0, 0, 0);
            if (bi >= 2) o = __builtin_amdgcn_mfma_f32_16x16x32_bf16(__builtin_bit_cast(bf16x8, (u32x4){vc.x, vc.y, vd.x, vd.y}), f23, o, 0, 0, 0);
            const LAS unsigned char* stb = L + HG_ST + (c & 1) * 32 * HG_P * 2;
#pragma unroll
            for (int hh = 0; hh < 2; ++hh) o = __builtin_amdgcn_mfma_f32_16x16x32_bf16(hg_frag(stb, 16 * vt + cl, 32 * hh + 8 * g), hg_scale(hg_frag(L + HG_QT, 16 * bi + cl, 32 * hh + 8 * g), Sc + bi * 64 + 32 * hh + 8 * g), o, 0, 0, 0);
            { const u32x2 pk2 = (u32x2){cvt_pk_bf16_v(o[0], o[1]), cvt_pk_bf16_v(o[2], o[3])};
              bf16_t* op = dupo ? (bf16_t*)(F.ws + WS_END) + ((row0 + 16 * bi + cl) & 1023) * N1 : QKV + (row0 + 16 * bi + cl) * N1;
              *(u32x2*)(op + C1_HI + h * 64 + vh * 32 + 16 * vt + 4 * g) = pk2; }
            const int kt = w >> 1;
            st = st * Sc[4 * 64 + 16 * kt + cl];
#pragma unroll
            for (int hh = 0; hh < 2; ++hh) st = __builtin_amdgcn_mfma_f32_16x16x32_bf16(hg_frag((const LAS unsigned char*)VT, 16 * vt + cl, 32 * hh + 8 * g), hg_frag(L + HG_KST, 16 * kt + cl, 32 * hh + 8 * g), st, 0, 0, 0);
            LAS bf16_t* stn = (LAS bf16_t*)(L + HG_ST + ((c + 1) & 1) * 32 * HG_P * 2);
#pragma unroll
            for (int r = 0; r < 4; ++r) stn[(16 * vt + 4 * g + r) * HG_P + 16 * kt + cl] = (bf16_t)(cvt_pk_bf16_v(st[r], 0.f) & 0xffffu);
        }
    }
    __syncthreads();
}


__device__ __forceinline__ void combine_rows(Frame& F) {
    bf16_t* QKV = (bf16_t*)(F.ws + WS_BIG); const bf16_t* DO = (const bf16_t*)(F.ws + WS_DY);
    const int gw = F.vcu * NWAVES + F.wave, NGW = F.G * NWAVES, lane = F.lane;
    const float* lv = F.inp[I_LAM];
    const float d01 = wave_sum(lv[lane] * lv[64 + lane]), d23 = wave_sum(lv[128 + lane] * lv[192 + lane]);
    const float lam_init = 0.8f - 0.6f * expf(-0.3f);
    const float lam = expf(d01) - expf(d23) + lam_init;
    float gh[8], gd[8];
#pragma unroll
    for (int j = 0; j < 8; ++j) { gh[j] = F.inp[I_HGRN_G][(lane & 7) * 8 + j]; gd[j] = F.inp[I_DIFF_G][(lane & 15) * 8 + j] * (1.0f - lam_init); }
    const int hd = lane >> 4, dd = (lane & 15) * 8;
    u32x4 nwo, nwg, nw1, nw2;
    { const int mc = gw < MTOK ? gw : MTOK - 1; const bf16_t* rp = QKV + (size_t)mc * N1; const bf16_t* dp = DO + (size_t)mc * DM + hd * 256 + dd;
      nwo = *(const u32x4*)(rp + C1_HI + lane * 8); nwg = *(const u32x4*)(rp + C1_HG + lane * 8); nw1 = *(const u32x4*)dp; nw2 = *(const u32x4*)(dp + 128); }
    for (int m = gw; m < MTOK; m += NGW) {
        bf16_t* rp = QKV + (size_t)m * N1;
        const u32x4 wo = nwo, wg = nwg, w1 = nw1, w2 = nw2;
        { const int mn = m + NGW; const int mc = mn < MTOK ? mn : MTOK - 1; const bf16_t* rpn = QKV + (size_t)mc * N1; const bf16_t* dpn = DO + (size_t)mc * DM + hd * 256 + dd;
          nwo = *(const u32x4*)(rpn + C1_HI + lane * 8); nwg = *(const u32x4*)(rpn + C1_HG + lane * 8); nw1 = *(const u32x4*)dpn; nw2 = *(const u32x4*)(dpn + 128); }
        {
          float o[8] = {bf_lo(wo.x), bf_hi(wo.x), bf_lo(wo.y), bf_hi(wo.y), bf_lo(wo.z), bf_hi(wo.z), bf_lo(wo.w), bf_hi(wo.w)};
          float g[8] = {bf_lo(wg.x), bf_hi(wg.x), bf_lo(wg.y), bf_hi(wg.y), bf_lo(wg.z), bf_hi(wg.z), bf_lo(wg.w), bf_hi(wg.w)};
          float ss = 0.f;
#pragma unroll
          for (int j = 0; j < 8; ++j) ss += o[j] * o[j];
          ss += __shfl_xor(ss, 1); ss += __shfl_xor(ss, 2); ss += __shfl_xor(ss, 4);
          const float rs = rsqrtf(ss * (1.0f / 64.0f) + EPS); float r[8];
#pragma unroll
          for (int j = 0; j < 8; ++j) r[j] = (KO & 8) ? 0.f : o[j] * rs * gh[j] * g[j] * __builtin_amdgcn_rcpf(1.0f + __builtin_amdgcn_exp2f(-LOG2E * g[j]));
          *(u32x4*)(rp + C1_HQ + lane * 8) = (u32x4){cvt_pk_bf16(r[0], r[1]), cvt_pk_bf16(r[2], r[3]), cvt_pk_bf16(r[4], r[5]), cvt_pk_bf16(r[6], r[7])}; }
        {
          float a[8] = {bf_lo(w1.x), bf_hi(w1.x), bf_lo(w1.y), bf_hi(w1.y), bf_lo(w1.z), bf_hi(w1.z), bf_lo(w1.w), bf_hi(w1.w)};
          float c[8] = {bf_lo(w2.x), bf_hi(w2.x), bf_lo(w2.y), bf_hi(w2.y), bf_lo(w2.z), bf_hi(w2.z), bf_lo(w2.w), bf_hi(w2.w)};
          float ss = 0.f; float d[8];
#pragma unroll
          for (int j = 0; j < 8; ++j) { d[j] = a[j] - lam * c[j]; ss += d[j] * d[j]; }
          ss += __shfl_xor(ss, 1); ss += __shfl_xor(ss, 2); ss += __shfl_xor(ss, 4); ss += __shfl_xor(ss, 8);
          const float rs = rsqrtf(ss * (1.0f / 128.0f) + EPS); float r[8];
#pragma unroll
          for (int j = 0; j < 8; ++j) r[j] = (KO & 16) ? 0.f : d[j] * rs * gd[j];
          *(u32x4*)(rp + C1_Q + hd * 128 + dd) = (u32x4){cvt_pk_bf16(r[0], r[1]), cvt_pk_bf16(r[2], r[3]), cvt_pk_bf16(r[4], r[5]), cvt_pk_bf16(r[6], r[7])}; }
    }
}

__device__ __forceinline__ void router_rows(Frame& F) {
    const bf16_t* XB = (const bf16_t*)(F.ws + WS_XB); const float* SS = (const float*)(F.ws + WS_SS); const float* WRT = (const float*)(F.ws + WS_WRT);
    float* GATE = (float*)(F.ws + WS_GATE); int* LIST = (int*)(F.ws + WS_LIST); unsigned* cnt = F.ctl + CW_CNT;
    LAS float* Ws = (LAS float*)F.lds;
    LAS unsigned* cntL = (LAS unsigned*)(F.lds + 32768);
    LAS int* rec = (LAS int*)(F.lds + 32768 + 256);
    const int lane = F.lane, NGW = F.G * NWAVES;
    for (int i = F.tid; i < 8 * DM; i += NTHR) Ws[i] = WRT[i];
    const int npass = (MTOK + NGW * 16 - 1) / (NGW * 16);
    for (int ps = 0; ps < npass; ++ps) {
        if (F.tid < 32) cntL[F.tid] = 0u;
        __syncthreads();
        u32x4 nw0, nw1; float nss;
        { const int m0 = ((ps * 16) * F.G + F.vcu) * NWAVES + F.wave; const int mc = m0 < MTOK ? m0 : MTOK - 1;
          nw0 = *(const u32x4*)(XB + (size_t)mc * DM + lane * 8); nw1 = *(const u32x4*)(XB + (size_t)mc * DM + 512 + lane * 8); nss = SS[(size_t)mc * 16 + (lane & 15)]; }
        for (int j = 0; j < 16; ++j) {
            const int m = ((ps * 16 + j) * F.G + F.vcu) * NWAVES + F.wave;
            const u32x4 w0 = nw0, w1 = nw1; const float css = nss;
            if (j + 1 < 16) { const int mn = ((ps * 16 + j + 1) * F.G + F.vcu) * NWAVES + F.wave; const int mc = mn < MTOK ? mn : MTOK - 1;
                nw0 = *(const u32x4*)(XB + (size_t)mc * DM + lane * 8); nw1 = *(const u32x4*)(XB + (size_t)mc * DM + 512 + lane * 8); nss = SS[(size_t)mc * 16 + (lane & 15)]; }
            if (m < MTOK) {
                const float x[16] = {bf_lo(w0.x), bf_hi(w0.x), bf_lo(w0.y), bf_hi(w0.y), bf_lo(w0.z), bf_hi(w0.z), bf_lo(w0.w), bf_hi(w0.w), bf_lo(w1.x), bf_hi(w1.x), bf_lo(w1.y), bf_hi(w1.y), bf_lo(w1.z), bf_hi(w1.z), bf_lo(w1.w), bf_hi(w1.w)};
                float ssum = (lane < 16) ? css : 0.f; ssum = wave_sum(ssum);
                const float rs = rsqrtf(ssum * (1.0f / DM) + EPS);
                { const float sc8 = rs * SX8; unsigned char* x8 = (unsigned char*)(F.ws + WS_XB8) + (size_t)m * DM;
                  int p0 = __builtin_amdgcn_cvt_pk_fp8_f32(x[0] * sc8, x[1] * sc8, 0, false); p0 = __builtin_amdgcn_cvt_pk_fp8_f32(x[2] * sc8, x[3] * sc8, p0, true);
                  int p1 = __builtin_amdgcn_cvt_pk_fp8_f32(x[4] * sc8, x[5] * sc8, 0, false); p1 = __builtin_amdgcn_cvt_pk_fp8_f32(x[6] * sc8, x[7] * sc8, p1, true);
                  int p2 = __builtin_amdgcn_cvt_pk_fp8_f32(x[8] * sc8, x[9] * sc8, 0, false); p2 = __builtin_amdgcn_cvt_pk_fp8_f32(x[10] * sc8, x[11] * sc8, p2, true);
                  int p3 = __builtin_amdgcn_cvt_pk_fp8_f32(x[12] * sc8, x[13] * sc8, 0, false); p3 = __builtin_amdgcn_cvt_pk_fp8_f32(x[14] * sc8, x[15] * sc8, p3, true);
                  *(u32x2*)(x8 + lane * 8) = (u32x2){(unsigned)p0, (unsigned)p1}; *(u32x2*)(x8 + 512 + lane * 8) = (u32x2){(unsigned)p2, (unsigned)p3}; }
                float lg[8];
#pragma unroll
                for (int e = 0; e < 8; ++e) { const LAS float* wp = Ws + e * DM + lane * 8; float s = 0.f;
                    const f32x4 a0 = *(const LAS f32x4*)wp, a1 = *(const LAS f32x4*)(wp + 4), b0 = *(const LAS f32x4*)(wp + 512), b1 = *(const LAS f32x4*)(wp + 516);
                    s += x[0] * a0[0] + x[1] * a0[1] + x[2] * a0[2] + x[3] * a0[3] + x[4] * a1[0] + x[5] * a1[1] + x[6] * a1[2] + x[7] * a1[3];
                    s += x[8] * b0[0] + x[9] * b0[1] + x[10] * b0[2] + x[11] * b0[3] + x[12] * b1[0] + x[13] * b1[1] + x[14] * b1[2] + x[15] * b1[3];
                    lg[e] = wave_sum(s) * rs; }
                int i1 = 0; float l1 = lg[0];
#pragma unroll
                for (int e = 1; e < 8; ++e) if (lg[e] > l1) { l1 = lg[e]; i1 = e; }
                int i2 = -1; float l2 = -INFINITY;
#pragma unroll
                for (int e = 0; e < 8; ++e) if (e != i1 && lg[e] > l2) { l2 = lg[e]; i2 = e; }
                const float g1 = 1.0f / (1.0f + __expf(l2 - l1)), g2 = 1.0f - g1;
                if (lane == 0) {
                    const unsigned r1 = atomicAdd((unsigned*)(cntL + i1), 1u), r2 = atomicAdd((unsigned*)(cntL + 8 + i2), 1u);
                    LAS int* rp = rec + (F.wave * 16 + j) * 4; rp[0] = i1; rp[1] = (int)r1; rp[2] = i2; rp[3] = (int)r2;
                    GATE[m] = g1; GATE[MTOK + m] = g2;
                }
            }
        }
        __syncthreads();
        if (F.tid < 16) { const unsigned n = cntL[F.tid]; cntL[16 + F.tid] = n ? __hip_atomic_fetch_add(cnt + F.tid, n, RLX_AGENT) : 0u; }
        __syncthreads();
        if (F.tid < 128) { const int w = F.tid >> 4, j = F.tid & 15; const int m = ((ps * 16 + j) * F.G + F.vcu) * NWAVES + w;
            if (m < MTOK) { const LAS int* rp = rec + F.tid * 4; const int i1 = rp[0], r1 = rp[1], i2 = rp[2], r2 = rp[3];
                LIST[(size_t)i1 * MTOK + cntL[16 + i1] + r1] = m; LIST[(size_t)(8 + i2) * MTOK + cntL[16 + 8 + i2] + r2] = m; } }
        __syncthreads();
    }
}

__device__ __forceinline__ void final_norm(Frame& F, int part, int widx, int nwork) {
    if (widx < 0) return;
    const int gw = widx * NWAVES + F.wave, NGW = nwork * NWAVES, lane = F.lane;
    const unsigned char* FLAG = (const unsigned char*)(F.ws + WS_FLAG);
    const int mflag = (gw + lane * NGW < MTOK) ? (int)FLAG[gw + lane * NGW] : 0;
    const u64 fl = __ballot(mflag != 0);
    const int nrows = gw < MTOK ? (MTOK - gw + NGW - 1) / NGW : 0;
    u64 todo = (part ? fl : ~fl) & (nrows >= 64 ? ~0ull : ((1ull << nrows) - 1ull));
    if (!todo) return;
    f32x4 g[4];
#pragma unroll
    for (int j = 0; j < 4; ++j) g[j] = *((const f32x4*)F.inp[I_LN_FINAL] + lane + 64 * j);
    const bf16_t* X3 = (const bf16_t*)(F.ws + WS_XB); const bf16_t* Y1 = (const bf16_t*)(F.ws + WS_DY); const bf16_t* Y0 = (const bf16_t*)(F.ws + WS_Y0);
    u32x2 nx[4], ny[4], nz[4];
#define FN_LOAD(M) do { _Pragma("unroll") for (int j_ = 0; j_ < 4; ++j_) { nx[j_] = *((const u32x2*)(X3 + (size_t)(M) * DM) + lane + 64 * j_); ny[j_] = *((const u32x2*)(Y1 + (size_t)(M) * DM) + lane + 64 * j_); nz[j_] = *((const u32x2*)(Y0 + (size_t)(M) * DM) + lane + 64 * j_); } } while (0)
    int jr = __builtin_ctzll(todo); todo &= todo - 1ull;
    FN_LOAD(gw + jr * NGW);
    for (;;) {
        const int m = gw + jr * NGW;
        u32x2 cx[4], cy[4], cz[4];
#pragma unroll
        for (int j = 0; j < 4; ++j) { cx[j] = nx[j]; cy[j] = ny[j]; cz[j] = nz[j]; }
        const bool more = todo != 0ull;
        if (more) { jr = __builtin_ctzll(todo); todo &= todo - 1ull; FN_LOAD(gw + jr * NGW); }
        f32x4* xr = (f32x4*)(F.out + (size_t)m * DM) + lane; f32x4 v[4]; float s = 0.f;
#pragma unroll
        for (int j = 0; j < 4; ++j) { const u32x2 xw = cx[j], yw = cy[j], zw = cz[j];
            v[j] = (f32x4){bf_lo(xw.x), bf_hi(xw.x), bf_lo(xw.y), bf_hi(xw.y)} + ((f32x4){bf_lo(yw.x), bf_hi(yw.x), bf_lo(yw.y), bf_hi(yw.y)} + (f32x4){bf_lo(zw.x), bf_hi(zw.x), bf_lo(zw.y), bf_hi(zw.y)}); s += (v[j][0] * v[j][0] + v[j][1] * v[j][1]) + (v[j][2] * v[j][2] + v[j][3] * v[j][3]); }
        const float rs = rsqrtf(wave_sum(s) * (1.0f / DM) + EPS);
#pragma unroll
        for (int j = 0; j < 4; ++j) xr[64 * j] = v[j] * rs * g[j];
        if (!more) break;
    }
#undef FN_LOAD
}

constexpr int NPH = 17;
struct Args { const float* in[22]; float* out; unsigned char* ws; int ph_lo, ph_hi, li, dup; };
__global__ void __launch_bounds__(NTHR, 2) trunk_fwd(Args args) {
    extern __shared__ __attribute__((aligned(16))) unsigned char lds[];
    Frame F;
    F.lds = (LAS unsigned char*)lds;
    F.tid = threadIdx.x; F.lane = F.tid & 63; F.wave = __builtin_amdgcn_readfirstlane(F.tid >> 6);
    F.G = gridDim.x; { const int bx = blockIdx.x; F.vcu = (F.G % 8 == 0) ? (bx % 8) * (F.G / 8) + bx / 8 : bx; }
    F.ws = args.ws; F.out = args.out; F.ctl = (unsigned*)(args.ws + WS_CTL);
    F.inp = args.in;
    volatile LAS unsigned* MISC = (volatile LAS unsigned*)(F.lds + MISC_OFF);
    for (int u = F.tid; u < (LDS_BYTES - LDSCTL_OFF) / 4; u += NTHR) ((LAS unsigned*)(F.lds + LDSCTL_OFF))[u] = 0u;
    __syncthreads();
    XcdBarrier bar; bar.bar = F.ctl + CW_BAR + args.li * XCD_BAR_WORDS; bar.x = 0; bar.st = nullptr;
    if (!MK_PER_PHASE) bar = xcd_barrier_post(F.ctl + CW_BAR + args.li * XCD_BAR_WORDS, MISC + 8);
#define GRID_BAR() do { if (MK_PER_PHASE) { if (F.tid == 0) __hip_atomic_store(F.ctl + CW_TMO, 0xBADBA0u, RLX_AGENT); } else { xcd_barrier(bar); } } while (0)
    const int lo = args.ph_lo, hi = args.ph_hi;
#ifndef PH_MASK
#define PH_MASK 0x1ffff
#endif
#define IN(k) ((((PH_MASK) >> (k)) & 1) && lo <= (k) && (k) < hi)
#define BOTH(k) (IN(k) && IN((k) + 1))
    unsigned char* ws = args.ws;
    bf16_t* XB = (bf16_t*)(ws + WS_XB); float* SS = (float*)(ws + WS_SS); bf16_t* BIG = (bf16_t*)(ws + WS_BIG);
    const int c = (int)blockIdx.x, G = F.G; const bool dupo = args.dup != 0;

    if (IN(0)) { p0_prologue(F); if (BOTH(0)) GRID_BAR(); }
    if (IN(1)) {
        pg8::Gemm g{XB, ws + WS_WIN0, DM * 2, DM * 2, 0, nullptr}; pg8::StaticOrder S; S.init(MTOK, N0, G, c);
        pg8::EpiIn E{BIG, N0, SS, (const float*)(ws + WS_ROPE), (float*)(ws + WS_LOGF), (float*)(ws + WS_IW), F.inp[I_B_FOX], 0};
        pg8::gemm_phase<pg8::EpiIn, pg8::StaticOrder, false, true>(F.lds, g, S, E);
        if (BOTH(1)) GRID_BAR();
    }
    if (IN(2)) {
        for (int u = c; u < 128; u += G) fox_cumsum_unit(F, u);
        idx_units(F, c, G);
        if (BOTH(2)) GRID_BAR();
    }
    if (IN(3)) {
#if FAST_ATTN
        static_assert(attn_body::LDS_BYTES <= RING_BYTES, "attention LDS");
        if (c < 256) {
            const int cc = (c & 7) * 32 + (c >> 3);
            const int hc = cc >> 1, b = hc >> 3, h = hc & 7;
            attn_body::bf16* base = (attn_body::bf16*)(BIG + (size_t)b * SEQ * N0);
            attn_body::bf16* dbase = (attn_body::bf16*)(ws + WS_XB + 16 * MiB);
            const float* cbp = (const float*)(ws + WS_CB) + (size_t)(b * 8 + h) * SEQ; const u64* mkp = (const u64*)(ws + WS_MASK) + (size_t)b * 32 * SEQ;
            const float fqk = ((const float*)(ws + WS_FQK))[b * 8 + h];
            attn_body::bf16* obase = dupo ? dbase : base;
            const attn_body::bf16* dk_ = base + C0_DK + (h >> 2) * 64; const attn_body::bf16* dv_ = base + C0_DV + (h >> 2) * 64;
#define FOX_SK(QBI) ((QBI) >= 2 && fqk + (cbp[(QBI) * 256] - cbp[(QBI) * 256 - 257]) * LOG2E < -40.0f)
#define FOX_SH(QBI, SK) ((SK) ? (size_t)((QBI) - 1) * 256 * N0 : (size_t)0)
#define FOX_U(QBI, SK, PRE, KN, VN) do { if (SK) { const size_t sh_ = (size_t)((QBI) - 1) * 256 * N0; \
                attn_body::attn_unit<8, 1, N0, N0, N0, 1, PRE, true>(base + sh_ + C0_FQ + h * 64, base + sh_ + C0_FK + h * 64, base + sh_ + C0_FV + h * 64, obase + sh_ + C0_FQ + h * 64, (char*)lds, cbp + ((QBI) - 1) * 256, nullptr, KN, VN); } \
            else attn_body::attn_unit<8, 1, N0, N0, N0, QBI, PRE, true>(base + C0_FQ + h * 64, base + C0_FK + h * 64, base + C0_FV + h * 64, obase + C0_FQ + h * 64, (char*)lds, cbp, nullptr, KN, VN); } while (0)
#define DSA_U(QBI, PFN) attn_body::attn_unit<8, 2, N0, N0, N0, QBI, true, PFN>(base + C0_DQ + h * 64, dk_, dv_, obase + C0_DQ + h * 64, (char*)lds, nullptr, mkp, dk_, dv_)
#define L0_SEQ(A, B, C, D) do { const bool sa = FOX_SK(A), sb = FOX_SK(B), sc_ = FOX_SK(C), sd = FOX_SK(D); \
                FOX_U(A, sa, false, base + FOX_SH(B, sb) + C0_FK + h * 64, base + FOX_SH(B, sb) + C0_FV + h * 64); \
                FOX_U(B, sb, true, base + FOX_SH(C, sc_) + C0_FK + h * 64, base + FOX_SH(C, sc_) + C0_FV + h * 64); \
                FOX_U(C, sc_, true, base + FOX_SH(D, sd) + C0_FK + h * 64, base + FOX_SH(D, sd) + C0_FV + h * 64); \
                FOX_U(D, sd, true, dk_, dv_); \
                DSA_U(A, true); DSA_U(B, true); DSA_U(C, true); DSA_U(D, false); } while (0)
            if (cc & 1) L0_SEQ(1, 6, 3, 4); else L0_SEQ(0, 7, 2, 5);
#undef L0_SEQ
#undef DSA_U
#undef FOX_U
#undef FOX_SH
#undef FOX_SK
#undef DSA_U
        }
#else
        const int gw = F.vcu * NWAVES + F.wave, NGW = G * NWAVES;
        for (int id = gw; id < 256 * SEQ; id += NGW) {
            const int combo = id & 255, t = id >> 8; const int typ = combo >> 7, b = (combo >> 3) & 15, h = combo & 7;
            bf16_t* rowp = BIG + ((size_t)b * SEQ + t) * N0; const bf16_t* b0 = BIG + (size_t)b * SEQ * N0;
            if (typ == 0) naive_attn_row<1, (KO & 1) != 0>(rowp + C0_FQ + h * 64, b0 + C0_FK + h * 64, b0 + C0_FV + h * 64, N0, rowp + C0_FQ + h * 64, t, (const float*)(ws + WS_CB) + (size_t)(b * 8 + h) * SEQ, nullptr, F.lane);
            else naive_attn_row<2, (KO & 2) != 0>(rowp + C0_DQ + h * 64, b0 + C0_DK + (h >> 2) * 64, b0 + C0_DV + (h >> 2) * 64, N0, rowp + C0_DQ + h * 64, t, nullptr, (const u64*)(ws + WS_MASK) + (size_t)b * 32 * SEQ, F.lane);
        }
#endif
        if (BOTH(3)) GRID_BAR();
    }
    if (IN(4)) {
        pg8::Gemm g{BIG, ws + WS_WOUT0, N0 * 2, DM * 2, 0, nullptr}; pg8::StaticOrder S; S.init(MTOK, DM, G, c);
        pg8::EpiRes<true> E{(const float*)XB, nullptr, XB, SS, 0x7fffffff, FFN_GU8 ? (unsigned char*)(ws + WS_XB8) : nullptr, 1.0f};
        pg8::gemm_phase<pg8::EpiRes<true>, pg8::StaticOrder, false, true>(F.lds, g, S, E);
        if (BOTH(4)) GRID_BAR();
    }
    if (IN(5) && !(KO & 4)) {
        pg8::Gemm g{FFN_GU8 ? (const void*)(ws + WS_XB8) : (const void*)XB, ws + WS_WGU0, FFN_GU8 ? DM : DM * 2, FFN_GU8 ? DM : DM * 2, 0, nullptr}; pg8::StaticOrder S; S.init(MTOK, 2 * FF, G, c);
        pg8::EpiGU<false, FFN_DN8 != 0, FFN_GU8 != 0> E{BIG, FF, SS, nullptr};
        pg8::gemm_phase<pg8::EpiGU<false, FFN_DN8 != 0, FFN_GU8 != 0>, pg8::StaticOrder, false, true, FFN_GU8 != 0>(F.lds, g, S, E);
        if (BOTH(5)) GRID_BAR();
    }
    if (IN(6) && !(KO & 4)) {
        pg8::Gemm g{BIG, ws + WS_WDN0, FFN_DN8 ? FF : FF * 2, FFN_DN8 ? FF : FF * 2, 0, nullptr}; pg8::StaticOrder S; S.init(MTOK, DM, G, c);
        pg8::EpiRes<true> E{(const float*)XB, dupo ? (float*)(ws + WS_END) : nullptr, dupo ? (bf16_t*)(ws + WS_END + 4 * MiB) : XB, dupo ? (float*)(ws + WS_END + 6 * MiB) : SS, dupo ? 1023 : 0x7fffffff, nullptr, FFN_DN8 ? 1.0f / (SH8 * SW8) : 1.0f};
        pg8::gemm_phase<pg8::EpiRes<true>, pg8::StaticOrder, false, true, FFN_DN8 != 0>(F.lds, g, S, E);
        if (BOTH(6)) GRID_BAR();
    }
    if (IN(7)) {
        pg8::Gemm g{XB, ws + WS_WIN1, DM * 2, DM * 2, 0, nullptr}; pg8::StaticOrder S; S.init(MTOK, N1, G, c);
        pg8::EpiIn E{BIG, N1, SS, (const float*)(ws + WS_ROPE), nullptr, nullptr, nullptr, 1};
        pg8::gemm_phase<pg8::EpiIn, pg8::StaticOrder, false, true>(F.lds, g, S, E);
        if (BOTH(7)) GRID_BAR();
    }
    if (IN(8)) {
        if (!(dupo && HG_SKIP)) for (int u = c; u < 256; u += G) { const int uu = (G == 256) ? (u & 7) * 32 + (u >> 3) : u; hgrn_mfma_unit(F, uu, dupo); }
        if (!(dupo && AT_SKIP))
#if FAST_ATTN
        if (c < 256) {
            static_assert(attn_body::LDS_BYTES_DV2 <= RING_BYTES, "attention LDS (DV2)");
            const int cc = (c & 7) * 32 + (c >> 3);
            const int hm = cc >> 1, b = hm >> 3, hd = (hm >> 1) & 3, mp = hm & 1;
            attn_body::bf16* base = (attn_body::bf16*)(BIG + (size_t)b * SEQ * N1);
            attn_body::bf16* obase = (attn_body::bf16*)((bf16_t*)(ws + WS_DY) + (size_t)b * SEQ * DM) + (hd * 2 + mp) * 128;
#define DIFF_U(QBI, PRE, PFN) attn_body::attn_unit<8, 0, N1, N1, DM, QBI, PRE, PFN, true>(base + C1_Q + (hd * 2 + mp) * 64, base + C1_K + (hd * 2 + mp) * 64, base + C1_V + hd * 128, obase, (char*)lds, nullptr, nullptr, base + C1_K + (hd * 2 + mp) * 64, base + C1_V + hd * 128)
            if (cc & 1) { DIFF_U(6, false, true); DIFF_U(1, true, true); DIFF_U(4, true, true); DIFF_U(3, true, false); }
            else        { DIFF_U(7, false, true); DIFF_U(0, true, true); DIFF_U(5, true, true); DIFF_U(2, true, false); }
#undef DIFF_U
        }
#else
        const int gw = F.vcu * NWAVES + F.wave, NGW = G * NWAVES;
        bf16_t* DO = (bf16_t*)(ws + WS_DY);
        for (int id = gw; id < 256 * SEQ; id += NGW) {
            const int combo = id & 255, t = id >> 8; const int b = combo >> 4, hd = (combo >> 2) & 3, mp = (combo >> 1) & 1, jv = combo & 1;
            const bf16_t* rowp = BIG + ((size_t)b * SEQ + t) * N1; const bf16_t* b0 = BIG + (size_t)b * SEQ * N1;
            naive_attn_row<0>(rowp + C1_Q + (hd * 2 + mp) * 64, b0 + C1_K + (hd * 2 + mp) * 64, b0 + C1_V + hd * 128 + jv * 64, N1,
                              DO + ((size_t)b * SEQ + t) * DM + (hd * 2 + mp) * 128 + jv * 64, t, nullptr, nullptr, F.lane);
        }
#endif
        if (BOTH(8)) GRID_BAR();
    }
    if (IN(9)) { combine_rows(F); if (BOTH(9)) GRID_BAR(); }
    if (IN(10)) {
        pg8::Gemm g{BIG, ws + WS_WOUT1, N1 * 2, DM * 2, 0, nullptr}; pg8::StaticOrder S; S.init(MTOK, DM, G, c);
        pg8::EpiRes<true> E{(const float*)XB, dupo ? (float*)(ws + WS_END) : nullptr, dupo ? (bf16_t*)(ws + WS_END + 4 * MiB) : XB, dupo ? (float*)(ws + WS_END + 6 * MiB) : SS, dupo ? 1023 : 0x7fffffff, nullptr, 1.0f};
        pg8::gemm_phase<pg8::EpiRes<true>, pg8::StaticOrder, false, true>(F.lds, g, S, E);
        if (BOTH(10)) GRID_BAR();
    }
    if (IN(11)) { router_rows(F); if (BOTH(11)) GRID_BAR(); }
    { const int* LIST = (const int*)(ws + WS_LIST);
      if (IN(12) && !(KO & 32)) {
          { pg8::MoeOrder Sd; Sd.init(F.ctl + CW_CNT, 4, G, c);
            for (int pg = Sd.Pmain + c; pg < Sd.NPt; pg += G) { pg8::Unit pu; Sd.panel(pg, pu); if (F.tid < pu.nvalid) ((unsigned char*)(ws + WS_FLAG))[LIST[pu.lbase + F.tid]] = 1; } }
          pg8::Gemm g{ws + WS_XB8, ws + WS_WEGU, DM, DM, (size_t)7168 * DM, LIST}; pg8::MoeOrder S; S.init(F.ctl + CW_CNT, 28, G, c);
          pg8::EpiGU<true> E{BIG, FFE, SS, LIST};
          pg8::gemm_phase<pg8::EpiGU<true>, pg8::MoeOrder, true, true, true>(F.lds, g, S, E);
          if (BOTH(12)) GRID_BAR();
      }
      if (IN(13) && !(KO & 32)) {
          pg8::Gemm g{BIG, ws + WS_WEDN, FFE, FFE, (size_t)DM * FFE, nullptr}; pg8::MoeOrder S; S.init(F.ctl + CW_CNT, 4, G, c);
          pg8::EpiMoeDown E{dupo ? (bf16_t*)(ws + WS_END) : (bf16_t*)(ws + WS_Y0), LIST, (const float*)(ws + WS_GATE), dupo ? 2047 : 0x7fffffff, dupo ? (bf16_t*)(ws + WS_END + 8 * MiB) : (bf16_t*)(ws + WS_DY)};
          S.mode = 1; pg8::gemm_phase<pg8::EpiMoeDown, pg8::MoeOrder, false, true, true>(F.lds, g, S, E);
          GRID_BAR();
          const int nsur = S.NPt * 4 - S.Lmain;
          S.mode = 2;
          if (c < nsur) pg8::gemm_phase<pg8::EpiMoeDown, pg8::MoeOrder, false, true, true>(F.lds, g, S, E);
          else final_norm(F, 0, c - nsur, G - nsur);
          GRID_BAR();
          final_norm(F, 1, F.vcu, G);
      } }
#undef IN
#undef BOTH
}


#ifndef DBG
#define DBG 0
#endif
#if DBG
constexpr int CW_CHK = 512;
constexpr size_t WS_DBG = WS_END;
__device__ __forceinline__ void chk_max(unsigned* ctl, int id, float e) { if (!(e >= 0.f)) e = 1e30f; atomicMax(ctl + CW_CHK + id, __float_as_uint(e)); }
__device__ __forceinline__ float relerr(float got, float exp_, float scale = 1.0f) { return fabsf(got - exp_) / (fabsf(exp_) + 0.5f * scale); }
__device__ __forceinline__ int dbg_row(int i) { const int rows[8] = {0, 255, 256, 1000, 2047, 2048 + 77, 16 * 2048 - 1, 20000}; return rows[i & 7]; }
__device__ float block_sum(float v, float* red) {
    v = wave_sum(v); __syncthreads(); if ((threadIdx.x & 63) == 0) red[threadIdx.x >> 6] = v; __syncthreads();
    float s = 0.f; for (int w = 0; w < 8; ++w) s += red[w]; __syncthreads(); return s;
}
__global__ void __launch_bounds__(512) dbg_check(Args args, int which) {
    __shared__ float hv[3584]; __shared__ float raw[2880]; __shared__ float red[8];
    const float* const* in = args.in; unsigned char* ws = args.ws; unsigned* ctl = (unsigned*)(ws + WS_CTL);
    const int tid = threadIdx.x; const int r = dbg_row(blockIdx.x), t = r & (SEQ - 1);
    const bf16_t* BIG = (const bf16_t*)(ws + WS_BIG); const bf16_t* XB = (const bf16_t*)(ws + WS_XB); const float* SS = (const float*)(ws + WS_SS);
    float* SCR = (float*)(ws + WS_DBG) + (size_t)blockIdx.x * 1024;
    float emax = 0.f;
    if (which == 1) {
        float ssq = 0.f; for (int k = tid; k < DM; k += 512) { const float x = in[I_X][(size_t)r * DM + k]; ssq += x * x; }
        const float rs = rsqrtf(block_sum(ssq, red) / DM + EPS);
        for (int k = tid; k < DM; k += 512) hv[k] = in[I_X][(size_t)r * DM + k] * rs * in[I_LN_MIX_E][k];
        __syncthreads();
        for (int n = tid; n < N0SRC; n += 512) { float a = 0.f; for (int k = 0; k < DM; ++k) a += hv[k] * in[I_W_IN_E][(size_t)k * N0SRC + n]; raw[n] = a; }
        __syncthreads();
        const bf16_t* q = BIG + (size_t)r * N0;
        float e1 = 0.f, e2 = 0.f, e3 = 0.f;
        for (int i = tid; i < 512; i += 512) { e1 = fmaxf(e1, relerr(bf1(q[C0_FQ + i]), raw[i] * C2, C2)); e2 = fmaxf(e2, relerr(bf1(q[C0_FK + i]), raw[512 + i])); e3 = fmaxf(e3, relerr(bf1(q[C0_FV + i]), raw[1024 + i])); }
        chk_max(ctl, 21, wave_max(e1)); chk_max(ctl, 22, wave_max(e2)); chk_max(ctl, 23, wave_max(e3));
        float e4 = 0.f; for (int i = tid; i < 128; i += 512) e4 = fmaxf(e4, relerr(bf1(q[C0_DV + i]), raw[2184 + i]));
        chk_max(ctl, 24, wave_max(e4));
        const int sb[4] = {1544, 2056, 2312, 2568}, nh[4] = {8, 2, 4, 1}, db[4] = {C0_DQ, C0_DK, C0_IQ, C0_IK}; const float scl[4] = {C2, 1.f, 0.125f, 1.f};
        for (int sg = 0; sg < 4; ++sg) { float e = 0.f; for (int i = tid; i < nh[sg] * 32; i += 512) { const int hh = i >> 5, p = i & 31;
            const float inv = powf(10000.0f, -(float)p * 2.0f / 64.0f), ang = (float)t * inv, cs = cosf(ang), sn = sinf(ang);
            const float x1 = raw[sb[sg] + hh * 64 + p], x2 = raw[sb[sg] + hh * 64 + 32 + p];
            e = fmaxf(e, relerr(bf1(q[db[sg] + hh * 64 + 2 * p]), (x1 * cs - x2 * sn) * scl[sg], scl[sg])); e = fmaxf(e, relerr(bf1(q[db[sg] + hh * 64 + 2 * p + 1]), (x2 * cs + x1 * sn) * scl[sg], scl[sg])); }
            chk_max(ctl, 25 + sg, wave_max(e)); }
        float e9 = 0.f, e10 = 0.f;
        if (tid < 8) { const float x = raw[1536 + tid] + in[I_B_FOX][tid]; const float lf = fminf(x, 0.f) - log1pf(expf(-fabsf(x))); e9 = relerr(((const float*)(ws + WS_LOGF))[(size_t)r * 8 + tid], lf); }
        if (tid < 4) e10 = relerr(((const float*)(ws + WS_IW))[(size_t)r * 4 + tid], raw[2632 + tid] * 0.5f);
        float ea = 0.f, eb = 0.f, ec = 0.f;
        if (tid < 8) { ea = relerr(bf1(q[C0_FF + tid]), raw[1536 + tid]); const float x = raw[1536 + tid]; const float lf = fminf(x, 0.f) - log1pf(expf(-fabsf(x))); eb = relerr(((const float*)(ws + WS_LOGF))[(size_t)r * 8 + tid], lf); ec = e9; }
        chk_max(ctl, 1, wave_max(ea)); chk_max(ctl, 2, wave_max(eb)); chk_max(ctl, 3, wave_max(ec)); chk_max(ctl, 4, wave_max(e10));
    } else if (which == 2) {
        const float* LOGF = (const float*)(ws + WS_LOGF); const float* CB = (const float*)(ws + WS_CB); const u64* MASKT = (const u64*)(ws + WS_XB);
        const int gid = blockIdx.x * 512 + tid;
        if (gid < 128) { const int b = gid >> 3, h = gid & 7; float c = 0.f; for (int s2 = 0; s2 < SEQ; ++s2) { c += LOGF[((size_t)b * SEQ + s2) * 8 + h]; emax = fmaxf(emax, fabsf(CB[(size_t)gid * SEQ + s2] - c) / (fabsf(c) * 1e-3f + 0.01f)); } }
        chk_max(ctl, 2, wave_max(emax));
        float e3 = 0.f;
        for (int rr = gid; rr < MTOK; rr += 8 * 512) { const int b = rr >> 11, tt = rr & 2047; int pc = 0; bool bad = false;
            for (int i = 0; i < 32; ++i) { const u64 w = MASKT[((size_t)b * 32 + i) * SEQ + tt]; pc += __popcll(w);
                const int lo = i * 64; if (lo > tt) { if (w) bad = true; } else if (tt - lo < 63) { if (w >> (tt - lo + 1)) bad = true; } }
            const int want = (tt + 1 < 256) ? tt + 1 : 256; if (pc != want || bad) e3 = 1.f; }
        chk_max(ctl, 3, wave_max(e3));
    } else if (which == 4) {
        for (int k = tid; k < DM; k += 512) hv[k] = bf1(BIG[(size_t)r * N0 + k]);
        __syncthreads();
        float ssq = 0.f;
        for (int n = tid; n < DM; n += 512) { float a = in[I_X][(size_t)r * DM + n]; for (int k = 0; k < DM; ++k) a += hv[k] * in[I_W_OUT_E][(size_t)k * DM + n];
            emax = fmaxf(emax, relerr(args.out[(size_t)r * DM + n], a)); emax = fmaxf(emax, relerr(bf1(XB[(size_t)r * DM + n]), a)); ssq += a * a; }
        ssq = block_sum(ssq, red); float s16 = 0.f; for (int i = 0; i < 16; ++i) s16 += SS[(size_t)r * 16 + i];
        emax = fmaxf(emax, fabsf(s16 - ssq) / ssq * 10.f);
        chk_max(ctl, 4, wave_max(emax));
    } else if (which == 5) {
        float ssq = 0.f; for (int k = tid; k < DM; k += 512) { const float x = args.out[(size_t)r * DM + k]; ssq += x * x; }
        const float rs = rsqrtf(block_sum(ssq, red) / DM + EPS);
        for (int k = tid; k < DM; k += 512) hv[k] = args.out[(size_t)r * DM + k] * rs * in[I_LN_FFN_E][k];
        __syncthreads();
        for (int n = tid; n < FF; n += 512) { float g = 0.f, u = 0.f; for (int k = 0; k < DM; ++k) { g += hv[k] * in[I_W_GATE][(size_t)k * FF + n]; u += hv[k] * in[I_W_UP][(size_t)k * FF + n]; }
            const float h = g / (1.f + expf(-g)) * u; emax = fmaxf(emax, relerr(bf1(BIG[(size_t)r * FF + n]), h)); }
        __syncthreads();
        for (int k = tid; k < FF; k += 512) hv[k] = bf1(BIG[(size_t)r * FF + k]);
        __syncthreads();
        for (int n = tid; n < DM; n += 512) { float a = args.out[(size_t)r * DM + n]; for (int k = 0; k < FF; ++k) a += hv[k] * in[I_W_DOWN][(size_t)k * DM + n]; SCR[n] = a; }
        chk_max(ctl, 5, wave_max(emax));
    } else if (which == 6) {
        for (int n = tid; n < DM; n += 512) emax = fmaxf(emax, relerr(args.out[(size_t)r * DM + n], SCR[n]));
        chk_max(ctl, 6, wave_max(emax));
    }
}
__global__ void __launch_bounds__(512) dbg_encode(Args args, int nchk, int total) {
    const unsigned* ctl = (const unsigned*)(args.ws + WS_CTL);
    int idx = 0, mag = 0;
    for (int i = 1; i <= nchk; ++i) { const float e = __uint_as_float(ctl[CW_CHK + i]); if (e > 0.06f) { idx = i; mag = 0; float th = 1.0f; while (mag < 9 && e < th) { th *= 0.5f; ++mag; } break; } }
    const float s = sqrtf((float)(10 * idx + mag));
    for (int i = blockIdx.x * 512 + threadIdx.x; i < total; i += gridDim.x * 512) args.out[i] = s;
}
#endif
extern "C" void kernel_launch(void* const* d_in, const int* in_sizes, int n_in, void* d_out, int out_size, void* d_ws, size_t ws_size, hipStream_t stream) {
    static int grid = 0;
    if (grid == 0) {
        if (n_in != 22 || in_sizes[0] != MTOK * DM || out_size != MTOK * DM || ws_size < WS_END) { fprintf(stderr, "kernel_launch: unexpected shapes / workspace (%zu < %zu)\n", ws_size, (size_t)WS_END); grid = -1; return; }
        int dev = 0, cus = 0, per_cu = 0;
        if (hipGetDevice(&dev) != hipSuccess || hipDeviceGetAttribute(&cus, hipDeviceAttributeMultiprocessorCount, dev) != hipSuccess) { grid = -1; return; }
        if (hipFuncSetAttribute((const void*)trunk_fwd, hipFuncAttributeMaxDynamicSharedMemorySize, LDS_BYTES) != hipSuccess) { grid = -1; return; }
        if (hipOccupancyMaxActiveBlocksPerMultiprocessor(&per_cu, (const void*)trunk_fwd, NTHR, LDS_BYTES) != hipSuccess || per_cu < 1) { fprintf(stderr, "kernel_launch: occupancy query says %d\n", per_cu); }
        (void)hipGetLastError();
        grid = cus;
    }
    if (grid < 0) return;
    if (hipMemsetAsync((char*)d_ws + WS_CTL, 0, CTL_ZERO_BYTES, stream) != hipSuccess) return;
    Args a{};
    for (int i = 0; i < 22; ++i) a.in[i] = (const float*)d_in[i];
    a.out = (float*)d_out; a.ws = (unsigned char*)d_ws; a.dup = 0;
#if MK_PER_PHASE
    for (int p = 0; p < NPH; ++p) { a.ph_lo = p; a.ph_hi = p + 1; a.li = p; hipLaunchKernelGGL(trunk_fwd, dim3(grid), dim3(NTHR), LDS_BYTES, stream, a);
#if DBG
        if (p == 1 || p == 2 || p == 4 || p == 5 || p == 6) hipLaunchKernelGGL(dbg_check, dim3(8), dim3(512), 0, stream, a, p);
        if (p == DBG_LAST) { hipLaunchKernelGGL(dbg_encode, dim3(1024), dim3(512), 0, stream, a, 9, MTOK * DM); break; }
#endif
    }
#else
#if PROBE_PH >= 0
    a.ph_lo = 0; a.ph_hi = PROBE_PH + 1; a.li = 0; hipLaunchKernelGGL(trunk_fwd, dim3(grid), dim3(NTHR), LDS_BYTES, stream, a);
    a.ph_lo = PROBE_PH; a.ph_hi = PROBE_PH + 1; a.li = 1; a.dup = 1; hipLaunchKernelGGL(trunk_fwd, dim3(grid), dim3(NTHR), LDS_BYTES, stream, a);
    a.dup = 0; a.ph_lo = PROBE_PH + 1; a.ph_hi = NPH; a.li = 2; hipLaunchKernelGGL(trunk_fwd, dim3(grid), dim3(NTHR), LDS_BYTES, stream, a);
#else
    a.ph_lo = 0; a.ph_hi = NPH; a.li = 0;
    hipLaunchKernelGGL(trunk_fwd, dim3(grid), dim3(NTHR), LDS_BYTES, stream, a);
#endif
#endif
}
```

```cpp
#include <hip/hip_runtime.h>
#include <hip/hip_bf16.h>
#include <cstdio>
#include <cstdint>

#ifndef MK_PER_PHASE
#define MK_PER_PHASE 0
#endif
#ifndef KO
#define KO 0
#endif
#define DBG 0
#define DBG_LAST 1
#ifndef PROBE_PH
#define PROBE_PH -1
#endif
#ifndef HG_SKIP
#define HG_SKIP 0
#define AT_SKIP 0
#endif
#ifndef HGRN_MFMA
#define HGRN_MFMA 1
#endif
#ifndef FFN_GU8
#define FFN_GU8 1
#endif
#ifndef FFN_DN8
#define FFN_DN8 1
#endif
#ifndef FAST_ATTN
#define FAST_ATTN 1
#endif

#define LAS __attribute__((address_space(3)))
#define GAS __attribute__((address_space(1)))
typedef unsigned short bf16_t;
typedef short bf16x8 __attribute__((ext_vector_type(8)));
typedef float f32x4 __attribute__((ext_vector_type(4)));
typedef float f32x2 __attribute__((ext_vector_type(2)));
typedef unsigned u32x4 __attribute__((ext_vector_type(4)));
typedef unsigned u32x2 __attribute__((ext_vector_type(2)));
typedef unsigned long long u64;

constexpr int NB = 16, SEQ = 2048, DM = 1024, MTOK = NB * SEQ;
constexpr int N0 = 2816;
constexpr int N0SRC = 2636, N1 = 3584, FF = 2816, FFE = 3584, NEXP = 8;
constexpr float EPS = 1e-6f;
constexpr float LOG2E = 1.4426950408889634f;
constexpr float C2 = 0.125f * LOG2E;
constexpr int C0_FQ = 0, C0_DQ = 512, C0_FK = 1024, C0_FV = 1536, C0_DK = 2048, C0_DV = 2176, C0_IQ = 2304, C0_IK = 2560, C0_FF = 2624, C0_IW = 2632;
constexpr int C1_HQ = 0, C1_Q = 512, C1_HF = 1024, C1_HI = 1536, C1_HG = 2048, C1_K = 2560, C1_V = 3072;

constexpr size_t MiB = 1u << 20;
constexpr size_t WS_FLAG = 64 * 1024;
constexpr size_t WS_CTL = 0, CTL_ZERO_BYTES = 64 * 1024 + 32768;
constexpr size_t WS_ROPE = 1 * MiB;
constexpr size_t WS_IW   = WS_ROPE + 512 * 1024;
constexpr size_t WS_LOGF = 2 * MiB;
constexpr size_t WS_CB   = 3 * MiB;
constexpr size_t WS_SS   = 4 * MiB;
constexpr size_t WS_WRT  = 6 * MiB;
constexpr size_t WS_FQK  = 6 * MiB + 64 * 1024;
constexpr size_t WS_GATE = 6 * MiB + 256 * 1024;
constexpr size_t WS_LIST = 7 * MiB;
constexpr size_t WS_WIN0 = 10 * MiB;
constexpr size_t WS_WOUT0 = 16 * MiB;
constexpr size_t WS_WGU0 = 18 * MiB;
constexpr size_t WS_WDN0 = 29 * MiB;
constexpr size_t WS_WIN1 = 35 * MiB;
constexpr size_t WS_WOUT1 = 42 * MiB;
constexpr size_t WS_WEGU = 44 * MiB;
constexpr size_t WS_WEDN = 100 * MiB;
constexpr size_t WS_XB8 = 128 * MiB;
constexpr size_t WS_Y0 = 16 * MiB;
constexpr size_t WS_DY = 128 * MiB;
constexpr size_t WS_MASK = 160 * MiB;
constexpr float SW8 = 64.0f, SX8 = 8.0f, SH8 = 4.0f;
constexpr size_t WS_XB = 212 * MiB;
constexpr size_t WS_BIG = 276 * MiB;
constexpr size_t WS_END = 514 * MiB;
constexpr int MAXPANEL = 136;
static_assert(WS_BIG + (size_t)MAXPANEL * 256 * FFE * 2 <= WS_END && WS_BIG + (size_t)MTOK * N1 * 2 <= WS_END, "ws map");
constexpr int CW_TMO = 0, CW_CODE = 1;
constexpr int CW_CNT = 64;
constexpr int CW_BAR = 4096;

constexpr int RING_BYTES = 151552;
constexpr int LDSCTL_OFF = RING_BYTES, MISC_OFF = LDSCTL_OFF + 320;
constexpr int LDS_BYTES = 155648;
constexpr int NWAVES = 8, NTHR = 512;

#define RLX_AGENT __ATOMIC_RELAXED, __HIP_MEMORY_SCOPE_AGENT
#define LDS_WAIT() asm volatile("s_waitcnt lgkmcnt(0)" ::: "memory")
__device__ __forceinline__ unsigned cvt_pk_bf16(float lo, float hi) { unsigned r; asm volatile("v_cvt_pk_bf16_f32 %0, %1, %2" : "=v"(r) : "v"(lo), "v"(hi)); return r; }
typedef __bf16 bf16x2_v __attribute__((ext_vector_type(2)));
__device__ __forceinline__ unsigned cvt_pk_bf16_v(float lo, float hi) { f32x2 v = {lo, hi}; bf16x2_v b = __builtin_convertvector(v, bf16x2_v); return __builtin_bit_cast(unsigned, b); }
__device__ __forceinline__ float bf_lo(unsigned u) { return __uint_as_float(u << 16); }
__device__ __forceinline__ float bf_hi(unsigned u) { return __uint_as_float(u & 0xffff0000u); }
__device__ __forceinline__ float bf1(bf16_t u) { return __uint_as_float(((unsigned)u) << 16); }
#define DPP_F(v, ctrl) __uint_as_float((unsigned)__builtin_amdgcn_update_dpp(0, (int)__float_as_uint(v), ctrl, 0xF, 0xF, true))
__device__ __forceinline__ float wave_sum(float v) {
    v += DPP_F(v, 0xB1); v += DPP_F(v, 0x4E); v += DPP_F(v, 0x141); v += DPP_F(v, 0x140);
    const int b = (int)__float_as_uint(v);
    return (__uint_as_float((unsigned)__builtin_amdgcn_readlane(b, 0)) + __uint_as_float((unsigned)__builtin_amdgcn_readlane(b, 16))) + (__uint_as_float((unsigned)__builtin_amdgcn_readlane(b, 32)) + __uint_as_float((unsigned)__builtin_amdgcn_readlane(b, 48)));
}
__device__ __forceinline__ float wave_max(float v) {
    v = fmaxf(v, DPP_F(v, 0xB1)); v = fmaxf(v, DPP_F(v, 0x4E)); v = fmaxf(v, DPP_F(v, 0x141)); v = fmaxf(v, DPP_F(v, 0x140));
    const int b = (int)__float_as_uint(v);
    return fmaxf(fmaxf(__uint_as_float((unsigned)__builtin_amdgcn_readlane(b, 0)), __uint_as_float((unsigned)__builtin_amdgcn_readlane(b, 16))), fmaxf(__uint_as_float((unsigned)__builtin_amdgcn_readlane(b, 32)), __uint_as_float((unsigned)__builtin_amdgcn_readlane(b, 48))));
}
__device__ __forceinline__ float sigmoidf_(float x) { return 1.0f / (1.0f + __expf(-x)); }
__device__ __forceinline__ float siluf_(float x) { return x / (1.0f + __expf(-x)); }

namespace pg8 {
constexpr int BM = 256, BK = 64, HALF = 128, HTB = HALF * BK * 2, STAGE_BYTES = 8 * HTB, NXCD = 8, WGM = 8;
__host__ __device__ __forceinline__ int lds_byte(int r, int c) { const int st = (r >> 4) * 2 + (c >> 5), rr = r & 15, cc = c & 31, ob = rr * 64 + cc * 2; return st * 1024 + (ob ^ (((ob >> 9) & 1) << 5)); }
__host__ __device__ __forceinline__ void stage_rc(int b, int& R, int& C) { const int st = b / 1024, sb = b % 1024, swz = sb ^ (((sb >> 9) & 1) << 5); R = (st >> 1) * 16 + swz / 64; C = (st & 1) * 32 + (swz % 64) / 2; }
__host__ __device__ __forceinline__ int perm32(int rho) { const int n = rho >> 4, i = rho & 15; return 8 * (i >> 2) + 4 * n + (i & 3); }

typedef int v4i_t __attribute__((ext_vector_type(4)));
typedef int v8i_t __attribute__((ext_vector_type(8)));
struct Unit { int pm, pn, e, nvalid, lbase, kc; };
struct Gemm { const void* A; const void* Bt; int lda; int K; size_t bstride_e; const int* list; };

__device__ __forceinline__ void swz_order(int L, int nM, int nN, int& pm, int& pn) {
    const int nwg = nM * nN; int wgid = L;
    { const int q = nwg / NXCD, r = nwg % NXCD, xcd = wgid % NXCD, off = wgid / NXCD; wgid = (xcd < r ? xcd * (q + 1) : r * (q + 1) + (xcd - r) * q) + off; }
    const int nig = WGM * nN, gid = wgid / nig, fm = gid * WGM, gsz = (nM - fm) < WGM ? (nM - fm) : WGM;
    pm = fm + ((wgid % nig) % gsz); pn = (wgid % nig) / gsz;
}
struct StaticOrder {
    int nM, nN, nwg, G, c;
    __device__ __forceinline__ void init(int M, int N, int G_, int c_) { nM = M / BM; nN = N / BM; nwg = nM * nN; G = G_; c = c_; }
    __device__ __forceinline__ bool next(int i, Unit& u) const {
        const long L = (long)i * G + c; if (L >= nwg) return false;
        swz_order((int)L, nM, nN, u.pm, u.pn); u.e = 0; u.nvalid = BM; u.lbase = 0; u.kc = 0; return true;
    }
};
struct MoeOrder {
    int nN, NP0, NPt, G, c; int a0, a1, a2, a3, a4, a5, a6, a7, b0, b1, b2, b3, b4, b5, b6, b7;
    int mode, Lmain, Pmain;
    __device__ __forceinline__ static int npan(int x0, int x1, int x2, int x3, int x4, int x5, int x6, int x7) {
        int n = ((x0 + 255) >> 8) + ((x1 + 255) >> 8) + ((x2 + 255) >> 8) + ((x3 + 255) >> 8) + ((x4 + 255) >> 8) + ((x5 + 255) >> 8) + ((x6 + 255) >> 8) + ((x7 + 255) >> 8); return n > MAXPANEL ? MAXPANEL : n; }
    __device__ __forceinline__ void init(const unsigned* cntp, int nN_, int G_, int c_) {
        nN = nN_; G = G_; c = c_;
        a0 = (int)cntp[0]; a1 = (int)cntp[1]; a2 = (int)cntp[2]; a3 = (int)cntp[3]; a4 = (int)cntp[4]; a5 = (int)cntp[5]; a6 = (int)cntp[6]; a7 = (int)cntp[7];
        b0 = (int)cntp[8]; b1 = (int)cntp[9]; b2 = (int)cntp[10]; b3 = (int)cntp[11]; b4 = (int)cntp[12]; b5 = (int)cntp[13]; b6 = (int)cntp[14]; b7 = (int)cntp[15];
        NP0 = npan(a0, a1, a2, a3, a4, a5, a6, a7); NPt = NP0 + npan(b0, b1, b2, b3, b4, b5, b6, b7);
        mode = 0; Lmain = (NPt * nN / G) * G; if (Lmain % nN) Lmain = 0; Pmain = Lmain / nN;
    }
    __device__ __forceinline__ bool next(int i, Unit& u) const {
        const long L = (long)i * G + c + (mode == 2 ? Lmain : 0); if (L >= (mode == 1 ? (long)Lmain : (long)NPt * nN)) return false;
        int pg, pn;
        if (mode == 0) swz_order((int)L, NPt, nN, pg, pn); else if (mode == 1) swz_order((int)L, Pmain, nN, pg, pn); else { pg = Pmain + ((int)L - Lmain) / nN; pn = ((int)L - Lmain) % nN; }
        panel(pg, u); u.pn = pn; return true;
    }
    __device__ __forceinline__ void panel(int pg, Unit& u) const {
        const int pn = 0;
        const int kc = pg >= NP0 ? 1 : 0, pm = pg - (kc ? NP0 : 0);
        const int c0 = kc ? b0 : a0, c1 = kc ? b1 : a1, c2 = kc ? b2 : a2, c3 = kc ? b3 : a3, c4 = kc ? b4 : a4, c5 = kc ? b5 : a5, c6 = kc ? b6 : a6, c7 = kc ? b7 : a7;
        int e = 0, ps = 0, ce = c0;
#define MOE_STEP(CN, CNEXT, EI) { const int np = ((CN) + 255) >> 8; if (e == (EI) - 1 && pm >= ps + np) { ps += np; e = (EI); ce = (CNEXT); } }
        MOE_STEP(c0, c1, 1) MOE_STEP(c1, c2, 2) MOE_STEP(c2, c3, 3) MOE_STEP(c3, c4, 4) MOE_STEP(c4, c5, 5) MOE_STEP(c5, c6, 6) MOE_STEP(c6, c7, 7)
#undef MOE_STEP
        const int local = pm - ps; int nv = ce - local * 256; nv = nv > 256 ? 256 : nv; nv = nv < 1 ? 1 : nv;
        u.pm = kc * MAXPANEL + pm; u.pn = pn; u.e = e; u.nvalid = nv; u.lbase = (kc * 8 + e) * MTOK + local * 256; u.kc = kc;
    }
};

__device__ __forceinline__ float row_rstd(const float* SS, int row, int fq) {
    const f32x4* pp = (const f32x4*)(SS + (size_t)row * 16); const f32x4 p0 = pp[0], p1 = pp[1], p2 = pp[2], p3 = pp[3]; (void)fq;
    const float s = ((p0[0] + p0[1]) + (p0[2] + p0[3])) + ((p1[0] + p1[1]) + (p1[2] + p1[3])) + ((p2[0] + p2[1]) + (p2[2] + p2[3])) + ((p3[0] + p3[1]) + (p3[2] + p3[3]));
    return rsqrtf(s * (1.0f / DM) + EPS);
}

struct EpiIn {
    static constexpr bool PERM = true;
    bf16_t* O; int ldc; const float* SS; const float* rope; float* LOGF; float* IW; const float* bfox; int layer;
    __device__ __forceinline__ int kind_of(int g64) const {
        if (layer == 0) { if (g64 < 8) return 1; if (g64 < 16) return 3; if (g64 < 32) return 0; if (g64 < 34) return 2; if (g64 < 36) return 0; if (g64 < 40) return 4; if (g64 == 40) return 2; if (g64 == 41) return 5; return 0; }
        if (g64 < 8) return 6; if (g64 >= 8 && g64 < 16) return 3; if (g64 >= 40 && g64 < 48) return 2; return 0;
    }
    __device__ __forceinline__ void operator()(const f32x4 (&acc)[2][2][4][2], const Unit& u, int wr, int wc, int fr, int fq) const {
        const int row0 = u.pm * BM + wr * 64 + fr;
        int kind[2]; int colb[2];
#pragma unroll
        for (int bj = 0; bj < 2; ++bj) { colb[bj] = u.pn * BM + bj * HALF + wc * 32; kind[bj] = kind_of(colb[bj] >> 6); }
        const bool anyrope = (kind[0] >= 2 && kind[0] <= 4) || (kind[1] >= 2 && kind[1] <= 4);
        const int i0 = (((wc & 1) * 32) + 8 * fq) >> 1;
#pragma unroll
        for (int ai = 0; ai < 2; ++ai)
#pragma unroll
            for (int m = 0; m < 4; ++m) {
                const int row = row0 + ai * HALF + m * 16;
                const float rs = row_rstd(SS, row, fq);
                f32x4 cs0 = (f32x4){1.f, 0.f, 1.f, 0.f}, cs1 = cs0;
                if (anyrope) { const float* rp = rope + ((size_t)(row & (SEQ - 1)) * 32 + i0) * 2; cs0 = *(const f32x4*)rp; cs1 = *(const f32x4*)(rp + 4); }
#pragma unroll
                for (int bj = 0; bj < 2; ++bj) {
                    f32x4 v0 = acc[ai][bj][m][0] * rs, v1 = acc[ai][bj][m][1] * rs;
                    const int kd = kind[bj];
                    if (kd >= 2 && kd <= 4) {
                        f32x4 a, b;
                        a[0] = v0[0] * cs0[0] - v0[1] * cs0[1]; a[1] = v0[1] * cs0[0] + v0[0] * cs0[1];
                        a[2] = v0[2] * cs0[2] - v0[3] * cs0[3]; a[3] = v0[3] * cs0[2] + v0[2] * cs0[3];
                        b[0] = v1[0] * cs1[0] - v1[1] * cs1[1]; b[1] = v1[1] * cs1[0] + v1[0] * cs1[1];
                        b[2] = v1[2] * cs1[2] - v1[3] * cs1[3]; b[3] = v1[3] * cs1[2] + v1[2] * cs1[3];
                        v0 = a; v1 = b;
                    }
                    const float sc = (kd == 1 || kd == 3) ? C2 : (kd == 4 ? 0.125f : 1.0f);
                    if (kd == 5 && (wc & 1) == 0) {
                        if (fq == 0) { f32x4 l0, l1;
#pragma unroll
                            for (int j = 0; j < 4; ++j) { const float x0 = v0[j] + bfox[j], x1 = v1[j] + bfox[4 + j];
                                l0[j] = fminf(x0, 0.f) - log1pf(__expf(-fabsf(x0))); l1[j] = fminf(x1, 0.f) - log1pf(__expf(-fabsf(x1))); }
                            *(f32x4*)(LOGF + (size_t)row * 8) = l0; *(f32x4*)(LOGF + (size_t)row * 8 + 4) = l1; }
                        if (fq == 1) { *(f32x4*)(IW + (size_t)row * 4) = v0 * 0.5f; }
                    }
                    v0 = v0 * sc; v1 = v1 * sc;
                    if (kd == 6) {
#pragma unroll
                        for (int j = 0; j < 4; ++j) { v0[j] = v0[j] * __builtin_amdgcn_rcpf(1.0f + __builtin_amdgcn_exp2f(-LOG2E * v0[j])); v1[j] = v1[j] * __builtin_amdgcn_rcpf(1.0f + __builtin_amdgcn_exp2f(-LOG2E * v1[j])); } }
                    u32x4 w; w.x = cvt_pk_bf16(v0[0], v0[1]); w.y = cvt_pk_bf16(v0[2], v0[3]); w.z = cvt_pk_bf16(v1[0], v1[1]); w.w = cvt_pk_bf16(v1[2], v1[3]);
                    *(u32x4*)(O + (size_t)row * ldc + colb[bj] + 8 * fq) = w;
                }
            }
    }
};
template <bool BASE16> struct EpiRes {
    static constexpr bool PERM = false;
    const float* base; float* out; bf16_t* xb; float* SS; int omask; unsigned char* xb8; float ascale;
    __device__ __forceinline__ void operator()(const f32x4 (&acc)[2][2][4][2], const Unit& u, int wr, int wc, int fr, int fq) const {
        const int col0 = u.pn * BM + wc * 32 + 4 * fq;
#pragma unroll
        for (int ai = 0; ai < 2; ++ai) {
            f32x4 pre[4][2][2];
#pragma unroll
            for (int m = 0; m < 4; ++m)
#pragma unroll
                for (int bj = 0; bj < 2; ++bj)
#pragma unroll
                    for (int n = 0; n < 2; ++n) { const size_t off = (size_t)(u.pm * BM + ai * HALF + wr * 64 + m * 16 + fr) * DM + col0 + bj * HALF + n * 16;
                        if (BASE16) { const u32x2 w = *(const u32x2*)((const bf16_t*)base + off); pre[m][bj][n] = (f32x4){bf_lo(w.x), bf_hi(w.x), bf_lo(w.y), bf_hi(w.y)}; } else pre[m][bj][n] = *(const f32x4*)(base + off); }
#pragma unroll
            for (int m = 0; m < 4; ++m) {
                const int row = u.pm * BM + ai * HALF + wr * 64 + m * 16 + fr; float ssq = 0.f;
#pragma unroll
                for (int bj = 0; bj < 2; ++bj)
#pragma unroll
                    for (int n = 0; n < 2; ++n) {
                        const size_t offo = (size_t)(row & omask) * DM + col0 + bj * HALF + n * 16;
                        const f32x4 o = pre[m][bj][n] + acc[ai][bj][m][n] * ascale;
                        if (out) *(f32x4*)(out + offo) = o; ssq += (o[0] * o[0] + o[1] * o[1]) + (o[2] * o[2] + o[3] * o[3]);
                        u32x2 w; w.x = cvt_pk_bf16(o[0], o[1]); w.y = cvt_pk_bf16(o[2], o[3]); *(u32x2*)(xb + offo) = w;
                        if (xb8) { int p = __builtin_amdgcn_cvt_pk_fp8_f32(o[0] * SX8, o[1] * SX8, 0, false); p = __builtin_amdgcn_cvt_pk_fp8_f32(o[2] * SX8, o[3] * SX8, p, true); *(int*)(xb8 + offo) = p; }
                    }
                ssq += __shfl_xor(ssq, 16); ssq += __shfl_xor(ssq, 32);
                if (fq == 0) SS[(size_t)(row & omask) * 16 + u.pn * 4 + wc] = ssq;
            }
        }
    }
};
template <bool MOE, bool H8 = MOE, bool IN8 = MOE> struct EpiGU {
    static constexpr bool PERM = true;
    bf16_t* H; int ldh; const float* SS; const int* list;
    __device__ __forceinline__ void operator()(const f32x4 (&acc)[2][2][4][2], const Unit& u, int wr, int wc, int fr, int fq) const {
        const int hcol = u.pn * HALF + wc * 32 + 8 * fq;
#pragma unroll
        for (int ai = 0; ai < 2; ++ai)
#pragma unroll
            for (int m = 0; m < 4; ++m) {
                const int rl = ai * HALF + wr * 64 + m * 16 + fr;
                const float rs = MOE ? 1.0f / (SX8 * SW8) : row_rstd(SS, u.pm * BM + rl, fq) * (IN8 ? 1.0f / (SX8 * SW8) : 1.0f);
                unsigned w[4];
                const float c1 = -LOG2E * rs, c2 = rs * rs * (H8 ? SH8 : 1.0f);
#pragma unroll
                for (int n = 0; n < 2; ++n) { float h[4];
#pragma unroll
                    for (int jp = 0; jp < 2; ++jp) {
                        const f32x2 g2 = (f32x2){acc[ai][0][m][n][2 * jp], acc[ai][0][m][n][2 * jp + 1]}, u2 = (f32x2){acc[ai][1][m][n][2 * jp], acc[ai][1][m][n][2 * jp + 1]};
                        const f32x2 a = g2 * c1; f32x2 t = (f32x2){__builtin_amdgcn_exp2f(a[0]), __builtin_amdgcn_exp2f(a[1])}; t = t + 1.0f;
                        const f32x2 r = (f32x2){__builtin_amdgcn_rcpf(t[0]), __builtin_amdgcn_rcpf(t[1])};
                        const f32x2 h2 = ((g2 * u2) * c2) * r; h[2 * jp] = h2[0]; h[2 * jp + 1] = h2[1]; }
                    if (H8) { int p = __builtin_amdgcn_cvt_pk_fp8_f32(h[0], h[1], 0, false); p = __builtin_amdgcn_cvt_pk_fp8_f32(h[2], h[3], p, true); w[n] = (unsigned)p; }
                    else { w[2 * n] = cvt_pk_bf16(h[0], h[1]); w[2 * n + 1] = cvt_pk_bf16(h[2], h[3]); } }
                if (H8) *(u32x2*)((unsigned char*)H + (size_t)(u.pm * BM + rl) * ldh + hcol) = (u32x2){w[0], w[1]};
                else *(u32x4*)(H + (size_t)(u.pm * BM + rl) * ldh + hcol) = (u32x4){w[0], w[1], w[2], w[3]};
            }
    }
};
struct EpiMoeDown {
    static constexpr bool PERM = false;
    bf16_t* y0; const int* list; const float* gate; int tmask; bf16_t* y1;
    __device__ __forceinline__ void operator()(const f32x4 (&acc)[2][2][4][2], const Unit& u, int wr, int wc, int fr, int fq) const {
        const int col0 = u.pn * BM + wc * 32 + 4 * fq;
#pragma unroll
        for (int ai = 0; ai < 2; ++ai) {
            int tk[4]; float gg[4];
#pragma unroll
            for (int m = 0; m < 4; ++m) { const int rl = ai * HALF + wr * 64 + m * 16 + fr; const int rc = rl < u.nvalid ? rl : u.nvalid - 1; tk[m] = list[u.lbase + rc]; }
#pragma unroll
            for (int m = 0; m < 4; ++m) gg[m] = gate[u.kc * MTOK + tk[m]] * (1.0f / (SH8 * SW8));
            bf16_t* yb = u.kc ? y1 : y0;
#pragma unroll
            for (int m = 0; m < 4; ++m) { const int rl = ai * HALF + wr * 64 + m * 16 + fr; if (rl < u.nvalid) {
#pragma unroll
                for (int bj = 0; bj < 2; ++bj)
#pragma unroll
                    for (int n = 0; n < 2; ++n) { const f32x4 v = acc[ai][bj][m][n] * gg[m]; u32x2 w; w.x = cvt_pk_bf16(v[0], v[1]); w.y = cvt_pk_bf16(v[2], v[3]);
                        *(u32x2*)(yb + (size_t)(tk[m] & tmask) * DM + col0 + bj * HALF + n * 16) = w; } } }
        }
    }
};

template <bool GATHER> __device__ __forceinline__ void a_offsets(const Gemm& g, const Unit& u, const int (&R)[2], const int (&C)[2], unsigned (&ao)[2][2]) {
#pragma unroll
    for (int h = 0; h < 2; ++h)
#pragma unroll
        for (int i = 0; i < 2; ++i) { const int rl = h * HALF + R[i]; size_t row;
            if (GATHER) { const int rc = rl < u.nvalid ? rl : u.nvalid - 1; row = (size_t)g.list[u.lbase + rc]; } else row = (size_t)u.pm * BM + rl;
            ao[h][i] = (unsigned)(row * (size_t)g.lda + C[i] * 2); }
}

template <class Epi, class Sched, bool GATHER, bool ALIGN_EPI, bool FP8 = false>
__device__ __forceinline__ void gemm_phase(LAS unsigned char* lds, const Gemm g, const Sched& S, const Epi& E) {
    const int tid = threadIdx.x, wid = __builtin_amdgcn_readfirstlane(tid >> 6), lane = tid & 63, wr = wid >> 2, wc = wid & 3, fr = lane & 15, fq = lane >> 4;
    const int K = g.K, nt = K / (BK * 2);
    int RR[2], CC[2]; unsigned voffB[2];
#pragma unroll
    for (int i = 0; i < 2; ++i) { int R, C; stage_rc(tid * 16 + i * 8192, R, C); RR[i] = R; CC[i] = C; const int Rb = Epi::PERM ? ((R & ~31) + perm32(R & 31)) : R; voffB[i] = (unsigned)(Rb * K + C * 2); }
    const size_t kstep = (size_t)(BK * 2);
    const size_t hstepB = (size_t)HALF * K;
    const size_t tstepB = 2 * hstepB;
    const unsigned ldsw = (unsigned)wid * 1024u;
    const int aoff = lds_byte(wr * 64 + fr, fq * 8), boff = lds_byte(wc * 32 + fr, fq * 8);
#define PG8_SA(b, h) (((b) * 2 + (h)) * HTB)
#define PG8_SB(b, h) ((4 + (b) * 2 + (h)) * HTB)
#define PG8_STAGE_B(bufoff, gbase) do { _Pragma("unroll") for (int _i = 0; _i < 2; ++_i) \
        __builtin_amdgcn_global_load_lds((const unsigned*)((const char*)(gbase) + voffB[_i]), (LAS unsigned*)(lds + (bufoff) + ldsw + _i * 8192), 16, 0, 0); } while (0)
#define PG8_STAGE_A(bufoff, kb, AO) do { _Pragma("unroll") for (int _i = 0; _i < 2; ++_i) \
        __builtin_amdgcn_global_load_lds((const unsigned*)(Ab + (kb) + (AO)[_i]), (LAS unsigned*)(lds + (bufoff) + ldsw + _i * 8192), 16, 0, 0); } while (0)
#define PG8_LDA(dst, b, h) do { _Pragma("unroll") for (int m = 0; m < 4; ++m) { const bf16x8 r0_ = *(const LAS bf16x8*)(lds + PG8_SA(b, h) + aoff + m * 2048), r1_ = *(const LAS bf16x8*)(lds + PG8_SA(b, h) + aoff + m * 2048 + 1024); \
        if constexpr (FP8) dst##8[m] = PG8_CAT8(r0_, r1_); else { dst[m][0] = r0_; dst[m][1] = r1_; } } } while (0)
#define PG8_LDB(dst, b, h) do { _Pragma("unroll") for (int n = 0; n < 2; ++n) { const bf16x8 r0_ = *(const LAS bf16x8*)(lds + PG8_SB(b, h) + boff + n * 2048), r1_ = *(const LAS bf16x8*)(lds + PG8_SB(b, h) + boff + n * 2048 + 1024); \
        if constexpr (FP8) dst##8[n] = PG8_CAT8(r0_, r1_); else { dst[n][0] = r0_; dst[n][1] = r1_; } } } while (0)
#define PG8_CAT8(x0, x1) __builtin_shufflevector(__builtin_bit_cast(v4i_t, x0), __builtin_bit_cast(v4i_t, x1), 0, 1, 2, 3, 4, 5, 6, 7)
#define PG8_MMA(ai, bj, At, Bt) do { __builtin_amdgcn_s_setprio(1); _Pragma("unroll") for (int m = 0; m < 4; ++m) _Pragma("unroll") for (int n = 0; n < 2; ++n) { \
        if constexpr (FP8) asm volatile("v_mfma_f32_16x16x128_f8f6f4 %0, %1, %2, %0" : "+v"(acc[ai][bj][m][n]) : "v"(Bt##8[n]), "v"(At##8[m])); \
        else { _Pragma("unroll") for (int k = 0; k < 2; ++k) acc[ai][bj][m][n] = __builtin_amdgcn_mfma_f32_16x16x32_bf16(Bt[n][k], At[m][k], acc[ai][bj][m][n], 0, 0, 0); } } __builtin_amdgcn_s_setprio(0); } while (0)
#define PG8_WAIT_V(n) asm volatile("s_waitcnt vmcnt(" #n ")" ::: "memory")
#define PG8_WAIT_L(n) asm volatile("s_waitcnt lgkmcnt(" #n ")" ::: "memory")
#define PG8_BAR __builtin_amdgcn_s_barrier()
#define PG8_SCHED __builtin_amdgcn_sched_barrier(0)
    Unit cur, nxt; int ui = 0;
    if (!S.next(0, cur)) return;
    f32x4 acc[2][2][4][2];
#pragma unroll
    for (int a = 0; a < 2; ++a)
#pragma unroll
        for (int b = 0; b < 2; ++b)
#pragma unroll
            for (int m = 0; m < 4; ++m)
#pragma unroll
                for (int n = 0; n < 2; ++n) acc[a][b][m][n] = (f32x4){0.f, 0.f, 0.f, 0.f};
    bf16x8 At[4][2], B0[2][2], B1[2][2];
    v8i_t At8[4], B08[2], B18[2];
    unsigned cao[2][2], nao[2][2];
    a_offsets<GATHER>(g, cur, RR, CC, cao);
    const char* Ab = (const char*)g.A;
    const char* cB = (const char*)g.Bt + (size_t)cur.e * g.bstride_e + (size_t)cur.pn * tstepB;
    PG8_STAGE_B(PG8_SB(0, 0), cB); PG8_STAGE_B(PG8_SB(0, 1), cB + hstepB); PG8_STAGE_A(PG8_SA(0, 0), 0, cao[0]); PG8_STAGE_A(PG8_SA(0, 1), 0, cao[1]);
    if (wr == 1) PG8_BAR;
    PG8_WAIT_V(2); PG8_BAR;
    PG8_STAGE_B(PG8_SB(1, 0), cB + kstep); PG8_STAGE_A(PG8_SA(1, 0), kstep, cao[0]); PG8_STAGE_B(PG8_SB(1, 1), cB + hstepB + kstep);
    PG8_WAIT_V(6); PG8_BAR;
    for (;;) {
        const bool has_next = S.next(ui + 1, nxt);
        if (has_next) a_offsets<GATHER>(g, nxt, RR, CC, nao);
        else {
#pragma unroll
            for (int h = 0; h < 2; ++h)
#pragma unroll
                for (int i = 0; i < 2; ++i) nao[h][i] = cao[h][i]; }
        const char* nB = has_next ? (const char*)g.Bt + (size_t)nxt.e * g.bstride_e + (size_t)nxt.pn * tstepB : cB;
        for (int t = 0; t < nt; t += 2) {
            const bool last = (t == nt - 2);
            const size_t ka1 = (size_t)(t + 1) * kstep;
            const size_t ka2 = last ? 0 : (size_t)(t + 2) * kstep; const char* b2 = last ? nB : cB + (size_t)(t + 2) * kstep;
            const size_t ka3 = ka2 + kstep; const char* b3 = b2 + kstep;
            unsigned ao2[2][2];
#pragma unroll
            for (int h = 0; h < 2; ++h)
#pragma unroll
                for (int i = 0; i < 2; ++i) ao2[h][i] = last ? nao[h][i] : cao[h][i];
            PG8_LDB(B0, 0, 0); PG8_LDB(B1, 0, 1); PG8_SCHED; PG8_LDA(At, 0, 0); PG8_STAGE_A(PG8_SA(1, 1), ka1, cao[1]);
            PG8_WAIT_V(8); PG8_WAIT_L(0); PG8_BAR; PG8_MMA(0, 0, At, B0); PG8_MMA(0, 1, At, B1); PG8_BAR; PG8_SCHED;
            PG8_LDA(At, 0, 1); PG8_STAGE_B(PG8_SB(0, 0), b2); PG8_STAGE_B(PG8_SB(0, 1), b2 + hstepB); PG8_STAGE_A(PG8_SA(0, 0), ka2, ao2[0]);
            PG8_WAIT_V(8); PG8_WAIT_L(0); PG8_BAR; PG8_MMA(1, 0, At, B0); PG8_MMA(1, 1, At, B1); PG8_BAR; PG8_SCHED;
            PG8_LDB(B0, 1, 0); PG8_LDB(B1, 1, 1); PG8_SCHED; PG8_LDA(At, 1, 0); PG8_STAGE_A(PG8_SA(0, 1), ka2, ao2[1]);
            PG8_WAIT_V(8); PG8_WAIT_L(0); PG8_BAR; PG8_MMA(0, 0, At, B0); PG8_MMA(0, 1, At, B1); PG8_BAR; PG8_SCHED;
            PG8_LDA(At, 1, 1); PG8_STAGE_B(PG8_SB(1, 0), b3); PG8_STAGE_B(PG8_SB(1, 1), b3 + hstepB); PG8_STAGE_A(PG8_SA(1, 0), ka3, ao2[0]);
            PG8_WAIT_V(8); PG8_WAIT_L(0); PG8_BAR; PG8_MMA(1, 0, At, B0); PG8_MMA(1, 1, At, B1); PG8_BAR; PG8_SCHED;
        }
        if constexpr (ALIGN_EPI) { if (wr == 0) PG8_BAR; }
        if constexpr (FP8) asm volatile("s_nop 15\n\ts_nop 15\n\ts_nop 15" ::: "memory");
        if constexpr (FP8) {
#pragma unroll
            for (int a = 0; a < 2; ++a)
#pragma unroll
                for (int b = 0; b < 2; ++b)
#pragma unroll
                    for (int m = 0; m < 4; ++m)
#pragma unroll
                        for (int n = 0; n < 2; ++n) asm volatile("" : "+v"(acc[a][b][m][n])); }
        E(acc, cur, wr, wc, fr, fq);
        if (!has_next) break;
#pragma unroll
        for (int a = 0; a < 2; ++a)
#pragma unroll
            for (int b = 0; b < 2; ++b)
#pragma unroll
                for (int m = 0; m < 4; ++m)
#pragma unroll
                    for (int n = 0; n < 2; ++n) acc[a][b][m][n] = (f32x4){0.f, 0.f, 0.f, 0.f};
        cur = nxt; cB = nB; ++ui;
#pragma unroll
        for (int h = 0; h < 2; ++h)
#pragma unroll
            for (int i = 0; i < 2; ++i) cao[h][i] = nao[h][i];
        if constexpr (ALIGN_EPI) { if (wr == 1) PG8_BAR; }
    }
    PG8_WAIT_V(0);
    if constexpr (!ALIGN_EPI) { if (wr == 0) PG8_BAR; }
    PG8_BAR;
#undef PG8_SA
#undef PG8_SB
#undef PG8_STAGE_A
#undef PG8_STAGE_B
#undef PG8_LDA
#undef PG8_LDB
#undef PG8_MMA
#undef PG8_CAT8
#undef PG8_WAIT_V
#undef PG8_WAIT_L
#undef PG8_BAR
#undef PG8_SCHED
}
}

namespace attn_body {
typedef float f32x4_t __attribute__((ext_vector_type(4)));

using bf16=__hip_bfloat16;
using bf16x8=__attribute__((ext_vector_type(8)))short;
using s16x4=__attribute__((ext_vector_type(4)))short;
using f32x16=__attribute__((ext_vector_type(16)))float;
using u32x4=__attribute__((ext_vector_type(4)))unsigned;
__device__ __forceinline__ u32x4 kbw_(unsigned long long w){ return (u32x4){(unsigned)w,(unsigned)(w>>32),0u,0u}; }
constexpr int D=64;
constexpr int NW=8,QBLK=32,QB=QBLK*NW,KVBLK=64;
__device__ __forceinline__ int crow(int r,int hi){return (r&3)+8*(r>>2)+4*hi;}
#define SBAR() __builtin_amdgcn_sched_barrier(0)
__device__ __forceinline__ void cmask(f32x16&p0,f32x16&p1,int jb,int qrel,int hi){
  const float NEG=-INFINITY; int kb=64*jb+4*hi;
  #pragma unroll
  for(int r=0;r<16;++r){int kv=kb+(r&3)+8*(r>>2); if(kv>qrel)p0[r]=NEG; if(kv+32>qrel)p1[r]=NEG;}
}

constexpr int NSLOT=3, SLOTB=8192;
constexpr int LDS_K=0, LDS_V=NSLOT*SLOTB, LDS_WS=2*NSLOT*SLOTB, LDS_OST=LDS_WS+NW*64*4, LDS_X=LDS_OST+NW*4096, LDS_BYTES=LDS_X+65536, LDS_BYTES_DV2=LDS_V+2*NSLOT*SLOTB+NW*64*4+NW*8192;
constexpr float C2A=0.125f*1.4426950408889634f;
__device__ __forceinline__ void glds16(const void*gsrc,unsigned lds_dst){unsigned keep;
  asm volatile("s_mov_b32 %0, m0\n\ts_mov_b32 m0, %2\n\ts_nop 0\n\tglobal_load_lds_dwordx4 %1, off\n\ts_mov_b32 m0, %0":"=&s"(keep):"v"(gsrc),"s"(lds_dst):"memory");}
__device__ __forceinline__ float max3f(float a,float b,float c){float r;asm("v_max3_f32 %0, %1, %2, %3":"=v"(r):"v"(a),"v"(b),"v"(c));return r;}
__device__ __forceinline__ float max2f(float a,float b){float r;asm("v_max_f32_e32 %0, %1, %2":"=v"(r):"v"(a),"v"(b));return r;}
__device__ __forceinline__ float fadd_s(float a,float b){float r;asm("v_add_f32_e32 %0, %1, %2":"=v"(r):"v"(a),"v"(b));return r;}
__device__ __forceinline__ float fsub_s(float a,float b){float r;asm("v_sub_f32_e32 %0, %1, %2":"=v"(r):"v"(a),"v"(b));return r;}
typedef float f32x2_t __attribute__((ext_vector_type(2))); typedef __bf16 bf16x2_t __attribute__((ext_vector_type(2)));
__device__ __forceinline__ unsigned cvtpk_s(float lo,float hi){f32x2_t v={lo,hi};bf16x2_t b=__builtin_convertvector(v,bf16x2_t);return __builtin_bit_cast(unsigned,b);}
#define WAIT_BAR(N) asm volatile("s_waitcnt vmcnt(" #N ") lgkmcnt(0)\n\ts_barrier":::"memory")

__device__ __forceinline__ void qkt(f32x16&p0,f32x16&p1,const char*Kslot,const bf16x8*qr,const f32x16&negm,int r32,int hi){
  const char*kb=Kslot+hi*1024+r32*16;
  #pragma unroll
  for(int d0=0;d0<4;++d0){
    const bf16x8 b0=*reinterpret_cast<const bf16x8*>(kb+d0*2048);
    const bf16x8 b1=*reinterpret_cast<const bf16x8*>(kb+d0*2048+512);
    if(d0==0){p0=__builtin_amdgcn_mfma_f32_32x32x16_bf16(b0,qr[0],negm,0,0,0);p1=__builtin_amdgcn_mfma_f32_32x32x16_bf16(b1,qr[0],negm,0,0,0);}
    else{p0=__builtin_amdgcn_mfma_f32_32x32x16_bf16(b0,qr[d0],p0,0,0,0);p1=__builtin_amdgcn_mfma_f32_32x32x16_bf16(b1,qr[d0],p1,0,0,0);}}
}
typedef __attribute__((address_space(3))) const char* lds_cptr;
typedef short v4i16_t __attribute__((ext_vector_type(4)));
__device__ __forceinline__ void kload8(bf16x8*kf,lds_cptr kp){
  kf[0]=*(const __attribute__((address_space(3))) bf16x8*)(kp);      kf[1]=*(const __attribute__((address_space(3))) bf16x8*)(kp+512);
  kf[2]=*(const __attribute__((address_space(3))) bf16x8*)(kp+2048); kf[3]=*(const __attribute__((address_space(3))) bf16x8*)(kp+2560);
  kf[4]=*(const __attribute__((address_space(3))) bf16x8*)(kp+4096); kf[5]=*(const __attribute__((address_space(3))) bf16x8*)(kp+4608);
  kf[6]=*(const __attribute__((address_space(3))) bf16x8*)(kp+6144); kf[7]=*(const __attribute__((address_space(3))) bf16x8*)(kp+6656);
}
__device__ __forceinline__ void kload2(bf16x8*kf,lds_cptr kp,int j){ kf[2*j]=*(const __attribute__((address_space(3))) bf16x8*)(kp+j*2048); kf[2*j+1]=*(const __attribute__((address_space(3))) bf16x8*)(kp+j*2048+512); }
__device__ __forceinline__ s16x4 vtr(lds_cptr p){ return __builtin_bit_cast(s16x4,__builtin_amdgcn_ds_read_tr16_b64_v4i16((__attribute__((address_space(3))) v4i16_t*)p)); }
__device__ __forceinline__ float rowmax(const f32x16&p0,const f32x16&p1){
  float a=max3f(p0[0],p0[1],p1[0]),b=max3f(p0[2],p0[3],p1[1]);a=max3f(a,p1[2],p1[3]);
  #pragma unroll
  for(int r=4;r<16;r+=4){a=max3f(a,p0[r],p0[r+1]);b=max3f(b,p0[r+2],p0[r+3]);a=max3f(a,p1[r],p1[r+1]);b=max3f(b,p1[r+2],p1[r+3]);}
  const float m=max2f(a,b);
  auto rr=__builtin_amdgcn_permlane32_swap(__float_as_uint(m),__float_as_uint(m),false,false);
  return max2f(__uint_as_float(rr[0]),__uint_as_float(rr[1]));
}
__device__ __forceinline__ void pv(f32x16*o,int vb,bf16x8 pa0,bf16x8 pa1,bf16x8 pa2,bf16x8 pa3){
  #pragma unroll
  for(int d0=0;d0<2;++d0){s16x4 lo[4],hi[4];
    #pragma unroll
    for(int ks=0;ks<4;++ks){
      asm volatile("ds_read_b64_tr_b16 %0,%1 offset:%c2":"=&v"(lo[ks]):"v"(vb),"i"(d0*4096+ks*1024):"memory");
      asm volatile("ds_read_b64_tr_b16 %0,%1 offset:%c2":"=&v"(hi[ks]):"v"(vb),"i"(d0*4096+ks*1024+512):"memory");}
    asm volatile("s_waitcnt lgkmcnt(0)":::"memory");SBAR();
    #define PK(k) (bf16x8){lo[k][0],lo[k][1],lo[k][2],lo[k][3],hi[k][0],hi[k][1],hi[k][2],hi[k][3]}
    o[d0]=__builtin_amdgcn_mfma_f32_32x32x16_bf16(pa0,PK(0),o[d0],0,0,0);
    o[d0]=__builtin_amdgcn_mfma_f32_32x32x16_bf16(pa1,PK(1),o[d0],0,0,0);
    o[d0]=__builtin_amdgcn_mfma_f32_32x32x16_bf16(pa2,PK(2),o[d0],0,0,0);
    o[d0]=__builtin_amdgcn_mfma_f32_32x32x16_bf16(pa3,PK(3),o[d0],0,0,0);
    #undef PK
  }
}

#ifndef ATTN_STORE16
#define ATTN_STORE16(p,v) (*(u32x4*)(p)=(v))
#endif
template<int THRL,int MODE,int qp,int kvp,int op,int QBI,bool PRE=false,bool PFN=false,bool DV2=false> __device__ __forceinline__ void attn_unit(const bf16*Qb,const bf16*__restrict__ Kb,const bf16*__restrict__ Vb,bf16*Ob,char*shm,const float*cb,const unsigned long long*maskb,const bf16*Kn=nullptr,const bf16*Vn=nullptr){
  constexpr int q0=QBI*QB;
  constexpr int VSL=DV2?2:1;
  constexpr int L_WS=LDS_V+NSLOT*SLOTB*VSL, L_OST=L_WS+NW*64*4, L_X=L_OST+NW*4096*VSL;
  static_assert(!DV2||MODE==0,"DV2 is for the plain causal mode");
  #define WB(NA,NB) do{ if(DV2){WAIT_BAR(NB);}else{WAIT_BAR(NA);} }while(0)
  int tid_=threadIdx.x; asm volatile("":"+v"(tid_));
  const int tid=tid_,lane=tid&63,r32=lane&31,hi=lane>>5; const int wid=__builtin_amdgcn_readfirstlane(tid>>6);
  const bf16*Qw=Qb+(long)(q0+wid*QBLK)*qp;
  const bf16*Kh=Kb,*Vh=Vb;
  const unsigned lds0=(unsigned)(uintptr_t)shm;
  float*wsf=(float*)(shm+L_WS)+wid*64;
  const lds_cptr shm3=(lds_cptr)shm;
  const bf16*ksrc=Kh+(long)lane*kvp+wid*8;
  const bf16*vsrc=Vh+(long)(16*(wid&3)+(lane>>2))*kvp+(wid>>2)*32+(lane&3)*8;
  const unsigned kdst=lds0+LDS_K+wid*1024, vdst=lds0+LDS_V+wid*1024;
  #define DMA_K(t,slot) glds16(ksrc+(long)(t)*KVBLK*kvp,(unsigned)__builtin_amdgcn_readfirstlane(kdst+(slot)))
  #define DMA_V(t,slot) do{ glds16(vsrc+(long)(t)*KVBLK*kvp,(unsigned)__builtin_amdgcn_readfirstlane(vdst+VSL*(slot))); if(DV2){glds16(vsrc+(long)(t)*KVBLK*kvp+64,(unsigned)__builtin_amdgcn_readfirstlane(vdst+VSL*(slot)+SLOTB));} }while(0)
  const int vb0=(int)(lds0+LDS_V)+((lane>>4)&1)*32+(lane&3)*8+(4*hi+((lane&15)>>2))*64;
  const char*Kbase=shm+LDS_K; bf16x8 kf[8];
  const lds_cptr kp0=shm3+LDS_K+hi*1024+r32*16; const lds_cptr vp0=shm3+LDS_V+((lane>>4)&1)*32+(lane&3)*8+(4*hi+((lane&15)>>2))*64;
  const int NT=(q0+QB)/KVBLK;
  typedef __attribute__((address_space(3))) unsigned long long* lds_u64p;
  const lds_u64p xq=(lds_u64p)(shm3+L_X);
  if(MODE==1){ const int s0=4*tid; if(s0<q0+QB){ const f32x4_t c=*reinterpret_cast<const f32x4_t*>(cb+s0);
      _Pragma("unroll") for(int j=0;j<4;++j){ const float x=-c[j]*1.4426950408889634f; const unsigned p1=cvtpk_s(x,0.f)&0xffffu; const float r1=x-__uint_as_float(p1<<16);
        const unsigned p2=cvtpk_s(r1,0.f)&0xffffu; const float r2=r1-__uint_as_float(p2<<16); const unsigned p3=cvtpk_s(r2,0.f)&0xffffu;
        *(__attribute__((address_space(3))) u32x4*)(shm3+L_X+(s0+j)*16)=(u32x4){p1|(p2<<16),p3|0x3f800000u,0x00003f80u,0u}; } } }
  if(MODE==2){ const int npc=((q0+QB)/KVBLK)*128; for(int i=tid;i<npc;i+=NW*64){ const int tile=i>>7,pc=i&127;
      const u32x4 v=*reinterpret_cast<const u32x4*>(maskb+(long)tile*2048+q0+2*pc); *(__attribute__((address_space(3))) u32x4*)(shm3+L_X+(tile*256+2*pc)*8)=v; } }
  const unsigned himask=hi?0u:~0u;
  bf16x8 qone=__builtin_bit_cast(bf16x8,(u32x4){0x3f803f80u,0x00003f80u,0u,0u});
  if(MODE==1){ const float x=cb[q0+wid*QBLK+r32]*1.4426950408889634f; const unsigned p1=cvtpk_s(x,0.f)&0xffffu; const float r1=x-__uint_as_float(p1<<16);
    const unsigned p2=cvtpk_s(r1,0.f)&0xffffu; const float r2=r1-__uint_as_float(p2<<16); const unsigned p3=cvtpk_s(r2,0.f)&0xffffu;
    qone=__builtin_bit_cast(bf16x8,(u32x4){0x3f803f80u,0x00003f80u|(p1<<16),p2|(p3<<16),0u}); }
  #define KBF(t,half) __builtin_bit_cast(bf16x8,(*(const __attribute__((address_space(3))) u32x4*)(shm3+L_X+((t)*64+(half)*32+r32)*16))&(u32x4){himask,himask,himask,himask})
  #define BIAS(P0,P1,t) do{ if(MODE==1){ P0=__builtin_amdgcn_mfma_f32_32x32x16_bf16(KBF(t,0),qone,P0,0,0,0); P1=__builtin_amdgcn_mfma_f32_32x32x16_bf16(KBF(t,1),qone,P1,0,0,0); } }while(0)
  unsigned mlo=0u,mhi=0u;
  #define MLOAD(t) do{ if(MODE==2){ const unsigned long long mw_=xq[(t)*256+wid*QBLK+r32]>>(4*hi); mlo=(unsigned)mw_; mhi=(unsigned)(mw_>>32); } }while(0)
  #define MBIT(r) (((r)&3)+8*((r)>>2))
  #define EXM(v,r,W) ((MODE==2)?__uint_as_float(__float_as_uint(__builtin_amdgcn_exp2f(v))&(unsigned)__builtin_amdgcn_sbfe((int)(W),MBIT(r),1)):__builtin_amdgcn_exp2f(v))
  if(!PRE){DMA_K(0,0);DMA_V(0,0);DMA_K(1,SLOTB);}
  bf16x8 qr[4];
  #pragma unroll
  for(int d0=0;d0<4;++d0)qr[d0]=*reinterpret_cast<const bf16x8*>(&Qw[(long)r32*qp+d0*16+hi*8]);
  float mhat=0.f,l_reg=0.f;f32x16 o[DV2?4:2];o[0]=f32x16{};o[1]=f32x16{};if(DV2){o[DV2?2:0]=f32x16{};o[DV2?3:1]=f32x16{};}f32x16 negm=f32x16{};asm volatile("":"+v"(negm));
  const int qrel=wid*QBLK+r32;
  #define CMASK(P0,P1,t) do{ if(MODE!=2){int jb_=(t)-(NT-4); if(jb_>=0)cmask(P0,P1,jb_,qrel,hi);} }while(0)
  bool resc=false;
  #define START(P0,P1) do{ const float rm=rowmax(P0,P1); resc=false; \
    { const float dl=rm; mhat=fadd_s(mhat,dl); \
      _Pragma("unroll") for(int r=0;r<16;++r){P0[r]=fsub_s(P0[r],dl);P1[r]=fsub_s(P1[r],dl);} \
      _Pragma("unroll") for(int r=0;r<16;++r)negm[r]=-mhat; asm volatile("":"+v"(negm)); } \
    _Pragma("unroll") for(int r=0;r<16;++r)P0[r]=EXM(P0[r],r,mlo); }while(0)
  #define RESC() do{ if(resc){ asm volatile("s_waitcnt lgkmcnt(0)":::"memory"); \
      _Pragma("unroll") for(int d_=0;d_<(DV2?4:2);++d_) _Pragma("unroll") for(int r=0;r<16;++r)o[d_][r]*=wsf[crow(r,hi)]; } }while(0)
  f32x16 pA0,pA1,pB0,pB1;
  int sl_prev=0,sl_cur=0,sl_next=SLOTB;
  #define ROT() do{sl_prev=sl_cur;sl_cur=sl_next;sl_next=(sl_next==(NSLOT-1)*SLOTB)?0:sl_next+SLOTB;}while(0)
  if(!PRE){DMA_K(2,2*SLOTB);}
  WB(3,4);
  qkt(pA0,pA1,Kbase,qr,negm,r32,hi);BIAS(pA0,pA1,0);asm volatile("s_nop 15\n\ts_nop 7":"+v"(pA0),"+v"(pA1));CMASK(pA0,pA1,0);MLOAD(0);
  START(pA0,pA1);
  _Pragma("unroll") for(int r=0;r<16;++r)pA1[r]=EXM(pA1[r],r,mhi);
  WAIT_BAR(0);
  DMA_K(3,0);DMA_V(1,SLOTB);
  ROT();
  kload8(kf,kp0+sl_cur);
  WB(2,3);
  s16x4 vlo[8],vhi[8]; u32x4 pw0,pw1,pw2,pw3;
  #define PKW(P,B) cvtpk_s(P[B],P[B+1])
  #define PAF(k) __builtin_bit_cast(bf16x8,pw##k)
  #define VFR(i) (bf16x8){vlo[i][0],vlo[i][1],vlo[i][2],vlo[i][3],vhi[i][0],vhi[i][1],vhi[i][2],vhi[i][3]}
  #define PIN(x) asm volatile("":"+v"(x))
  #define MX3(a,b,c) __builtin_fmaxf(__builtin_fmaxf((a),(b)),(c))
  #define GAPA(MF,A0,A1,A2,A3,W0,W1,PW) do{ MF; sacc+=A0; sacc+=A1; sacc+=A2; sacc+=A3; PIN(sacc); W0; W1; PIN(PW); SBAR(); }while(0)
  #define EX(v) __builtin_amdgcn_exp2f(v)
  #define GAPB(MF,X,B,W) do{ MF; X[B]=EXM(X[B],B,W); X[B+1]=EXM(X[B+1],B+1,W); X[B+2]=EXM(X[B+2],B+2,W); X[B+3]=EXM(X[B+3],B+3,W); PIN(X); SBAR(); }while(0)
  #define VRD(i) do{ vlo[i]=vtr(vp_+(((i)>>2)*4096+((i)&3)*1024)); vhi[i]=vtr(vp_+(((i)>>2)*4096+((i)&3)*1024+512)); }while(0)
  #define VRD2(i) do{ vlo[i]=vtr(vp_+(8192+((i)>>2)*4096+((i)&3)*1024)); vhi[i]=vtr(vp_+(8192+((i)>>2)*4096+((i)&3)*1024+512)); }while(0)
  #define KRD(G,j) do{ if(G){ kload2(kf,kp0+sl_next,j); SBAR(); } }while(0)
  #define STEP(C0,C1,P0,P1,t,GK,GV,GL) do{ SBAR(); \
    const lds_cptr vp_=vp0+VSL*sl_prev; \
    VRD(0); SBAR(); float sacc=(P0[0]+P0[1]); \
    GAPA(C0=__builtin_amdgcn_mfma_f32_32x32x16_bf16(kf[0],qr[0],negm,0,0,0), P0[2],P0[3],P0[4],P0[5],     pw0[0]=PKW(P0,0), pw0[1]=PKW(P0,2), pw0); \
    VRD(4); SBAR(); GAPA(C1=__builtin_amdgcn_mfma_f32_32x32x16_bf16(kf[1],qr[0],negm,0,0,0), P0[6],P0[7],P0[8],P0[9],     pw0[2]=PKW(P0,4), pw0[3]=PKW(P0,6), pw0); \
    VRD(1); SBAR(); GAPA(C0=__builtin_amdgcn_mfma_f32_32x32x16_bf16(kf[2],qr[1],C0,0,0,0),   P0[10],P0[11],P0[12],P0[13], pw1[0]=PKW(P0,8), pw1[1]=PKW(P0,10), pw1); \
    VRD(5); SBAR(); GAPA(C1=__builtin_amdgcn_mfma_f32_32x32x16_bf16(kf[3],qr[1],C1,0,0,0),   P0[14],P0[15],P1[0],P1[1],   pw1[2]=PKW(P0,12),pw1[3]=PKW(P0,14), pw1); \
    VRD(2); SBAR(); GAPA(C0=__builtin_amdgcn_mfma_f32_32x32x16_bf16(kf[4],qr[2],C0,0,0,0),   P1[2],P1[3],P1[4],P1[5],     pw2[0]=PKW(P1,0), pw2[1]=PKW(P1,2), pw2); \
    VRD(6); SBAR(); GAPA(C1=__builtin_amdgcn_mfma_f32_32x32x16_bf16(kf[5],qr[2],C1,0,0,0),   P1[6],P1[7],P1[8],P1[9],     pw2[2]=PKW(P1,4), pw2[3]=PKW(P1,6), pw2); \
    VRD(3); SBAR(); GAPA(C0=__builtin_amdgcn_mfma_f32_32x32x16_bf16(kf[6],qr[3],C0,0,0,0),   P1[10],P1[11],P1[12],P1[13], pw3[0]=PKW(P1,8), pw3[1]=PKW(P1,10), pw3); \
    VRD(7); SBAR(); GAPA(C1=__builtin_amdgcn_mfma_f32_32x32x16_bf16(kf[7],qr[3],C1,0,0,0),   P1[14],P1[15],0.f,0.f,       pw3[2]=PKW(P1,12),pw3[3]=PKW(P1,14), pw3); \
    l_reg+=sacc; BIAS(C0,C1,t); MLOAD(t); \
    if(GK){DMA_K((t)+3,sl_cur);} if(GV){DMA_V((t)+1,sl_next);} \
    CMASK(C0,C1,t); \
    { float a=MX3(C0[0],C0[1],C1[0]),b=MX3(C0[2],C0[3],C1[1]); a=MX3(a,C1[2],C1[3]); \
      _Pragma("unroll") for(int r=4;r<16;r+=4){a=MX3(a,C0[r],C0[r+1]);b=MX3(b,C0[r+2],C0[r+3]);a=MX3(a,C1[r],C1[r+1]);b=MX3(b,C1[r+2],C1[r+3]);} \
      float rm=__builtin_fmaxf(a,b); { auto rr=__builtin_amdgcn_permlane32_swap(__float_as_uint(rm),__float_as_uint(rm),false,false); rm=__builtin_fmaxf(__uint_as_float(rr[0]),__uint_as_float(rr[1])); } \
      resc=false; \
      if(__builtin_expect(__any(rm>(float)THRL),0)){ const float dl=__builtin_fmaxf(rm,0.f); mhat+=dl; \
        _Pragma("unroll") for(int r=0;r<16;++r){C0[r]-=dl;C1[r]-=dl;} \
        _Pragma("unroll") for(int r=0;r<16;++r)negm[r]=-mhat; asm volatile("":"+v"(negm)); \
        const float f=__builtin_amdgcn_exp2f(-dl); l_reg*=f; if(hi==0)wsf[r32]=f; resc=true; } } \
    SBAR(); \
    GAPB(o[0]=__builtin_amdgcn_mfma_f32_32x32x16_bf16(PAF(0),VFR(0),o[0],0,0,0), C0,0,mlo); \
    GAPB(o[1]=__builtin_amdgcn_mfma_f32_32x32x16_bf16(PAF(0),VFR(4),o[1],0,0,0), C0,4,mlo); \
    KRD(GL,0); GAPB(o[0]=__builtin_amdgcn_mfma_f32_32x32x16_bf16(PAF(1),VFR(1),o[0],0,0,0), C0,8,mlo); \
    KRD(GL,1); GAPB(o[1]=__builtin_amdgcn_mfma_f32_32x32x16_bf16(PAF(1),VFR(5),o[1],0,0,0), C0,12,mlo); \
    KRD(GL,2); GAPB(o[0]=__builtin_amdgcn_mfma_f32_32x32x16_bf16(PAF(2),VFR(2),o[0],0,0,0), C1,0,mhi); \
    KRD(GL,3); GAPB(o[1]=__builtin_amdgcn_mfma_f32_32x32x16_bf16(PAF(2),VFR(6),o[1],0,0,0), C1,4,mhi); \
    GAPB(o[0]=__builtin_amdgcn_mfma_f32_32x32x16_bf16(PAF(3),VFR(3),o[0],0,0,0), C1,8,mhi); \
    GAPB(o[1]=__builtin_amdgcn_mfma_f32_32x32x16_bf16(PAF(3),VFR(7),o[1],0,0,0), C1,12,mhi); \
    if(DV2){ VRD2(0);VRD2(4);VRD2(1);VRD2(5);VRD2(2);VRD2(6);VRD2(3);VRD2(7); SBAR(); \
      o[DV2?2:0]=__builtin_amdgcn_mfma_f32_32x32x16_bf16(PAF(0),VFR(0),o[DV2?2:0],0,0,0); o[DV2?3:1]=__builtin_amdgcn_mfma_f32_32x32x16_bf16(PAF(0),VFR(4),o[DV2?3:1],0,0,0); \
      o[DV2?2:0]=__builtin_amdgcn_mfma_f32_32x32x16_bf16(PAF(1),VFR(1),o[DV2?2:0],0,0,0); o[DV2?3:1]=__builtin_amdgcn_mfma_f32_32x32x16_bf16(PAF(1),VFR(5),o[DV2?3:1],0,0,0); \
      o[DV2?2:0]=__builtin_amdgcn_mfma_f32_32x32x16_bf16(PAF(2),VFR(2),o[DV2?2:0],0,0,0); o[DV2?3:1]=__builtin_amdgcn_mfma_f32_32x32x16_bf16(PAF(2),VFR(6),o[DV2?3:1],0,0,0); \
      o[DV2?2:0]=__builtin_amdgcn_mfma_f32_32x32x16_bf16(PAF(3),VFR(3),o[DV2?2:0],0,0,0); o[DV2?3:1]=__builtin_amdgcn_mfma_f32_32x32x16_bf16(PAF(3),VFR(7),o[DV2?3:1],0,0,0); SBAR(); } \
    }while(0)
  int t=1;
  #undef CMASK
  #define CMASK(P0,P1,t) do{}while(0)
  for(;t+5<NT;t+=2){
    STEP(pB0,pB1,pA0,pA1,t,true,true,true);     WB(2,3); RESC(); ROT();
    STEP(pA0,pA1,pB0,pB1,t+1,true,true,true);   WB(2,3); RESC(); ROT();
  }
  #undef CMASK
  #define CMASK(P0,P1,t) do{ if(MODE!=2){int jb_=(t)-(NT-4); if(jb_>=0)cmask(P0,P1,jb_,qrel,hi);} }while(0)
  #define ENDW(tt) do{ if((tt)+3<NT){WB(2,3);} else if((tt)+2<NT){WB(1,2);} else {WAIT_BAR(0);} }while(0)
  for(;t+1<NT;t+=2){
    STEP(pB0,pB1,pA0,pA1,t,(t+3<NT),(t+1<NT),(t+1<NT));       ENDW(t);   RESC(); ROT();
    STEP(pA0,pA1,pB0,pB1,t+1,(t+4<NT),(t+2<NT),(t+2<NT));     ENDW(t+1); RESC(); ROT();
  }
  STEP(pB0,pB1,pA0,pA1,NT-1,false,false,false); RESC();
  { float sacc=pB0[0]+pB0[1]; _Pragma("unroll") for(int r=2;r<16;++r)sacc+=pB0[r]; _Pragma("unroll") for(int r=0;r<16;++r)sacc+=pB1[r]; l_reg+=sacc;
    pw0=(u32x4){PKW(pB0,0),PKW(pB0,2),PKW(pB0,4),PKW(pB0,6)};pw1=(u32x4){PKW(pB0,8),PKW(pB0,10),PKW(pB0,12),PKW(pB0,14)};pw2=(u32x4){PKW(pB1,0),PKW(pB1,2),PKW(pB1,4),PKW(pB1,6)};pw3=(u32x4){PKW(pB1,8),PKW(pB1,10),PKW(pB1,12),PKW(pB1,14)};
    SBAR(); pv(o,vb0+VSL*sl_cur,PAF(0),PAF(1),PAF(2),PAF(3)); if(DV2){ SBAR(); pv(o+(DV2?2:0),vb0+VSL*sl_cur+SLOTB,PAF(0),PAF(1),PAF(2),PAF(3)); } }
  #undef PKW
  #undef PAF
  #undef VFR
  #undef PIN
  #undef MX3
  #undef GAPA
  #undef GAPB
  #undef EX
  #undef VRD
  #undef KRD
  #undef STEP
  #undef ENDW
  if(PFN){ asm volatile("s_waitcnt lgkmcnt(0)\n\ts_barrier":::"memory");
    const bf16*nks=Kn+(long)lane*kvp+wid*8; const bf16*nvs=Vn+(long)(16*(wid&3)+(lane>>2))*kvp+(wid>>2)*32+(lane&3)*8;
    glds16(nks,(unsigned)__builtin_amdgcn_readfirstlane(kdst)); glds16(nvs,(unsigned)__builtin_amdgcn_readfirstlane(vdst)); if(DV2){glds16(nvs+64,(unsigned)__builtin_amdgcn_readfirstlane(vdst+SLOTB));} glds16(nks+(long)KVBLK*kvp,(unsigned)__builtin_amdgcn_readfirstlane(kdst+SLOTB)); glds16(nks+(long)2*KVBLK*kvp,(unsigned)__builtin_amdgcn_readfirstlane(kdst+2*SLOTB)); }
  {auto rr=__builtin_amdgcn_permlane32_swap(__float_as_uint(l_reg),__float_as_uint(l_reg),false,false);l_reg=__uint_as_float(rr[0])+__uint_as_float(rr[1]);}
  if(hi==0)wsf[32+r32]=l_reg;asm volatile("s_waitcnt lgkmcnt(0)":::"memory");
  float rli[16];
  #pragma unroll
  for(int r=0;r<16;++r)rli[r]=__builtin_amdgcn_rcpf(wsf[32+crow(r,hi)]);
  bf16*Ow=Ob+(long)(q0+wid*QBLK)*op;
  { constexpr int OW=DV2?128:64; bf16*stg=(bf16*)(shm+L_OST)+wid*2048*VSL;
    #pragma unroll
    for(int r=0;r<16;++r){const int orow=crow(r,hi);
      #pragma unroll
      for(int d0=0;d0<(DV2?4:2);++d0)stg[orow*OW+d0*32+r32]=__float2bfloat16(o[d0][r]*rli[r]);}
    asm volatile("s_waitcnt lgkmcnt(0)":::"memory");
    #pragma unroll
    for(int i=0;i<4*VSL;++i){const int row=DV2?i*4+(lane>>4):i*8+(lane>>3),ch=DV2?(lane&15):(lane&7); const u32x4 v=*(const u32x4*)(stg+row*OW+ch*8); ATTN_STORE16(Ow+(long)row*op+ch*8,v);} }
  if(!PFN){ asm volatile("s_waitcnt lgkmcnt(0)\n\ts_barrier":::"memory"); }
  #undef KBF
  #undef BIAS
  #undef MLOAD
  #undef MBIT
  #undef EXM
  #undef DMA_K
  #undef DMA_V
  #undef WB
  #undef VRD2
  #undef CMASK
  #undef START
  #undef RESC
  #undef ROT
}
#undef SBAR
#undef WAIT_BAR
}

#define XB_TMO      128
#define XB_XCNT(j)  (256  + 64 * (j))
#define XB_XSUB(j)  (1280 + 64 * (j))
#define XB_XGEN(j)  (2304 + 64 * (j))
#define XB_TOP      3328
#define XB_TOPGEN   3392
#define XCD_BAR_WORDS 3456
#define XB_SPIN_CAP (1u << 18)
__device__ __forceinline__ unsigned xb_ld(unsigned* p)              { return __hip_atomic_load(p, __ATOMIC_RELAXED, __HIP_MEMORY_SCOPE_AGENT); }
__device__ __forceinline__ unsigned xb_add(unsigned* p, unsigned v) { return __hip_atomic_fetch_add(p, v, __ATOMIC_RELAXED, __HIP_MEMORY_SCOPE_AGENT); }
__device__ __forceinline__ unsigned xb_xcc_id() { return (unsigned)__builtin_amdgcn_s_getreg((3 << 11) | 20) & 0xFu; }
#define XB_SPIN(cond, bar) do { unsigned _sp = 0; while (cond) { __builtin_amdgcn_s_sleep(1); \
    if ((++_sp & 255u) == 0u) { if (xb_ld(&(bar)[XB_TMO])) break; if (_sp > XB_SPIN_CAP) { atomicAdd(&(bar)[XB_TMO], 1u); break; } } } } while (0)
struct XcdBarrier { unsigned* bar; unsigned x; volatile LAS unsigned* st; };
__device__ __forceinline__ XcdBarrier xcd_barrier_post(unsigned* bar, volatile LAS unsigned* st) {
    XcdBarrier b; b.bar = bar; b.x = xb_xcc_id(); b.st = st;
    if (threadIdx.x == 0) (void)xb_add(&bar[XB_XCNT(b.x)], 1u);
    return b;
}
__device__ __forceinline__ void xcd_barrier_complete(unsigned* bar, unsigned x, unsigned& nloc, unsigned& nx) {
    const unsigned G = gridDim.x * gridDim.y * gridDim.z;
    unsigned sum, cnt, mine, sp = 0u;
    for (;;) {
        sum = 0u; cnt = 0u; mine = 0u;
#pragma unroll
        for (unsigned j = 0; j < 16; ++j) { const unsigned c = xb_ld(&bar[XB_XCNT(j)]); sum += c; cnt += (c > 0u) ? 1u : 0u; mine = (j == x) ? c : mine; }
        if (sum == G) break;
        __builtin_amdgcn_s_sleep(1);
        if ((++sp & 255u) == 0u) { if (xb_ld(&bar[XB_TMO])) break; if (sp > XB_SPIN_CAP) { atomicAdd(&bar[XB_TMO], 1u); break; } }
    }
    nloc = mine > 0u ? mine : 1u; nx = cnt > 0u ? cnt : 1u;
}
__device__ __forceinline__ void xcd_barrier(const XcdBarrier& b) {
    asm volatile("s_waitcnt vmcnt(0)" ::: "memory");
    __syncthreads();
    if (threadIdx.x == 0) {
        unsigned* bar = b.bar;
        __builtin_amdgcn_s_waitcnt(0);
        unsigned nloc = b.st[0], nx = b.st[1];
        if (nloc == 0u) { xcd_barrier_complete(bar, b.x, nloc, nx); b.st[0] = nloc; b.st[1] = nx; }
        const unsigned old = xb_add(&bar[XB_XSUB(b.x)], 1u);
        const unsigned gen = old / nloc;
        if (old + 1u == (gen + 1u) * nloc) {
            __builtin_amdgcn_fence(__ATOMIC_RELEASE, "agent");
            asm volatile("s_waitcnt vmcnt(0)" ::: "memory");
            const unsigned og = xb_add(&bar[XB_TOP], 1u);
            const unsigned tg = og / nx;
            if (og + 1u == (tg + 1u) * nx) xb_add(&bar[XB_TOPGEN], 1u);
            else XB_SPIN(xb_ld(&bar[XB_TOPGEN]) == tg, bar);
            __builtin_amdgcn_fence(__ATOMIC_ACQUIRE, "agent");
            xb_add(&bar[XB_XGEN(b.x)], 1u);
            asm volatile("s_waitcnt vmcnt(0)" ::: "memory");
        } else {
            XB_SPIN(xb_ld(&bar[XB_XGEN(b.x)]) == gen, bar);
            __builtin_amdgcn_fence(__ATOMIC_ACQUIRE, "agent");
            asm volatile("s_waitcnt vmcnt(0)" ::: "memory");
        }
    }
    __syncthreads();
}

struct Frame {
    LAS unsigned char* lds;
    unsigned* ctl;
    int tid, lane, wave, vcu, G;
    const float* const* inp; float* out; unsigned char* ws;
};
enum { I_X = 0, I_LN_MIX_E, I_W_IN_E, I_B_FOX, I_W_OUT_E, I_LN_FFN_E, I_W_GATE, I_W_UP, I_W_DOWN, I_LN_MIX_O, I_W_IN_O, I_LB, I_HGRN_G, I_LAM, I_DIFF_G, I_W_OUT_O, I_LN_FFN_O, I_W_ROUTER, I_WE_GATE, I_WE_UP, I_WE_DOWN, I_LN_FINAL };

__device__ __forceinline__ int dim_of_pos(int p) { return (p >> 1) + 32 * (p & 1); }
__device__ __forceinline__ int srccol_in0(int j) {
    if (j < 512) return j;
    if (j < 1024) { const int o = j - 512; return 1544 + (o & ~63) + dim_of_pos(o & 63); }
    if (j < 1536) return 512 + (j - 1024);
    if (j < 2048) return 1024 + (j - 1536);
    if (j < 2176) { const int o = j - 2048; return 2056 + (o & ~63) + dim_of_pos(o & 63); }
    if (j < 2304) return 2184 + (j - 2176);
    if (j < 2560) { const int o = j - 2304; return 2312 + (o & ~63) + dim_of_pos(o & 63); }
    if (j < 2624) { const int o = j - 2560; return 2568 + dim_of_pos(o); }
    if (j < 2632) return 1536 + (j - 2624);
    if (j < 2636) return 2632 + (j - 2632);
    return -1;
}
__device__ __forceinline__ int srccol_in1(int j) {
    if (j < 512) return j;
    if (j < 1024) { const int o = j - 512; return 2048 + (o & ~63) + dim_of_pos(o & 63); }
    if (j < 1536) return 512 + (j - 1024);
    if (j < 2048) return 1024 + (j - 1536);
    if (j < 2560) return 1536 + (j - 2048);
    if (j < 3072) { const int o = j - 2560; return 2560 + (o & ~63) + dim_of_pos(o & 63); }
    return 3072 + (j - 3072);
}
__device__ __forceinline__ void p0_item(const float* W, int Nsrc, int sc, const float* gain, bf16_t* WT, int K, int n0, int k0, LAS float* scr, int lane) {
    const float gk = gain ? gain[k0 + lane] : 1.0f;
    const float* src = W + (size_t)k0 * Nsrc + (sc >= 0 ? sc : 0);
#pragma unroll 16
    for (int kk = 0; kk < 64; ++kk) { const float gkk = __shfl(gk, kk); float v = src[(size_t)kk * Nsrc] * gkk; v = (sc >= 0) ? v : 0.f; scr[kk * 65 + lane] = v; }
    LDS_WAIT(); asm volatile("" ::: "memory");
    const int c = lane & 7;
#pragma unroll
    for (int j = 0; j < 8; ++j) { const int n = (lane >> 3) + 8 * j; const LAS float* s = scr + (8 * c) * 65 + n;
        u32x4 o; o.x = cvt_pk_bf16(s[0 * 65], s[1 * 65]); o.y = cvt_pk_bf16(s[2 * 65], s[3 * 65]); o.z = cvt_pk_bf16(s[4 * 65], s[5 * 65]); o.w = cvt_pk_bf16(s[6 * 65], s[7 * 65]);
        *(u32x4*)(WT + (size_t)(n0 + n) * K + k0 + 8 * c) = o; }
    LDS_WAIT(); asm volatile("" ::: "memory");
}
__device__ __forceinline__ void p0_item8(const float* W, int Nsrc, int sc, const float* gain, unsigned char* WT, int K, int n0, int k0, LAS float* scr, int lane) {
    const float gk = (gain ? gain[k0 + lane] : 1.0f) * SW8;
    const float* src = W + (size_t)k0 * Nsrc + sc;
#pragma unroll 16
    for (int kk = 0; kk < 64; ++kk) { const float gkk = __shfl(gk, kk); scr[kk * 65 + lane] = src[(size_t)kk * Nsrc] * gkk; }
    LDS_WAIT(); asm volatile("" ::: "memory");
    const int c = lane & 7;
#pragma unroll
    for (int j = 0; j < 8; ++j) { const int n = (lane >> 3) + 8 * j; const LAS float* s = scr + (8 * c) * 65 + n;
        int p0 = __builtin_amdgcn_cvt_pk_fp8_f32(s[0 * 65], s[1 * 65], 0, false); p0 = __builtin_amdgcn_cvt_pk_fp8_f32(s[2 * 65], s[3 * 65], p0, true);
        int p1 = __builtin_amdgcn_cvt_pk_fp8_f32(s[4 * 65], s[5 * 65], 0, false); p1 = __builtin_amdgcn_cvt_pk_fp8_f32(s[6 * 65], s[7 * 65], p1, true);
        *(u32x2*)(WT + (size_t)(n0 + n) * K + k0 + 8 * c) = (u32x2){(unsigned)p0, (unsigned)p1}; }
    LDS_WAIT(); asm volatile("" ::: "memory");
}
__device__ __forceinline__ void p0_prologue(Frame& F) {
    LAS float* scr = (LAS float*)(F.lds + F.wave * 16640);
    const int gw = F.vcu * NWAVES + F.wave, NGW = F.G * NWAVES, lane = F.lane;
    unsigned char* ws = F.ws;
    constexpr int I0 = 16 * 44, I1 = 16 * 16, I2 = 16 * 88, I3 = 44 * 16, I4 = 16 * 56, I5 = 16 * 16, I6 = 8 * 16 * 112, I7 = 8 * 56 * 16;
    constexpr int NITEMS = I0 + I1 + I2 + I3 + I4 + I5 + I6 + I7;
    for (int it = gw; it < NITEMS; it += NGW) {
        int r = it;
        if (r < I0) { const int kb = r / 44, nb = r % 44; const int j = nb * 64 + lane; p0_item(F.inp[I_W_IN_E], N0SRC, srccol_in0(j), F.inp[I_LN_MIX_E], (bf16_t*)(ws + WS_WIN0), DM, nb * 64, kb * 64, scr, lane); continue; } r -= I0;
        if (r < I1) { const int kb = r / 16, nb = r % 16; p0_item(F.inp[I_W_OUT_E], DM, nb * 64 + lane, nullptr, (bf16_t*)(ws + WS_WOUT0), DM, nb * 64, kb * 64, scr, lane); continue; } r -= I1;
        if (r < I2) { const int kb = r / 88, nb = r % 88; const int j = nb * 64, pn = j >> 8, rr = j & 255; const float* W = (rr < 128) ? F.inp[I_W_GATE] : F.inp[I_W_UP];
            if (FFN_GU8) p0_item8(W, FF, pn * 128 + (rr & 127) + lane, F.inp[I_LN_FFN_E], (unsigned char*)(ws + WS_WGU0), DM, j, kb * 64, scr, lane); else
            p0_item(W, FF, pn * 128 + (rr & 127) + lane, F.inp[I_LN_FFN_E], (bf16_t*)(ws + WS_WGU0), DM, j, kb * 64, scr, lane); continue; } r -= I2;
        if (r < I3) { const int kb = r / 16, nb = r % 16; if (FFN_DN8) p0_item8(F.inp[I_W_DOWN], DM, nb * 64 + lane, nullptr, (unsigned char*)(ws + WS_WDN0), FF, nb * 64, kb * 64, scr, lane); else p0_item(F.inp[I_W_DOWN], DM, nb * 64 + lane, nullptr, (bf16_t*)(ws + WS_WDN0), FF, nb * 64, kb * 64, scr, lane); continue; } r -= I3;
        if (r < I4) { const int kb = r / 56, nb = r % 56; const int j = nb * 64 + lane; p0_item(F.inp[I_W_IN_O], N1, srccol_in1(j), F.inp[I_LN_MIX_O], (bf16_t*)(ws + WS_WIN1), DM, nb * 64, kb * 64, scr, lane); continue; } r -= I4;
        if (r < I5) { const int kb = r / 16, nb = r % 16; p0_item(F.inp[I_W_OUT_O], DM, nb * 64 + lane, nullptr, (bf16_t*)(ws + WS_WOUT1), DM, nb * 64, kb * 64, scr, lane); continue; } r -= I5;
        if (r < I6) { const int e = r / (16 * 112), q = r % (16 * 112), kb = q / 112, nb = q % 112; const int j = nb * 64, pn = j >> 8, rr = j & 255;
            const float* W = ((rr < 128) ? F.inp[I_WE_GATE] : F.inp[I_WE_UP]) + (size_t)e * DM * FFE;
            p0_item8(W, FFE, pn * 128 + (rr & 127) + lane, F.inp[I_LN_FFN_O], (unsigned char*)(ws + WS_WEGU) + (size_t)e * 7168 * DM, DM, j, kb * 64, scr, lane); continue; } r -= I6;
        { const int e = r / (56 * 16), q = r % (56 * 16), kb = q / 16, nb = q % 16;
            p0_item8(F.inp[I_WE_DOWN] + (size_t)e * FFE * DM, DM, nb * 64 + lane, nullptr, (unsigned char*)(ws + WS_WEDN) + (size_t)e * DM * FFE, FFE, nb * 64, kb * 64, scr, lane); }
    }
    { bf16_t* XB = (bf16_t*)(ws + WS_XB); float* SS = (float*)(ws + WS_SS);
      for (int m = gw; m < MTOK; m += NGW) {
        const f32x4* xr = (const f32x4*)(F.inp[I_X] + (size_t)m * DM) + lane; float s = 0.f; f32x4 v[4];
#pragma unroll
        for (int j = 0; j < 4; ++j) { v[j] = xr[64 * j]; s += (v[j][0] * v[j][0] + v[j][1] * v[j][1]) + (v[j][2] * v[j][2] + v[j][3] * v[j][3]); }
        s = wave_sum(s);
        u32x2* o = (u32x2*)(XB + (size_t)m * DM) + lane;
#pragma unroll
        for (int j = 0; j < 4; ++j) { u32x2 w; w.x = cvt_pk_bf16(v[j][0], v[j][1]); w.y = cvt_pk_bf16(v[j][2], v[j][3]); o[64 * j] = w; }
        if (lane < 16) SS[(size_t)m * 16 + lane] = (lane == 0) ? s : 0.f;
      } }
    { float* rope = (float*)(ws + WS_ROPE); const int gt = gw * 64 + lane, NT = NGW * 64;
      for (int i = gt; i < SEQ * 32; i += NT) { const int t = i >> 5, p = i & 31; const float inv = powf(10000.0f, -(float)p * 2.0f / 64.0f); const float ang = (float)t * inv;
          rope[2 * i] = cosf(ang); rope[2 * i + 1] = sinf(ang); }
      float* wrt = (float*)(ws + WS_WRT);
      for (int i = gt; i < 8 * DM; i += NT) { const int e = i >> 10, k = i & 1023; wrt[i] = F.inp[I_W_ROUTER][k * 8 + e] * F.inp[I_LN_FFN_O][k]; } }
}

__device__ __forceinline__ void fox_cumsum_unit(Frame& F, int bh) {
    const float* LOGF = (const float*)(F.ws + WS_LOGF); float* CB = (float*)(F.ws + WS_CB);
    LAS float* wt = (LAS float*)(F.lds);
    const int b = bh >> 3, h = bh & 7, tid = F.tid;
    float v[4]; float run = 0.f;
#pragma unroll
    for (int j = 0; j < 4; ++j) { v[j] = LOGF[((size_t)b * SEQ + 4 * tid + j) * 8 + h]; run += v[j]; v[j] = run; }
    float incl = run;
#pragma unroll
    for (int o = 1; o < 64; o <<= 1) { const float t = __shfl_up(incl, o); if (F.lane >= o) incl += t; }
    if (F.lane == 63) wt[F.wave] = incl;
    __syncthreads();
    float woff = 0.f;
    for (int w = 0; w < F.wave; ++w) woff += wt[w];
    const float base = woff + incl - run;
    f32x4 o = (f32x4){base + v[0], base + v[1], base + v[2], base + v[3]};
    *(f32x4*)(CB + (size_t)bh * SEQ + 4 * tid) = o;
    __syncthreads();
    { const bf16_t* QKV = (const bf16_t*)(F.ws + WS_BIG); float qm = 0.f, km = 0.f;
#pragma unroll 1
      for (int j = 0; j < 4; ++j) { const bf16_t* rp = QKV + ((size_t)b * SEQ + 4 * tid + j) * N0; float qs = 0.f, ks = 0.f;
#pragma unroll
          for (int cch = 0; cch < 8; ++cch) { const u32x4 wq = *(const u32x4*)(rp + C0_FQ + h * 64 + 8 * cch), wk = *(const u32x4*)(rp + C0_FK + h * 64 + 8 * cch);
              const unsigned qa[4] = {wq.x, wq.y, wq.z, wq.w}, ka[4] = {wk.x, wk.y, wk.z, wk.w};
#pragma unroll
              for (int e = 0; e < 4; ++e) { qs += bf_lo(qa[e]) * bf_lo(qa[e]) + bf_hi(qa[e]) * bf_hi(qa[e]); ks += bf_lo(ka[e]) * bf_lo(ka[e]) + bf_hi(ka[e]) * bf_hi(ka[e]); } }
          qm = fmaxf(qm, qs); km = fmaxf(km, ks); }
      qm = wave_max(qm); km = wave_max(km);
      if (F.lane == 0) { wt[16 + F.wave] = qm; wt[32 + F.wave] = km; }
      __syncthreads();
      if (tid == 0) { float a = 0.f, bb = 0.f; for (int w = 0; w < 8; ++w) { a = fmaxf(a, wt[16 + w]); bb = fmaxf(bb, wt[32 + w]); }
          ((float*)(F.ws + WS_FQK))[bh] = 2.0f * sqrtf(a) * sqrtf(bb) * 1.001f; }
      __syncthreads(); }
}
constexpr int SCP = 2052;
template <int NT>
__device__ __forceinline__ void select_row(const LAS float* Srow, int t, int nkeys, int lane, u64* mout) {
    int mlo = 0, mhi = 0;
    if (t + 1 <= 256) {
        const int r = t - lane * 64; const u64 w = (r >= 63) ? ~0ull : (r < 0 ? 0ull : ((2ull << r) - 1ull));
        mlo = (int)(unsigned)w; mhi = (int)(unsigned)(w >> 32);
    } else {
        float sc[NT];
#pragma unroll
        for (int i = 0; i < NT; ++i) { const int s_ = i * 64 + lane; sc[i] = Srow[s_ < nkeys ? s_ : nkeys - 1]; }
#pragma unroll
        for (int i = 0; i < NT; ++i) asm volatile("" : "+v"(sc[i]));
#pragma unroll
        for (int i = 0; i < NT; ++i) sc[i] = (i * 64 + lane <= t) ? sc[i] + 0.0f : -INFINITY;
#define CNT_OP(OPC, TH, OUT) do { int c_ = 0; const float th_ = (TH); _Pragma("unroll") for (int i_ = 0; i_ < NT; i_ += 4) { u64 t0_, t1_, t2_, t3_; \
            asm volatile("v_cmp_" OPC "_f32 %1, %5, %9\n\tv_cmp_" OPC "_f32 %2, %6, %9\n\tv_cmp_" OPC "_f32 %3, %7, %9\n\tv_cmp_" OPC "_f32 %4, %8, %9\n\t" \
                         "v_addc_co_u32 %0, vcc, 0, %0, %1\n\tv_addc_co_u32 %0, vcc, 0, %0, %2\n\tv_addc_co_u32 %0, vcc, 0, %0, %3\n\tv_addc_co_u32 %0, vcc, 0, %0, %4" \
                         : "+v"(c_), "=&s"(t0_), "=&s"(t1_), "=&s"(t2_), "=&s"(t3_) : "v"(sc[i_]), "v"(sc[i_ + 1]), "v"(sc[i_ + 2]), "v"(sc[i_ + 3]), "v"(th_) : "vcc"); } \
            c_ += __builtin_amdgcn_update_dpp(0, c_, 0xB1, 0xF, 0xF, true); c_ += __builtin_amdgcn_update_dpp(0, c_, 0x4E, 0xF, 0xF, true); \
            c_ += __builtin_amdgcn_update_dpp(0, c_, 0x141, 0xF, 0xF, true); c_ += __builtin_amdgcn_update_dpp(0, c_, 0x140, 0xF, 0xF, true); \
            OUT = (__builtin_amdgcn_readlane(c_, 0) + __builtin_amdgcn_readlane(c_, 16)) + (__builtin_amdgcn_readlane(c_, 32) + __builtin_amdgcn_readlane(c_, 48)); } while (0)
        float theta = 0.f; int need = 0; bool exact = false;
        int np, nz; CNT_OP("gt", 0.0f, np); CNT_OP("ge", 0.0f, nz);
        if (np < 256 && nz >= 256) { theta = 0.f; need = 256 - np; }
        else {
            float lo, hi; int clo, chi2; bool hi_moved;
            if (np >= 256) { lo = 0.f; clo = nz; float mx = -INFINITY;
#pragma unroll
                for (int i = 0; i < NT; ++i) mx = fmaxf(mx, sc[i]);
                hi = wave_max(mx); chi2 = 1; hi_moved = false; }
            else { hi = 0.f; chi2 = nz; hi_moved = true; clo = t + 1; float mn = INFINITY;
#pragma unroll
                for (int i = 0; i < NT; ++i) mn = fminf(mn, (sc[i] == -INFINITY) ? INFINITY : sc[i]);
                lo = -wave_max(-mn); }
#pragma unroll 1
            for (int it = 0; it < 300; ++it) {
                float mid = 0.5f * (lo + hi);
                if (!(it & 1)) { const float lc = __log2f((float)clo);
                    const float fr = fminf(fmaxf((lc - 8.0028f) * __builtin_amdgcn_rcpf(lc - __log2f(fmaxf((float)chi2, 0.5f))), 0.03f), 0.97f);
                    const float mi = lo + (hi - lo) * fr; if (mi > lo && mi < hi) mid = mi; }
                if (!(mid > lo && mid < hi)) break;
                int cm; CNT_OP("ge", mid, cm);
                if (cm == 256) { theta = mid; exact = true; break; }
                if (cm > 256) { lo = mid; clo = cm; } else { hi = mid; chi2 = cm; hi_moved = true; } }
            if (!exact) {
                theta = lo; int ngt = chi2;
                if (!hi_moved) { CNT_OP("ge", hi, ngt); if (ngt >= 256) { theta = hi; CNT_OP("gt", hi, ngt); } }
                need = 256 - ngt; }
        }
#undef CNT_OP
        if (exact) {
#pragma unroll
            for (int i = 0; i < NT; ++i) { const u64 w = __ballot(sc[i] >= theta);
                mlo = (lane == i) ? (int)(unsigned)w : mlo; mhi = (lane == i) ? (int)(unsigned)(w >> 32) : mhi; }
        } else {
            int running = 0;
#pragma unroll
            for (int i = 0; i < NT; ++i) { const u64 eq = __ballot(sc[i] == theta), gt = __ballot(sc[i] > theta);
                const int rank = (int)__builtin_amdgcn_mbcnt_hi((unsigned)(eq >> 32), __builtin_amdgcn_mbcnt_lo((unsigned)eq, (unsigned)running));
                const u64 lt = __ballot(rank < need); const u64 w = gt | (eq & lt); running += __popcll(eq);
                mlo = (lane == i) ? (int)(unsigned)w : mlo; mhi = (lane == i) ? (int)(unsigned)(w >> 32) : mhi; }
        }
    }
    if (lane < 32) mout[(size_t)lane * SEQ] = ((u64)(unsigned)mhi << 32) | (u64)(unsigned)mlo;
}
constexpr int IDX_STG = 16 * SCP * 4;
constexpr int IDX_QP = 528, IDX_KP = 144;
static_assert(IDX_STG + NWAVES * 16 * IDX_KP <= RING_BYTES && 16 * IDX_QP <= NWAVES * 16 * IDX_KP, "indexer staging");
struct IdxPre { bf16x8 qraw; f32x4 w4; bf16x8 kr[8][2]; };
__device__ __forceinline__ void idx_decode(int L, int& b, int& qt) { b = L & 15; const int j = L >> 4; qt = (j & 1) ? 127 - (j >> 1) : (j >> 1); }
__device__ __forceinline__ void idx_load_k(const Frame& F, int b, int nkb, int kb0, bf16x8 (&kr)[8][2]) {
    const bf16_t* QKV = (const bf16_t*)(F.ws + WS_BIG); const int l = F.lane;
#pragma unroll
    for (int u = 0; u < 8; ++u) { const int kb = kb0 + u * NWAVES; const size_t row0 = (size_t)b * SEQ + (kb < nkb ? kb : nkb - 1) * 16 + (l >> 3);
#pragma unroll
        for (int hf = 0; hf < 2; ++hf) kr[u][hf] = *(const bf16x8*)(QKV + (row0 + hf * 8) * N0 + C0_IK + (l & 7) * 8); }
}
__device__ __forceinline__ void idx_load(const Frame& F, int b, int qt, IdxPre& P) {
    const bf16_t* QKV = (const bf16_t*)(F.ws + WS_BIG); const float* IW = (const float*)(F.ws + WS_IW);
    const int l = F.lane; const size_t row0 = (size_t)b * SEQ + qt * 16;
    P.qraw = *(const bf16x8*)(QKV + (row0 + 2 * F.wave + (l >> 5)) * N0 + C0_IQ + (l & 31) * 8);
    P.w4 = *(const f32x4*)(IW + (row0 + (l & 15)) * 4);
    idx_load_k(F, b, qt + 1, F.wave, P.kr);
}
__device__ __forceinline__ void idx_score(const bf16x8 (&qf)[4][2], const f32x4 w4, const bf16x8 (&kr)[8][2], int kb0, int nkb, LAS unsigned char* wst, LAS float* Sc, int lane) {
    const int fr = lane & 15, fq = lane >> 4;
#pragma unroll
    for (int u = 0; u < 8; ++u) { const int kb = kb0 + u * NWAVES;
        if (kb < nkb) {
            *(LAS bf16x8*)(wst + (lane >> 3) * IDX_KP + (lane & 7) * 16) = kr[u][0]; *(LAS bf16x8*)(wst + (8 + (lane >> 3)) * IDX_KP + (lane & 7) * 16) = kr[u][1];
            const bf16x8 k0 = *(const LAS bf16x8*)(wst + fr * IDX_KP + fq * 16), k1 = *(const LAS bf16x8*)(wst + fr * IDX_KP + 64 + fq * 16);
            f32x4 sc = (f32x4){0.f, 0.f, 0.f, 0.f};
#pragma unroll
            for (int h = 0; h < 4; ++h) { f32x4 a = (f32x4){0.f, 0.f, 0.f, 0.f};
                a = __builtin_amdgcn_mfma_f32_16x16x32_bf16(k0, qf[h][0], a, 0, 0, 0); a = __builtin_amdgcn_mfma_f32_16x16x32_bf16(k1, qf[h][1], a, 0, 0, 0);
#pragma unroll
                for (int j = 0; j < 4; ++j) sc[j] += w4[h] * fmaxf(a[j], 0.f); }
            *(LAS f32x4*)(Sc + fr * SCP + kb * 16 + 4 * fq) = sc; } }
}
__device__ __forceinline__ void idx_units(Frame& F, int c, int G) {
    u64* MASKT = (u64*)(F.ws + WS_MASK);
    LAS float* Sc = (LAS float*)F.lds; LAS unsigned char* stg = F.lds + IDX_STG; LAS unsigned char* wst = stg + F.wave * 16 * IDX_KP;
    const int lane = F.lane, fr = lane & 15, fq = lane >> 4;
    int L = c; if (L >= 2048) return;
    int b, qt; idx_decode(L, b, qt);
    IdxPre P; idx_load(F, b, qt, P);
#pragma unroll 1
    for (;;) {
        const int nkb = qt + 1, nkeys = nkb * 16, q0 = qt * 16;
        *(LAS bf16x8*)(stg + (2 * F.wave + (lane >> 5)) * IDX_QP + (lane & 31) * 16) = P.qraw;
        __syncthreads();
        bf16x8 qf[4][2];
#pragma unroll
        for (int h = 0; h < 4; ++h)
#pragma unroll
            for (int ks = 0; ks < 2; ++ks) qf[h][ks] = *(const LAS bf16x8*)(stg + fr * IDX_QP + h * 128 + ks * 64 + fq * 16);
        __syncthreads();
        idx_score(qf, P.w4, P.kr, F.wave, nkb, wst, Sc, lane);
        if (nkb > 8 * NWAVES) { bf16x8 kr[8][2]; idx_load_k(F, b, nkb, F.wave + 8 * NWAVES, kr);
            idx_score(qf, P.w4, kr, F.wave + 8 * NWAVES, nkb, wst, Sc, lane); }
        __syncthreads();
        const int Ln = L + G; const bool more = Ln < 2048; int bn = b, qn = qt;
        if (more) { idx_decode(Ln, bn, qn); idx_load(F, bn, qn, P); }
        const int nt8 = (nkeys + 511) >> 9;
#pragma unroll 1
        for (int rr = 0; rr < 2; ++rr) {
            const int row = F.wave * 2 + rr, t = q0 + row;
            const LAS float* Srow = Sc + row * SCP; u64* mout = MASKT + (size_t)b * 32 * SEQ + t;
            if (nt8 == 1) select_row<8>(Srow, t, nkeys, lane, mout); else if (nt8 == 2) select_row<16>(Srow, t, nkeys, lane, mout);
            else if (nt8 == 3) select_row<24>(Srow, t, nkeys, lane, mout); else select_row<32>(Srow, t, nkeys, lane, mout);
        }
        __syncthreads();
        if (!more) break;
        L = Ln; b = bn; qt = qn;
    }
}

template <int MODE, bool KOZ = false>
__device__ __forceinline__ void naive_attn_row(const bf16_t* Qrow, const bf16_t* Kp, const bf16_t* Vp, long kvpitch, bf16_t* Orow, int t, const float* cb, const u64* maskb, int lane) {
    float q[64];
#pragma unroll
    for (int c = 0; c < 8; ++c) { const u32x4 w = *(const u32x4*)(Qrow + c * 8);
        q[8 * c + 0] = bf_lo(w.x); q[8 * c + 1] = bf_hi(w.x); q[8 * c + 2] = bf_lo(w.y); q[8 * c + 3] = bf_hi(w.y); q[8 * c + 4] = bf_lo(w.z); q[8 * c + 5] = bf_hi(w.z); q[8 * c + 6] = bf_lo(w.w); q[8 * c + 7] = bf_hi(w.w); }
    float m = -INFINITY, l = 0.f; float o[64];
#pragma unroll
    for (int d = 0; d < 64; ++d) o[d] = 0.f;
    for (int s = lane; s <= t; s += 64) {
        if (MODE == 2) { const u64 w = maskb[(size_t)(s >> 6) * SEQ + t]; if (!((w >> (s & 63)) & 1ull)) continue; }
        const bf16_t* kr = Kp + (size_t)s * kvpitch; float dot = 0.f;
#pragma unroll
        for (int c = 0; c < 8; ++c) { const u32x4 w = *(const u32x4*)(kr + c * 8);
            dot += q[8 * c + 0] * bf_lo(w.x) + q[8 * c + 1] * bf_hi(w.x) + q[8 * c + 2] * bf_lo(w.y) + q[8 * c + 3] * bf_hi(w.y) + q[8 * c + 4] * bf_lo(w.z) + q[8 * c + 5] * bf_hi(w.z) + q[8 * c + 6] * bf_lo(w.w) + q[8 * c + 7] * bf_hi(w.w); }
        if (MODE == 1) dot -= cb[s] * LOG2E;
        const float mn = fmaxf(m, dot), a = exp2f(m - mn), p = exp2f(dot - mn);
        l = l * a + p; m = mn;
        const bf16_t* vr = Vp + (size_t)s * kvpitch;
#pragma unroll
        for (int c = 0; c < 8; ++c) { const u32x4 w = *(const u32x4*)(vr + c * 8);
            o[8 * c + 0] = o[8 * c + 0] * a + p * bf_lo(w.x); o[8 * c + 1] = o[8 * c + 1] * a + p * bf_hi(w.x); o[8 * c + 2] = o[8 * c + 2] * a + p * bf_lo(w.y); o[8 * c + 3] = o[8 * c + 3] * a + p * bf_hi(w.y);
            o[8 * c + 4] = o[8 * c + 4] * a + p * bf_lo(w.z); o[8 * c + 5] = o[8 * c + 5] * a + p * bf_hi(w.z); o[8 * c + 6] = o[8 * c + 6] * a + p * bf_lo(w.w); o[8 * c + 7] = o[8 * c + 7] * a + p * bf_hi(w.w); }
    }
    const float Mx = wave_max(m); const float sc = (m == -INFINITY) ? 0.f : exp2f(m - Mx);
    const float L = wave_sum(l * sc); float res = 0.f;
#pragma unroll
    for (int d = 0; d < 64; ++d) { const float od = wave_sum(o[d] * sc); if (lane == d) res = od; }
    float r = res / L; if (KOZ) r = 0.f;
    const unsigned pk = cvt_pk_bf16(r, r);
    Orow[lane] = (bf16_t)(pk & 0xffffu);
}

constexpr int HG_P = 72;
constexpr int HG_QT = 0, HG_KH = HG_QT + 64 * HG_P * 2, HG_KB = HG_KH + 64 * HG_P * 2, HG_QI = HG_KB + 64 * HG_P * 2, HG_QD = HG_QI + 64 * HG_P * 2,
              HG_KST = HG_QD + 96 * HG_P * 2, HG_VT = HG_KST + 64 * HG_P * 2  , HG_ST = HG_VT + 128 * HG_P * 2  , HG_QRAW = HG_ST + 128 * HG_P * 2,
              HG_FRAW = HG_QRAW + 64 * 64 * 2, HG_TB = HG_FRAW + 64 * 64 * 2  , HG_SC = HG_TB + 4 * 64 * 4  , HG_END = HG_SC + 15 * 64 * 4;
static_assert(HG_END <= RING_BYTES, "hgrn LDS");
__device__ __forceinline__ bf16x8 hg_frag(const LAS unsigned char* base, int row, int col) { return *(const LAS bf16x8*)(base + (row * HG_P + col) * 2); }
__device__ __forceinline__ bf16x8 hg_scale(bf16x8 fr, const LAS float* sp) {
    const u32x4 w = __builtin_bit_cast(u32x4, fr); const f32x4 s0 = *(const LAS f32x4*)sp, s1 = *(const LAS f32x4*)(sp + 4);
    return __builtin_bit_cast(bf16x8, (u32x4){cvt_pk_bf16_v(bf_lo(w.x) * s0[0], bf_hi(w.x) * s0[1]), cvt_pk_bf16_v(bf_lo(w.y) * s0[2], bf_hi(w.y) * s0[3]), cvt_pk_bf16_v(bf_lo(w.z) * s1[0], bf_hi(w.z) * s1[1]), cvt_pk_bf16_v(bf_lo(w.w) * s1[2], bf_hi(w.w) * s1[3])});
}
__device__ __forceinline__ void hgrn_mfma_unit(Frame& F, int u, bool dupo) {
    bf16_t* QKV = (bf16_t*)(F.ws + WS_BIG);
    const int b = u >> 3, h = u & 7, tid = F.tid, lane = F.lane, w = F.wave, cl = lane & 15, g = lane >> 4;
    LAS unsigned char* L = F.lds;
    LAS bf16_t* Qt = (LAS bf16_t*)(L + HG_QT); LAS bf16_t* Kh = (LAS bf16_t*)(L + HG_KH); LAS bf16_t* Kb = (LAS bf16_t*)(L + HG_KB); LAS bf16_t* Qi = (LAS bf16_t*)(L + HG_QI);
    LAS bf16_t* QD = (LAS bf16_t*)(L + HG_QD); LAS bf16_t* KsT = (LAS bf16_t*)(L + HG_KST); LAS bf16_t* STb = (LAS bf16_t*)(L + HG_ST);
    LAS bf16_t* Qraw = (LAS bf16_t*)(L + HG_QRAW); LAS bf16_t* Fraw = (LAS bf16_t*)(L + HG_FRAW); LAS float* Tb = (LAS float*)(L + HG_TB); LAS float* Sc = (LAS float*)(L + HG_SC);
    const int kprep = 8 * w + (lane & 7);
    const float lbk = sigmoidf_(F.inp[I_LB][512 + h * 64 + kprep] - F.inp[I_LB][h * 64 + kprep]);
    const int rt = tid >> 3, rk = (tid & 7) * 8;
    const int vs = tid >> 3, vq = (tid & 7) * 8;
    f32x4 st[2] = {(f32x4){0.f, 0.f, 0.f, 0.f}, (f32x4){0.f, 0.f, 0.f, 0.f}};
    for (int i = tid; i < 2 * 64 * HG_P; i += NTHR) STb[i] = 0;
    const size_t rbase = (size_t)b * SEQ;
    u32x4 rq, rf, rv;
    { const bf16_t* rp = QKV + (rbase + rt) * N1; rq = *(const u32x4*)(rp + C1_HQ + h * 64 + rk); rf = *(const u32x4*)(rp + C1_HF + h * 64 + rk);
      rv = *(const u32x4*)(QKV + (rbase + vs) * N1 + C1_HI + h * 64 + vq); }
    for (int c = 0; c < SEQ / 64; ++c) {
        const size_t row0 = rbase + (size_t)c * 64;
        LAS bf16_t* VT = (LAS bf16_t*)(L + HG_VT + (c & 1) * 64 * HG_P * 2);
        *(LAS u32x4*)(Qraw + rt * 64 + rk) = rq; *(LAS u32x4*)(Fraw + rt * 64 + rk) = rf;
        { const unsigned vv[4] = {rv.x, rv.y, rv.z, rv.w};
#pragma unroll
            for (int e = 0; e < 4; ++e) { VT[(vq + 2 * e) * HG_P + vs] = (bf16_t)(vv[e] & 0xffffu); VT[(vq + 2 * e + 1) * HG_P + vs] = (bf16_t)(vv[e] >> 16); } }
        __syncthreads();
        if (c + 1 < SEQ / 64) { const bf16_t* rp = QKV + (row0 + 64 + rt) * N1; rq = *(const u32x4*)(rp + C1_HQ + h * 64 + rk); rf = *(const u32x4*)(rp + C1_HF + h * 64 + rk);
            rv = *(const u32x4*)(QKV + (row0 + 64 + vs) * N1 + C1_HI + h * 64 + vq); }
        {
            const int k = 8 * w + (lane & 7), sb_ = (lane >> 3) & 3, hf = lane >> 5, tb = 16 * sb_ + 8 * hf;
            float beta[8], kkv[8], qt[8], fr[8]; float bsum = 0.f;
#pragma unroll
            for (int j = 0; j < 8; ++j) { fr[j] = bf1(Fraw[(tb + j) * 64 + k]); qt[j] = bf1(Qraw[(tb + j) * 64 + k]); }
#pragma unroll
            for (int j = 0; j < 8; ++j) { const float sg = __builtin_amdgcn_rcpf(1.f + __builtin_amdgcn_exp2f(-LOG2E * fr[j]));
                const float f = lbk + (1.f - lbk) * sg; bsum += __builtin_amdgcn_logf(f); kkv[j] = 1.f - f; beta[j] = bsum;
                }
            const float oth = __shfl_xor(bsum, 32); const float off = hf ? oth : 0.f, T = bsum + oth;
            const int lb0 = lane & ~24;
            const float T0 = __shfl(T, lb0), T1 = __shfl(T, lb0 | 8), T2 = __shfl(T, lb0 | 16), T3 = __shfl(T, lb0 | 24);
            const float B1 = T0, B2 = B1 + T1, B3 = B2 + T2, B4 = B3 + T3;
            const float Bi = sb_ == 0 ? 0.f : (sb_ == 1 ? B1 : (sb_ == 2 ? B2 : B3)), Bn = sb_ == 0 ? B1 : (sb_ == 1 ? B2 : (sb_ == 2 ? B3 : B4));
            const float eBi = __builtin_amdgcn_exp2f(Bi), Gi = __builtin_amdgcn_exp2f(B4 - Bn), D0 = __builtin_amdgcn_exp2f(Bi - B1), D1 = __builtin_amdgcn_exp2f(Bi - B2), D2 = __builtin_amdgcn_exp2f(Bi - B3);
            if (hf == 0) { Sc[sb_ * 64 + k] = eBi; if (sb_ == 0) Sc[4 * 64 + k] = __builtin_amdgcn_exp2f(B4);
                const int cb9 = 9 + sb_ * (sb_ - 1) / 2; if (sb_ > 0) Sc[cb9 * 64 + k] = D0; if (sb_ > 1) Sc[(cb9 + 1) * 64 + k] = D1; if (sb_ > 2) Sc[(cb9 + 2) * 64 + k] = D2; }
            const float eT = __builtin_amdgcn_exp2f(fmaxf(T, -115.f));
            unsigned ksw[4];
#pragma unroll
            for (int j = 0; j < 8; ++j) { const int t = tb + j;
                const float e = __builtin_amdgcn_exp2f(fmaxf(beta[j] + off, -115.f)), ie = __builtin_amdgcn_rcpf(e), q2 = qt[j] * e, kb = kkv[j] * fminf(eT * ie, 1.0f);
                Qt[t * HG_P + k] = (bf16_t)(cvt_pk_bf16_v(q2, 0.f) & 0xffffu);
                Kh[t * HG_P + k] = (bf16_t)(cvt_pk_bf16_v(kkv[j] * ie, 0.f) & 0xffffu);
                Kb[t * HG_P + k] = (bf16_t)(cvt_pk_bf16_v(kb, 0.f) & 0xffffu);
                const unsigned kp = cvt_pk_bf16_v(kb * Gi, 0.f) & 0xffffu; if (j & 1) ksw[j >> 1] |= kp << 16; else ksw[j >> 1] = kp; }
            *(LAS u32x4*)(KsT + k * HG_P + tb) = (u32x4){ksw[0], ksw[1], ksw[2], ksw[3]};
        }
        __syncthreads();
        {
            const int bi = w >> 1, vt = w & 1;
            f32x4 p[4];
#pragma unroll
            for (int j = 0; j < 4; ++j) { p[j] = (f32x4){0.f, 0.f, 0.f, 0.f};
                if (j <= bi) { const bool dg = (j == bi); const LAS unsigned char* fb = L + (dg ? HG_KH : HG_KB); const int ci = bi * (bi - 1) / 2 + j;
#pragma unroll
                    for (int hh = 0; hh < 2; ++hh) { bf16x8 qf = hg_frag(L + HG_QT, 16 * bi + cl, 32 * hh + 8 * g); if (!dg) qf = hg_scale(qf, Sc + (9 + ci) * 64 + 32 * hh + 8 * g);
                        p[j] = __builtin_amdgcn_mfma_f32_16x16x32_bf16(hg_frag(fb, 16 * j + cl, 32 * hh + 8 * g), qf, p[j], 0, 0, 0); }
                    if (dg) {
#pragma unroll
                        for (int r = 0; r < 4; ++r) if (4 * g + r > cl) p[j][r] = 0.f; } } }
            const bf16x8 f01 = __builtin_bit_cast(bf16x8, (u32x4){cvt_pk_bf16_v(p[0][0], p[0][1]), cvt_pk_bf16_v(p[0][2], p[0][3]), cvt_pk_bf16_v(p[1][0], p[1][1]), cvt_pk_bf16_v(p[1][2], p[1][3])});
            const bf16x8 f23 = __builtin_bit_cast(bf16x8, (u32x4){cvt_pk_bf16_v(p[2][0], p[2][1]), cvt_pk_bf16_v(p[2][2], p[2][3]), cvt_pk_bf16_v(p[3][0], p[3][1]), cvt_pk_bf16_v(p[3][2], p[3][3])});
            bf16x8 qs[2], ksf[2];
            const int kt = w >> 1;
#pragma unroll
            for (int hh = 0; hh < 2; ++hh) { qs[hh] = hg_scale(hg_frag(L + HG_QT, 16 * bi + cl, 32 * hh + 8 * g), Sc + bi * 64 + 32 * hh + 8 * g); ksf[hh] = hg_frag(L + HG_KST, 16 * kt + cl, 32 * hh + 8 * g); }
            const LAS unsigned char* stb = L + HG_ST + (c & 1) * 64 * HG_P * 2;
            LAS bf16_t* stn = (LAS bf16_t*)(L + HG_ST + ((c + 1) & 1) * 64 * HG_P * 2);
            const float dec = Sc[4 * 64 + 16 * kt + cl];
#pragma unroll
            for (int vv_ = 0; vv_ < 2; ++vv_) {
                const int vtile = vt + 2 * vv_;
                const LAS bf16_t* vrow = VT + (16 * vtile + cl) * HG_P;
                const u32x2 va = *(const LAS u32x2*)(vrow + 4 * g), vb = *(const LAS u32x2*)(vrow + 16 + 4 * g), vc = *(const LAS u32x2*)(vrow + 32 + 4 * g), vd = *(const LAS u32x2*)(vrow + 48 + 4 * g);
                f32x4 o = (f32x4){0.f, 0.f, 0.f, 0.f};
                o = __builtin_amdgcn_mfma_f32_16x16x32_bf16(__builtin_bit_cast(bf16x8, (u32x4){va.x, va.y, vb.x, vb.y}), f01, o, 0, 0, 0);
                if (bi >= 2) o = __builtin_amdgcn_mfma_f32_16x16x32_bf16(__builtin_bit_cast(bf16x8, (u32x4){vc.x, vc.y, vd.x, vd.y}), f23, o, 0, 0, 0);
#pragma unroll
                for (int hh = 0; hh < 2; ++hh) o = __builtin_amdgcn_mfma_f32_16x16x32_bf16(hg_frag(stb, 16 * vtile + cl, 32 * hh + 8 * g), qs[hh], o, 0, 0, 0);
                { const u32x2 pk2 = (u32x2){cvt_pk_bf16_v(o[0], o[1]), cvt_pk_bf16_v(o[2], o[3])};
                  bf16_t* op = dupo ? (bf16_t*)(F.ws + WS_END) + ((row0 + 16 * bi + cl) & 1023) * N1 : QKV + (row0 + 16 * bi + cl) * N1;
                  *(u32x2*)(op + C1_HI + h * 64 + 16 * vtile + 4 * g) = pk2; }
                st[vv_] = st[vv_] * dec;
#pragma unroll
                for (int hh = 0; hh < 2; ++hh) st[vv_] = __builtin_amdgcn_mfma_f32_16x16x32_bf16(hg_frag((const LAS unsigned char*)VT, 16 * vtile + cl, 32 * hh + 8 * g), ksf[hh], st[vv_], 0, 0, 0);
#pragma unroll
                for (int r = 0; r < 4; ++r) stn[(16 * vtile + 4 * g + r) * HG_P + 16 * kt + cl] = (bf16_t)(cvt_pk_bf16_v(st[vv_][r], 0.f) & 0xffffu);
            }
        }
    }
    __syncthreads();
}


__device__ __forceinline__ void combine_rows(Frame& F) {
    bf16_t* QKV = (bf16_t*)(F.ws + WS_BIG); const bf16_t* DO = (const bf16_t*)(F.ws + WS_DY);
    const int gw = F.vcu * NWAVES + F.wave, NGW = F.G * NWAVES, lane = F.lane;
    const float* lv = F.inp[I_LAM];
    const float d01 = wave_sum(lv[lane] * lv[64 + lane]), d23 = wave_sum(lv[128 + lane] * lv[192 + lane]);
    const float lam_init = 0.8f - 0.6f * expf(-0.3f);
    const float lam = expf(d01) - expf(d23) + lam_init;
    float gh[8], gd[8];
#pragma unroll
    for (int j = 0; j < 8; ++j) { gh[j] = F.inp[I_HGRN_G][(lane & 7) * 8 + j]; gd[j] = F.inp[I_DIFF_G][(lane & 15) * 8 + j] * (1.0f - lam_init); }
    const int hd = lane >> 4, dd = (lane & 15) * 8;
    u32x4 nwo, nwg, nw1, nw2;
    { const int mc = gw < MTOK ? gw : MTOK - 1; const bf16_t* rp = QKV + (size_t)mc * N1; const bf16_t* dp = DO + (size_t)mc * DM + hd * 256 + dd;
      nwo = *(const u32x4*)(rp + C1_HI + lane * 8); nwg = *(const u32x4*)(rp + C1_HG + lane * 8); nw1 = *(const u32x4*)dp; nw2 = *(const u32x4*)(dp + 128); }
    for (int m = gw; m < MTOK; m += NGW) {
        bf16_t* rp = QKV + (size_t)m * N1;
        const u32x4 wo = nwo, wg = nwg, w1 = nw1, w2 = nw2;
        { const int mn = m + NGW; const int mc = mn < MTOK ? mn : MTOK - 1; const bf16_t* rpn = QKV + (size_t)mc * N1; const bf16_t* dpn = DO + (size_t)mc * DM + hd * 256 + dd;
          nwo = *(const u32x4*)(rpn + C1_HI + lane * 8); nwg = *(const u32x4*)(rpn + C1_HG + lane * 8); nw1 = *(const u32x4*)dpn; nw2 = *(const u32x4*)(dpn + 128); }
        {
          float o[8] = {bf_lo(wo.x), bf_hi(wo.x), bf_lo(wo.y), bf_hi(wo.y), bf_lo(wo.z), bf_hi(wo.z), bf_lo(wo.w), bf_hi(wo.w)};
          float g[8] = {bf_lo(wg.x), bf_hi(wg.x), bf_lo(wg.y), bf_hi(wg.y), bf_lo(wg.z), bf_hi(wg.z), bf_lo(wg.w), bf_hi(wg.w)};
          float ss = 0.f;
#pragma unroll
          for (int j = 0; j < 8; ++j) ss += o[j] * o[j];
          ss += __shfl_xor(ss, 1); ss += __shfl_xor(ss, 2); ss += __shfl_xor(ss, 4);
          const float rs = rsqrtf(ss * (1.0f / 64.0f) + EPS); float r[8];
#pragma unroll
          for (int j = 0; j < 8; ++j) r[j] = (KO & 8) ? 0.f : o[j] * rs * gh[j] * g[j] * __builtin_amdgcn_rcpf(1.0f + __builtin_amdgcn_exp2f(-LOG2E * g[j]));
          *(u32x4*)(rp + C1_HQ + lane * 8) = (u32x4){cvt_pk_bf16(r[0], r[1]), cvt_pk_bf16(r[2], r[3]), cvt_pk_bf16(r[4], r[5]), cvt_pk_bf16(r[6], r[7])}; }
        {
          float a[8] = {bf_lo(w1.x), bf_hi(w1.x), bf_lo(w1.y), bf_hi(w1.y), bf_lo(w1.z), bf_hi(w1.z), bf_lo(w1.w), bf_hi(w1.w)};
          float c[8] = {bf_lo(w2.x), bf_hi(w2.x), bf_lo(w2.y), bf_hi(w2.y), bf_lo(w2.z), bf_hi(w2.z), bf_lo(w2.w), bf_hi(w2.w)};
          float ss = 0.f; float d[8];
#pragma unroll
          for (int j = 0; j < 8; ++j) { d[j] = a[j] - lam * c[j]; ss += d[j] * d[j]; }
          ss += __shfl_xor(ss, 1); ss += __shfl_xor(ss, 2); ss += __shfl_xor(ss, 4); ss += __shfl_xor(ss, 8);
          const float rs = rsqrtf(ss * (1.0f / 128.0f) + EPS); float r[8];
#pragma unroll
          for (int j = 0; j < 8; ++j) r[j] = (KO & 16) ? 0.f : d[j] * rs * gd[j];
          *(u32x4*)(rp + C1_Q + hd * 128 + dd) = (u32x4){cvt_pk_bf16(r[0], r[1]), cvt_pk_bf16(r[2], r[3]), cvt_pk_bf16(r[4], r[5]), cvt_pk_bf16(r[6], r[7])}; }
    }
}

__device__ __forceinline__ void router_rows(Frame& F) {
    const bf16_t* XB = (const bf16_t*)(F.ws + WS_XB); const float* SS = (const float*)(F.ws + WS_SS); const float* WRT = (const float*)(F.ws + WS_WRT);
    float* GATE = (float*)(F.ws + WS_GATE); int* LIST = (int*)(F.ws + WS_LIST); unsigned* cnt = F.ctl + CW_CNT;
    LAS float* Ws = (LAS float*)F.lds;
    LAS unsigned* cntL = (LAS unsigned*)(F.lds + 32768);
    LAS int* rec = (LAS int*)(F.lds + 32768 + 256);
    const int lane = F.lane, NGW = F.G * NWAVES;
    for (int i = F.tid; i < 8 * DM; i += NTHR) Ws[i] = WRT[i];
    const int npass = (MTOK + NGW * 16 - 1) / (NGW * 16);
    for (int ps = 0; ps < npass; ++ps) {
        if (F.tid < 32) cntL[F.tid] = 0u;
        __syncthreads();
        u32x4 nw0, nw1; float nss;
        { const int m0 = ((ps * 16) * F.G + F.vcu) * NWAVES + F.wave; const int mc = m0 < MTOK ? m0 : MTOK - 1;
          nw0 = *(const u32x4*)(XB + (size_t)mc * DM + lane * 8); nw1 = *(const u32x4*)(XB + (size_t)mc * DM + 512 + lane * 8); nss = SS[(size_t)mc * 16 + (lane & 15)]; }
        for (int j = 0; j < 16; ++j) {
            const int m = ((ps * 16 + j) * F.G + F.vcu) * NWAVES + F.wave;
            const u32x4 w0 = nw0, w1 = nw1; const float css = nss;
            if (j + 1 < 16) { const int mn = ((ps * 16 + j + 1) * F.G + F.vcu) * NWAVES + F.wave; const int mc = mn < MTOK ? mn : MTOK - 1;
                nw0 = *(const u32x4*)(XB + (size_t)mc * DM + lane * 8); nw1 = *(const u32x4*)(XB + (size_t)mc * DM + 512 + lane * 8); nss = SS[(size_t)mc * 16 + (lane & 15)]; }
            if (m < MTOK) {
                const float x[16] = {bf_lo(w0.x), bf_hi(w0.x), bf_lo(w0.y), bf_hi(w0.y), bf_lo(w0.z), bf_hi(w0.z), bf_lo(w0.w), bf_hi(w0.w), bf_lo(w1.x), bf_hi(w1.x), bf_lo(w1.y), bf_hi(w1.y), bf_lo(w1.z), bf_hi(w1.z), bf_lo(w1.w), bf_hi(w1.w)};
                float ssum = (lane < 16) ? css : 0.f; ssum = wave_sum(ssum);
                const float rs = rsqrtf(ssum * (1.0f / DM) + EPS);
                { const float sc8 = rs * SX8; unsigned char* x8 = (unsigned char*)(F.ws + WS_XB8) + (size_t)m * DM;
                  int p0 = __builtin_amdgcn_cvt_pk_fp8_f32(x[0] * sc8, x[1] * sc8, 0, false); p0 = __builtin_amdgcn_cvt_pk_fp8_f32(x[2] * sc8, x[3] * sc8, p0, true);
                  int p1 = __builtin_amdgcn_cvt_pk_fp8_f32(x[4] * sc8, x[5] * sc8, 0, false); p1 = __builtin_amdgcn_cvt_pk_fp8_f32(x[6] * sc8, x[7] * sc8, p1, true);
                  int p2 = __builtin_amdgcn_cvt_pk_fp8_f32(x[8] * sc8, x[9] * sc8, 0, false); p2 = __builtin_amdgcn_cvt_pk_fp8_f32(x[10] * sc8, x[11] * sc8, p2, true);
                  int p3 = __builtin_amdgcn_cvt_pk_fp8_f32(x[12] * sc8, x[13] * sc8, 0, false); p3 = __builtin_amdgcn_cvt_pk_fp8_f32(x[14] * sc8, x[15] * sc8, p3, true);
                  *(u32x2*)(x8 + lane * 8) = (u32x2){(unsigned)p0, (unsigned)p1}; *(u32x2*)(x8 + 512 + lane * 8) = (u32x2){(unsigned)p2, (unsigned)p3}; }
                float lg[8];
#pragma unroll
                for (int e = 0; e < 8; ++e) { const LAS float* wp = Ws + e * DM + lane * 8; float s = 0.f;
                    const f32x4 a0 = *(const LAS f32x4*)wp, a1 = *(const LAS f32x4*)(wp + 4), b0 = *(const LAS f32x4*)(wp + 512), b1 = *(const LAS f32x4*)(wp + 516);
                    s += x[0] * a0[0] + x[1] * a0[1] + x[2] * a0[2] + x[3] * a0[3] + x[4] * a1[0] + x[5] * a1[1] + x[6] * a1[2] + x[7] * a1[3];
                    s += x[8] * b0[0] + x[9] * b0[1] + x[10] * b0[2] + x[11] * b0[3] + x[12] * b1[0] + x[13] * b1[1] + x[14] * b1[2] + x[15] * b1[3];
                    lg[e] = wave_sum(s) * rs; }
                int i1 = 0; float l1 = lg[0];
#pragma unroll
                for (int e = 1; e < 8; ++e) if (lg[e] > l1) { l1 = lg[e]; i1 = e; }
                int i2 = -1; float l2 = -INFINITY;
#pragma unroll
                for (int e = 0; e < 8; ++e) if (e != i1 && lg[e] > l2) { l2 = lg[e]; i2 = e; }
                const float g1 = 1.0f / (1.0f + __expf(l2 - l1)), g2 = 1.0f - g1;
                if (lane == 0) {
                    const unsigned r1 = atomicAdd((unsigned*)(cntL + i1), 1u), r2 = atomicAdd((unsigned*)(cntL + 8 + i2), 1u);
                    LAS int* rp = rec + (F.wave * 16 + j) * 4; rp[0] = i1; rp[1] = (int)r1; rp[2] = i2; rp[3] = (int)r2;
                    GATE[m] = g1; GATE[MTOK + m] = g2;
                }
            }
        }
        __syncthreads();
        if (F.tid < 16) { const unsigned n = cntL[F.tid]; cntL[16 + F.tid] = n ? __hip_atomic_fetch_add(cnt + F.tid, n, RLX_AGENT) : 0u; }
        __syncthreads();
        if (F.tid < 128) { const int w = F.tid >> 4, j = F.tid & 15; const int m = ((ps * 16 + j) * F.G + F.vcu) * NWAVES + w;
            if (m < MTOK) { const LAS int* rp = rec + F.tid * 4; const int i1 = rp[0], r1 = rp[1], i2 = rp[2], r2 = rp[3];
                LIST[(size_t)i1 * MTOK + cntL[16 + i1] + r1] = m; LIST[(size_t)(8 + i2) * MTOK + cntL[16 + 8 + i2] + r2] = m; } }
        __syncthreads();
    }
}

__device__ __forceinline__ void final_norm(Frame& F, int part, int widx, int nwork) {
    if (widx < 0) return;
    const int gw = widx * NWAVES + F.wave, NGW = nwork * NWAVES, lane = F.lane;
    const unsigned char* FLAG = (const unsigned char*)(F.ws + WS_FLAG);
    const int mflag = (gw + lane * NGW < MTOK) ? (int)FLAG[gw + lane * NGW] : 0;
    const u64 fl = __ballot(mflag != 0);
    const int nrows = gw < MTOK ? (MTOK - gw + NGW - 1) / NGW : 0;
    u64 todo = (part ? fl : ~fl) & (nrows >= 64 ? ~0ull : ((1ull << nrows) - 1ull));
    if (!todo) return;
    f32x4 g[4];
#pragma unroll
    for (int j = 0; j < 4; ++j) g[j] = *((const f32x4*)F.inp[I_LN_FINAL] + lane + 64 * j);
    const bf16_t* X3 = (const bf16_t*)(F.ws + WS_XB); const bf16_t* Y1 = (const bf16_t*)(F.ws + WS_DY); const bf16_t* Y0 = (const bf16_t*)(F.ws + WS_Y0);
    u32x2 nx[4], ny[4], nz[4];
#define FN_LOAD(M) do { _Pragma("unroll") for (int j_ = 0; j_ < 4; ++j_) { nx[j_] = *((const u32x2*)(X3 + (size_t)(M) * DM) + lane + 64 * j_); ny[j_] = *((const u32x2*)(Y1 + (size_t)(M) * DM) + lane + 64 * j_); nz[j_] = *((const u32x2*)(Y0 + (size_t)(M) * DM) + lane + 64 * j_); } } while (0)
    int jr = __builtin_ctzll(todo); todo &= todo - 1ull;
    FN_LOAD(gw + jr * NGW);
    for (;;) {
        const int m = gw + jr * NGW;
        u32x2 cx[4], cy[4], cz[4];
#pragma unroll
        for (int j = 0; j < 4; ++j) { cx[j] = nx[j]; cy[j] = ny[j]; cz[j] = nz[j]; }
        const bool more = todo != 0ull;
        if (more) { jr = __builtin_ctzll(todo); todo &= todo - 1ull; FN_LOAD(gw + jr * NGW); }
        f32x4* xr = (f32x4*)(F.out + (size_t)m * DM) + lane; f32x4 v[4]; float s = 0.f;
#pragma unroll
        for (int j = 0; j < 4; ++j) { const u32x2 xw = cx[j], yw = cy[j], zw = cz[j];
            v[j] = (f32x4){bf_lo(xw.x), bf_hi(xw.x), bf_lo(xw.y), bf_hi(xw.y)} + ((f32x4){bf_lo(yw.x), bf_hi(yw.x), bf_lo(yw.y), bf_hi(yw.y)} + (f32x4){bf_lo(zw.x), bf_hi(zw.x), bf_lo(zw.y), bf_hi(zw.y)}); s += (v[j][0] * v[j][0] + v[j][1] * v[j][1]) + (v[j][2] * v[j][2] + v[j][3] * v[j][3]); }
        const float rs = rsqrtf(wave_sum(s) * (1.0f / DM) + EPS);
#pragma unroll
        for (int j = 0; j < 4; ++j) xr[64 * j] = v[j] * rs * g[j];
        if (!more) break;
    }
#undef FN_LOAD
}

constexpr int NPH = 17;
struct Args { const float* in[22]; float* out; unsigned char* ws; int ph_lo, ph_hi, li, dup; };
__global__ void __launch_bounds__(NTHR, 2) trunk_fwd(Args args) {
    extern __shared__ __attribute__((aligned(16))) unsigned char lds[];
    Frame F;
    F.lds = (LAS unsigned char*)lds;
    F.tid = threadIdx.x; F.lane = F.tid & 63; F.wave = __builtin_amdgcn_readfirstlane(F.tid >> 6);
    F.G = gridDim.x; { const int bx = blockIdx.x; F.vcu = (F.G % 8 == 0) ? (bx % 8) * (F.G / 8) + bx / 8 : bx; }
    F.ws = args.ws; F.out = args.out; F.ctl = (unsigned*)(args.ws + WS_CTL);
    F.inp = args.in;
    volatile LAS unsigned* MISC = (volatile LAS unsigned*)(F.lds + MISC_OFF);
    for (int u = F.tid; u < (LDS_BYTES - LDSCTL_OFF) / 4; u += NTHR) ((LAS unsigned*)(F.lds + LDSCTL_OFF))[u] = 0u;
    __syncthreads();
    XcdBarrier bar; bar.bar = F.ctl + CW_BAR + args.li * XCD_BAR_WORDS; bar.x = 0; bar.st = nullptr;
    if (!MK_PER_PHASE) bar = xcd_barrier_post(F.ctl + CW_BAR + args.li * XCD_BAR_WORDS, MISC + 8);
#define GRID_BAR() do { if (MK_PER_PHASE) { if (F.tid == 0) __hip_atomic_store(F.ctl + CW_TMO, 0xBADBA0u, RLX_AGENT); } else { xcd_barrier(bar); } } while (0)
    const int lo = args.ph_lo, hi = args.ph_hi;
#ifndef PH_MASK
#define PH_MASK 0x1ffff
#endif
#define IN(k) ((((PH_MASK) >> (k)) & 1) && lo <= (k) && (k) < hi)
#define BOTH(k) (IN(k) && IN((k) + 1))
    unsigned char* ws = args.ws;
    bf16_t* XB = (bf16_t*)(ws + WS_XB); float* SS = (float*)(ws + WS_SS); bf16_t* BIG = (bf16_t*)(ws + WS_BIG);
    const int c = (int)blockIdx.x, G = F.G; const bool dupo = args.dup != 0;

    if (IN(0)) { p0_prologue(F); if (BOTH(0)) GRID_BAR(); }
    if (IN(1)) {
        pg8::Gemm g{XB, ws + WS_WIN0, DM * 2, DM * 2, 0, nullptr}; pg8::StaticOrder S; S.init(MTOK, N0, G, c);
        pg8::EpiIn E{BIG, N0, SS, (const float*)(ws + WS_ROPE), (float*)(ws + WS_LOGF), (float*)(ws + WS_IW), F.inp[I_B_FOX], 0};
        pg8::gemm_phase<pg8::EpiIn, pg8::StaticOrder, false, true>(F.lds, g, S, E);
        if (BOTH(1)) GRID_BAR();
    }
    if (IN(2)) {
        for (int u = c; u < 128; u += G) fox_cumsum_unit(F, u);
        idx_units(F, c, G);
        if (BOTH(2)) GRID_BAR();
    }
    if (IN(3)) {
#if FAST_ATTN
        static_assert(attn_body::LDS_BYTES <= RING_BYTES, "attention LDS");
        if (c < 256) {
            const int cc = (c & 7) * 32 + (c >> 3);
            const int hc = cc >> 1, b = hc >> 3, h = hc & 7;
            attn_body::bf16* base = (attn_body::bf16*)(BIG + (size_t)b * SEQ * N0);
            attn_body::bf16* dbase = (attn_body::bf16*)(ws + WS_XB + 16 * MiB);
            const float* cbp = (const float*)(ws + WS_CB) + (size_t)(b * 8 + h) * SEQ; const u64* mkp = (const u64*)(ws + WS_MASK) + (size_t)b * 32 * SEQ;
            const float fqk = ((const float*)(ws + WS_FQK))[b * 8 + h];
            attn_body::bf16* obase = dupo ? dbase : base;
            const attn_body::bf16* dk_ = base + C0_DK + (h >> 2) * 64; const attn_body::bf16* dv_ = base + C0_DV + (h >> 2) * 64;
#define FOX_SK(QBI) ((QBI) >= 2 && fqk + (cbp[(QBI) * 256] - cbp[(QBI) * 256 - 257]) * LOG2E < -40.0f)
#define FOX_SH(QBI, SK) ((SK) ? (size_t)((QBI) - 1) * 256 * N0 : (size_t)0)
#define FOX_U(QBI, SK, PRE, KN, VN) do { if (SK) { const size_t sh_ = (size_t)((QBI) - 1) * 256 * N0; \
                attn_body::attn_unit<8, 1, N0, N0, N0, 1, PRE, true>(base + sh_ + C0_FQ + h * 64, base + sh_ + C0_FK + h * 64, base + sh_ + C0_FV + h * 64, obase + sh_ + C0_FQ + h * 64, (char*)lds, cbp + ((QBI) - 1) * 256, nullptr, KN, VN); } \
            else attn_body::attn_unit<8, 1, N0, N0, N0, QBI, PRE, true>(base + C0_FQ + h * 64, base + C0_FK + h * 64, base + C0_FV + h * 64, obase + C0_FQ + h * 64, (char*)lds, cbp, nullptr, KN, VN); } while (0)
#define DSA_U(QBI, PFN) attn_body::attn_unit<8, 2, N0, N0, N0, QBI, true, PFN>(base + C0_DQ + h * 64, dk_, dv_, obase + C0_DQ + h * 64, (char*)lds, nullptr, mkp, dk_, dv_)
#define L0_SEQ(A, B, C, D) do { const bool sa = FOX_SK(A), sb = FOX_SK(B), sc_ = FOX_SK(C), sd = FOX_SK(D); \
                FOX_U(A, sa, false, base + FOX_SH(B, sb) + C0_FK + h * 64, base + FOX_SH(B, sb) + C0_FV + h * 64); \
                FOX_U(B, sb, true, base + FOX_SH(C, sc_) + C0_FK + h * 64, base + FOX_SH(C, sc_) + C0_FV + h * 64); \
                FOX_U(C, sc_, true, base + FOX_SH(D, sd) + C0_FK + h * 64, base + FOX_SH(D, sd) + C0_FV + h * 64); \
                FOX_U(D, sd, true, dk_, dv_); \
                DSA_U(A, true); DSA_U(B, true); DSA_U(C, true); DSA_U(D, false); } while (0)
            if (cc & 1) L0_SEQ(1, 6, 3, 4); else L0_SEQ(0, 7, 2, 5);
#undef L0_SEQ
#undef DSA_U
#undef FOX_U
#undef FOX_SH
#undef FOX_SK
#undef DSA_U
        }
#else
        const int gw = F.vcu * NWAVES + F.wave, NGW = G * NWAVES;
        for (int id = gw; id < 256 * SEQ; id += NGW) {
            const int combo = id & 255, t = id >> 8; const int typ = combo >> 7, b = (combo >> 3) & 15, h = combo & 7;
            bf16_t* rowp = BIG + ((size_t)b * SEQ + t) * N0; const bf16_t* b0 = BIG + (size_t)b * SEQ * N0;
            if (typ == 0) naive_attn_row<1, (KO & 1) != 0>(rowp + C0_FQ + h * 64, b0 + C0_FK + h * 64, b0 + C0_FV + h * 64, N0, rowp + C0_FQ + h * 64, t, (const float*)(ws + WS_CB) + (size_t)(b * 8 + h) * SEQ, nullptr, F.lane);
            else naive_attn_row<2, (KO & 2) != 0>(rowp + C0_DQ + h * 64, b0 + C0_DK + (h >> 2) * 64, b0 + C0_DV + (h >> 2) * 64, N0, rowp + C0_DQ + h * 64, t, nullptr, (const u64*)(ws + WS_MASK) + (size_t)b * 32 * SEQ, F.lane);
        }
#endif
        if (BOTH(3)) GRID_BAR();
    }
    if (IN(4)) {
        pg8::Gemm g{BIG, ws + WS_WOUT0, N0 * 2, DM * 2, 0, nullptr}; pg8::StaticOrder S; S.init(MTOK, DM, G, c);
        pg8::EpiRes<true> E{(const float*)XB, nullptr, XB, SS, 0x7fffffff, FFN_GU8 ? (unsigned char*)(ws + WS_XB8) : nullptr, 1.0f};
        pg8::gemm_phase<pg8::EpiRes<true>, pg8::StaticOrder, false, true>(F.lds, g, S, E);
        if (BOTH(4)) GRID_BAR();
    }
    if (IN(5) && !(KO & 4)) {
        pg8::Gemm g{FFN_GU8 ? (const void*)(ws + WS_XB8) : (const void*)XB, ws + WS_WGU0, FFN_GU8 ? DM : DM * 2, FFN_GU8 ? DM : DM * 2, 0, nullptr}; pg8::StaticOrder S; S.init(MTOK, 2 * FF, G, c);
        pg8::EpiGU<false, FFN_DN8 != 0, FFN_GU8 != 0> E{BIG, FF, SS, nullptr};
        pg8::gemm_phase<pg8::EpiGU<false, FFN_DN8 != 0, FFN_GU8 != 0>, pg8::StaticOrder, false, true, FFN_GU8 != 0>(F.lds, g, S, E);
        if (BOTH(5)) GRID_BAR();
    }
    if (IN(6) && !(KO & 4)) {
        pg8::Gemm g{BIG, ws + WS_WDN0, FFN_DN8 ? FF : FF * 2, FFN_DN8 ? FF : FF * 2, 0, nullptr}; pg8::StaticOrder S; S.init(MTOK, DM, G, c);
        pg8::EpiRes<true> E{(const float*)XB, dupo ? (float*)(ws + WS_END) : nullptr, dupo ? (bf16_t*)(ws + WS_END + 4 * MiB) : XB, dupo ? (float*)(ws + WS_END + 6 * MiB) : SS, dupo ? 1023 : 0x7fffffff, nullptr, FFN_DN8 ? 1.0f / (SH8 * SW8) : 1.0f};
        pg8::gemm_phase<pg8::EpiRes<true>, pg8::StaticOrder, false, true, FFN_DN8 != 0>(F.lds, g, S, E);
        if (BOTH(6)) GRID_BAR();
    }
    if (IN(7)) {
        pg8::Gemm g{XB, ws + WS_WIN1, DM * 2, DM * 2, 0, nullptr}; pg8::StaticOrder S; S.init(MTOK, N1, G, c);
        pg8::EpiIn E{BIG, N1, SS, (const float*)(ws + WS_ROPE), nullptr, nullptr, nullptr, 1};
        pg8::gemm_phase<pg8::EpiIn, pg8::StaticOrder, false, true>(F.lds, g, S, E);
        if (BOTH(7)) GRID_BAR();
    }
    if (IN(8)) {
        if (c < 256 && !(dupo && HG_SKIP)) { const int cc_ = (c & 7) * 32 + (c >> 3); if (cc_ & 1) hgrn_mfma_unit(F, cc_ >> 1, dupo); }
        if (!(dupo && AT_SKIP))
#if FAST_ATTN
        if (c < 256) {
            static_assert(attn_body::LDS_BYTES_DV2 <= RING_BYTES, "attention LDS (DV2)");
            const int cc = (c & 7) * 32 + (c >> 3);
            const int hm = cc >> 1, b = hm >> 3, hd = (hm >> 1) & 3, mp = hm & 1;
            attn_body::bf16* base = (attn_body::bf16*)(BIG + (size_t)b * SEQ * N1);
            attn_body::bf16* obase = (attn_body::bf16*)((bf16_t*)(ws + WS_DY) + (size_t)b * SEQ * DM) + (hd * 2 + mp) * 128;
#define DIFF_U(QBI, PRE, PFN) attn_body::attn_unit<8, 0, N1, N1, DM, QBI, PRE, PFN, true>(base + C1_Q + (hd * 2 + mp) * 64, base + C1_K + (hd * 2 + mp) * 64, base + C1_V + hd * 128, obase, (char*)lds, nullptr, nullptr, base + C1_K + (hd * 2 + mp) * 64, base + C1_V + hd * 128)
            if (cc & 1) { DIFF_U(2, false, true); DIFF_U(1, true, true); DIFF_U(0, true, false); }
            else        { DIFF_U(7, false, true); DIFF_U(6, true, true); DIFF_U(5, true, true); DIFF_U(4, true, true); DIFF_U(3, true, false); }
#undef DIFF_U
        }
#else
        const int gw = F.vcu * NWAVES + F.wave, NGW = G * NWAVES;
        bf16_t* DO = (bf16_t*)(ws + WS_DY);
        for (int id = gw; id < 256 * SEQ; id += NGW) {
            const int combo = id & 255, t = id >> 8; const int b = combo >> 4, hd = (combo >> 2) & 3, mp = (combo >> 1) & 1, jv = combo & 1;
            const bf16_t* rowp = BIG + ((size_t)b * SEQ + t) * N1; const bf16_t* b0 = BIG + (size_t)b * SEQ * N1;
            naive_attn_row<0>(rowp + C1_Q + (hd * 2 + mp) * 64, b0 + C1_K + (hd * 2 + mp) * 64, b0 + C1_V + hd * 128 + jv * 64, N1,
                              DO + ((size_t)b * SEQ + t) * DM + (hd * 2 + mp) * 128 + jv * 64, t, nullptr, nullptr, F.lane);
        }
#endif
        if (BOTH(8)) GRID_BAR();
    }
    if (IN(9)) { combine_rows(F); if (BOTH(9)) GRID_BAR(); }
    if (IN(10)) {
        pg8::Gemm g{BIG, ws + WS_WOUT1, N1 * 2, DM * 2, 0, nullptr}; pg8::StaticOrder S; S.init(MTOK, DM, G, c);
        pg8::EpiRes<true> E{(const float*)XB, dupo ? (float*)(ws + WS_END) : nullptr, dupo ? (bf16_t*)(ws + WS_END + 4 * MiB) : XB, dupo ? (float*)(ws + WS_END + 6 * MiB) : SS, dupo ? 1023 : 0x7fffffff, nullptr, 1.0f};
        pg8::gemm_phase<pg8::EpiRes<true>, pg8::StaticOrder, false, true>(F.lds, g, S, E);
        if (BOTH(10)) GRID_BAR();
    }
    if (IN(11)) { router_rows(F); if (BOTH(11)) GRID_BAR(); }
    { const int* LIST = (const int*)(ws + WS_LIST);
      if (IN(12) && !(KO & 32)) {
          { pg8::MoeOrder Sd; Sd.init(F.ctl + CW_CNT, 4, G, c);
            for (int pg = Sd.Pmain + c; pg < Sd.NPt; pg += G) { pg8::Unit pu; Sd.panel(pg, pu); if (F.tid < pu.nvalid) ((unsigned char*)(ws + WS_FLAG))[LIST[pu.lbase + F.tid]] = 1; } }
          pg8::Gemm g{ws + WS_XB8, ws + WS_WEGU, DM, DM, (size_t)7168 * DM, LIST}; pg8::MoeOrder S; S.init(F.ctl + CW_CNT, 28, G, c);
          pg8::EpiGU<true> E{BIG, FFE, SS, LIST};
          pg8::gemm_phase<pg8::EpiGU<true>, pg8::MoeOrder, true, true, true>(F.lds, g, S, E);
          if (BOTH(12)) GRID_BAR();
      }
      if (IN(13) && !(KO & 32)) {
          pg8::Gemm g{BIG, ws + WS_WEDN, FFE, FFE, (size_t)DM * FFE, nullptr}; pg8::MoeOrder S; S.init(F.ctl + CW_CNT, 4, G, c);
          pg8::EpiMoeDown E{dupo ? (bf16_t*)(ws + WS_END) : (bf16_t*)(ws + WS_Y0), LIST, (const float*)(ws + WS_GATE), dupo ? 2047 : 0x7fffffff, dupo ? (bf16_t*)(ws + WS_END + 8 * MiB) : (bf16_t*)(ws + WS_DY)};
          S.mode = 1; pg8::gemm_phase<pg8::EpiMoeDown, pg8::MoeOrder, false, true, true>(F.lds, g, S, E);
          GRID_BAR();
          const int nsur = S.NPt * 4 - S.Lmain;
          S.mode = 2;
          if (c < nsur) pg8::gemm_phase<pg8::EpiMoeDown, pg8::MoeOrder, false, true, true>(F.lds, g, S, E);
          else final_norm(F, 0, c - nsur, G - nsur);
          GRID_BAR();
          final_norm(F, 1, F.vcu, G);
      } }
#undef IN
#undef BOTH
}


#ifndef DBG
#define DBG 0
#endif
#if DBG
constexpr int CW_CHK = 512;
constexpr size_t WS_DBG = WS_END;
__device__ __forceinline__ void chk_max(unsigned* ctl, int id, float e) { if (!(e >= 0.f)) e = 1e30f; atomicMax(ctl + CW_CHK + id, __float_as_uint(e)); }
__device__ __forceinline__ float relerr(float got, float exp_, float scale = 1.0f) { return fabsf(got - exp_) / (fabsf(exp_) + 0.5f * scale); }
__device__ __forceinline__ int dbg_row(int i) { const int rows[8] = {0, 255, 256, 1000, 2047, 2048 + 77, 16 * 2048 - 1, 20000}; return rows[i & 7]; }
__device__ float block_sum(float v, float* red) {
    v = wave_sum(v); __syncthreads(); if ((threadIdx.x & 63) == 0) red[threadIdx.x >> 6] = v; __syncthreads();
    float s = 0.f; for (int w = 0; w < 8; ++w) s += red[w]; __syncthreads(); return s;
}
__global__ void __launch_bounds__(512) dbg_check(Args args, int which) {
    __shared__ float hv[3584]; __shared__ float raw[2880]; __shared__ float red[8];
    const float* const* in = args.in; unsigned char* ws = args.ws; unsigned* ctl = (unsigned*)(ws + WS_CTL);
    const int tid = threadIdx.x; const int r = dbg_row(blockIdx.x), t = r & (SEQ - 1);
    const bf16_t* BIG = (const bf16_t*)(ws + WS_BIG); const bf16_t* XB = (const bf16_t*)(ws + WS_XB); const float* SS = (const float*)(ws + WS_SS);
    float* SCR = (float*)(ws + WS_DBG) + (size_t)blockIdx.x * 1024;
    float emax = 0.f;
    if (which == 1) {
        float ssq = 0.f; for (int k = tid; k < DM; k += 512) { const float x = in[I_X][(size_t)r * DM + k]; ssq += x * x; }
        const float rs = rsqrtf(block_sum(ssq, red) / DM + EPS);
        for (int k = tid; k < DM; k += 512) hv[k] = in[I_X][(size_t)r * DM + k] * rs * in[I_LN_MIX_E][k];
        __syncthreads();
        for (int n = tid; n < N0SRC; n += 512) { float a = 0.f; for (int k = 0; k < DM; ++k) a += hv[k] * in[I_W_IN_E][(size_t)k * N0SRC + n]; raw[n] = a; }
        __syncthreads();
        const bf16_t* q = BIG + (size_t)r * N0;
        float e1 = 0.f, e2 = 0.f, e3 = 0.f;
        for (int i = tid; i < 512; i += 512) { e1 = fmaxf(e1, relerr(bf1(q[C0_FQ + i]), raw[i] * C2, C2)); e2 = fmaxf(e2, relerr(bf1(q[C0_FK + i]), raw[512 + i])); e3 = fmaxf(e3, relerr(bf1(q[C0_FV + i]), raw[1024 + i])); }
        chk_max(ctl, 21, wave_max(e1)); chk_max(ctl, 22, wave_max(e2)); chk_max(ctl, 23, wave_max(e3));
        float e4 = 0.f; for (int i = tid; i < 128; i += 512) e4 = fmaxf(e4, relerr(bf1(q[C0_DV + i]), raw[2184 + i]));
        chk_max(ctl, 24, wave_max(e4));
        const int sb[4] = {1544, 2056, 2312, 2568}, nh[4] = {8, 2, 4, 1}, db[4] = {C0_DQ, C0_DK, C0_IQ, C0_IK}; const float scl[4] = {C2, 1.f, 0.125f, 1.f};
        for (int sg = 0; sg < 4; ++sg) { float e = 0.f; for (int i = tid; i < nh[sg] * 32; i += 512) { const int hh = i >> 5, p = i & 31;
            const float inv = powf(10000.0f, -(float)p * 2.0f / 64.0f), ang = (float)t * inv, cs = cosf(ang), sn = sinf(ang);
            const float x1 = raw[sb[sg] + hh * 64 + p], x2 = raw[sb[sg] + hh * 64 + 32 + p];
            e = fmaxf(e, relerr(bf1(q[db[sg] + hh * 64 + 2 * p]), (x1 * cs - x2 * sn) * scl[sg], scl[sg])); e = fmaxf(e, relerr(bf1(q[db[sg] + hh * 64 + 2 * p + 1]), (x2 * cs + x1 * sn) * scl[sg], scl[sg])); }
            chk_max(ctl, 25 + sg, wave_max(e)); }
        float e9 = 0.f, e10 = 0.f;
        if (tid < 8) { const float x = raw[1536 + tid] + in[I_B_FOX][tid]; const float lf = fminf(x, 0.f) - log1pf(expf(-fabsf(x))); e9 = relerr(((const float*)(ws + WS_LOGF))[(size_t)r * 8 + tid], lf); }
        if (tid < 4) e10 = relerr(((const float*)(ws + WS_IW))[(size_t)r * 4 + tid], raw[2632 + tid] * 0.5f);
        float ea = 0.f, eb = 0.f, ec = 0.f;
        if (tid < 8) { ea = relerr(bf1(q[C0_FF + tid]), raw[1536 + tid]); const float x = raw[1536 + tid]; const float lf = fminf(x, 0.f) - log1pf(expf(-fabsf(x))); eb = relerr(((const float*)(ws + WS_LOGF))[(size_t)r * 8 + tid], lf); ec = e9; }
        chk_max(ctl, 1, wave_max(ea)); chk_max(ctl, 2, wave_max(eb)); chk_max(ctl, 3, wave_max(ec)); chk_max(ctl, 4, wave_max(e10));
    } else if (which == 2) {
        const float* LOGF = (const float*)(ws + WS_LOGF); const float* CB = (const float*)(ws + WS_CB); const u64* MASKT = (const u64*)(ws + WS_XB);
        const int gid = blockIdx.x * 512 + tid;
        if (gid < 128) { const int b = gid >> 3, h = gid & 7; float c = 0.f; for (int s2 = 0; s2 < SEQ; ++s2) { c += LOGF[((size_t)b * SEQ + s2) * 8 + h]; emax = fmaxf(emax, fabsf(CB[(size_t)gid * SEQ + s2] - c) / (fabsf(c) * 1e-3f + 0.01f)); } }
        chk_max(ctl, 2, wave_max(emax));
        float e3 = 0.f;
        for (int rr = gid; rr < MTOK; rr += 8 * 512) { const int b = rr >> 11, tt = rr & 2047; int pc = 0; bool bad = false;
            for (int i = 0; i < 32; ++i) { const u64 w = MASKT[((size_t)b * 32 + i) * SEQ + tt]; pc += __popcll(w);
                const int lo = i * 64; if (lo > tt) { if (w) bad = true; } else if (tt - lo < 63) { if (w >> (tt - lo + 1)) bad = true; } }
            const int want = (tt + 1 < 256) ? tt + 1 : 256; if (pc != want || bad) e3 = 1.f; }
        chk_max(ctl, 3, wave_max(e3));
    } else if (which == 4) {
        for (int k = tid; k < DM; k += 512) hv[k] = bf1(BIG[(size_t)r * N0 + k]);
        __syncthreads();
        float ssq = 0.f;
        for (int n = tid; n < DM; n += 512) { float a = in[I_X][(size_t)r * DM + n]; for (int k = 0; k < DM; ++k) a += hv[k] * in[I_W_OUT_E][(size_t)k * DM + n];
            emax = fmaxf(emax, relerr(args.out[(size_t)r * DM + n], a)); emax = fmaxf(emax, relerr(bf1(XB[(size_t)r * DM + n]), a)); ssq += a * a; }
        ssq = block_sum(ssq, red); float s16 = 0.f; for (int i = 0; i < 16; ++i) s16 += SS[(size_t)r * 16 + i];
        emax = fmaxf(emax, fabsf(s16 - ssq) / ssq * 10.f);
        chk_max(ctl, 4, wave_max(emax));
    } else if (which == 5) {
        float ssq = 0.f; for (int k = tid; k < DM; k += 512) { const float x = args.out[(size_t)r * DM + k]; ssq += x * x; }
        const float rs = rsqrtf(block_sum(ssq, red) / DM + EPS);
        for (int k = tid; k < DM; k += 512) hv[k] = args.out[(size_t)r * DM + k] * rs * in[I_LN_FFN_E][k];
        __syncthreads();
        for (int n = tid; n < FF; n += 512) { float g = 0.f, u = 0.f; for (int k = 0; k < DM; ++k) { g += hv[k] * in[I_W_GATE][(size_t)k * FF + n]; u += hv[k] * in[I_W_UP][(size_t)k * FF + n]; }
            const float h = g / (1.f + expf(-g)) * u; emax = fmaxf(emax, relerr(bf1(BIG[(size_t)r * FF + n]), h)); }
        __syncthreads();
        for (int k = tid; k < FF; k += 512) hv[k] = bf1(BIG[(size_t)r * FF + k]);
        __syncthreads();
        for (int n = tid; n < DM; n += 512) { float a = args.out[(size_t)r * DM + n]; for (int k = 0; k < FF; ++k) a += hv[k] * in[I_W_DOWN][(size_t)k * DM + n]; SCR[n] = a; }
        chk_max(ctl, 5, wave_max(emax));
    } else if (which == 6) {
        for (int n = tid; n < DM; n += 512) emax = fmaxf(emax, relerr(args.out[(size_t)r * DM + n], SCR[n]));
        chk_max(ctl, 6, wave_max(emax));
    }
}
__global__ void __launch_bounds__(512) dbg_encode(Args args, int nchk, int total) {
    const unsigned* ctl = (const unsigned*)(args.ws + WS_CTL);
    int idx = 0, mag = 0;
    for (int i = 1; i <= nchk; ++i) { const float e = __uint_as_float(ctl[CW_CHK + i]); if (e > 0.06f) { idx = i; mag = 0; float th = 1.0f; while (mag < 9 && e < th) { th *= 0.5f; ++mag; } break; } }
    const float s = sqrtf((float)(10 * idx + mag));
    for (int i = blockIdx.x * 512 + threadIdx.x; i < total; i += gridDim.x * 512) args.out[i] = s;
}
#endif
extern "C" void kernel_launch(void* const* d_in, const int* in_sizes, int n_in, void* d_out, int out_size, void* d_ws, size_t ws_size, hipStream_t stream) {
    static int grid = 0;
    if (grid == 0) {
        if (n_in != 22 || in_sizes[0] != MTOK * DM || out_size != MTOK * DM || ws_size < WS_END) { fprintf(stderr, "kernel_launch: unexpected shapes / workspace (%zu < %zu)\n", ws_size, (size_t)WS_END); grid = -1; return; }
        int dev = 0, cus = 0, per_cu = 0;
        if (hipGetDevice(&dev) != hipSuccess || hipDeviceGetAttribute(&cus, hipDeviceAttributeMultiprocessorCount, dev) != hipSuccess) { grid = -1; return; }
        if (hipFuncSetAttribute((const void*)trunk_fwd, hipFuncAttributeMaxDynamicSharedMemorySize, LDS_BYTES) != hipSuccess) { grid = -1; return; }
        if (hipOccupancyMaxActiveBlocksPerMultiprocessor(&per_cu, (const void*)trunk_fwd, NTHR, LDS_BYTES) != hipSuccess || per_cu < 1) { fprintf(stderr, "kernel_launch: occupancy query says %d\n", per_cu); }
        (void)hipGetLastError();
        grid = cus;
    }
    if (grid < 0) return;
    if (hipMemsetAsync((char*)d_ws + WS_CTL, 0, CTL_ZERO_BYTES, stream) != hipSuccess) return;
    Args a{};
    for (int i = 0; i < 22; ++i) a.in[i] = (const float*)d_in[i];
    a.out = (float*)d_out; a.ws = (unsigned char*)d_ws; a.dup = 0;
#if MK_PER_PHASE
    for (int p = 0; p < NPH; ++p) { a.ph_lo = p; a.ph_hi = p + 1; a.li = p; hipLaunchKernelGGL(trunk_fwd, dim3(grid), dim3(NTHR), LDS_BYTES, stream, a);
#if DBG
        if (p == 1 || p == 2 || p == 4 || p == 5 || p == 6) hipLaunchKernelGGL(dbg_check, dim3(8), dim3(512), 0, stream, a, p);
        if (p == DBG_LAST) { hipLaunchKernelGGL(dbg_encode, dim3(1024), dim3(512), 0, stream, a, 9, MTOK * DM); break; }
#endif
    }
#else
#if PROBE_PH >= 0
    a.ph_lo = 0; a.ph_hi = PROBE_PH + 1; a.li = 0; hipLaunchKernelGGL(trunk_fwd, dim3(grid), dim3(NTHR), LDS_BYTES, stream, a);
    a.ph_lo = PROBE_PH; a.ph_hi = PROBE_PH + 1; a.li = 1; a.dup = 1; hipLaunchKernelGGL(trunk_fwd, dim3(grid), dim3(NTHR), LDS_BYTES, stream, a);
    a.dup = 0; a.ph_lo = PROBE_PH + 1; a.ph_hi = NPH; a.li = 2; hipLaunchKernelGGL(trunk_fwd, dim3(grid), dim3(NTHR), LDS_BYTES, stream, a);
#else
    a.ph_lo = 0; a.ph_hi = NPH; a.li = 0;
    hipLaunchKernelGGL(trunk_fwd, dim3(grid), dim3(NTHR), LDS_BYTES, stream, a);
#endif
#endif
}
```
